# Optimizing an MI355X kernel written in HIP

```python
import jax, jax.numpy as jnp
from jax import lax
import numpy as np

D_MODEL = 1024
BATCH = 8
SEQ = 4096
DEPTH = 2

N_MIXERS = 2
D_FF = 2816
D_PLE = 256
CONV_WIDTH = 3
RET_HEADS = 4
RET_QK_DIM = D_MODEL // RET_HEADS
RET_V_DIM = 2 * RET_QK_DIM
RET_CHUNK = 128
ROPE_BASE = 10000.0
NORM_EPS = 1e-6
N_CONV_LAYERS = (DEPTH + N_MIXERS - 1) // N_MIXERS
N_RET_LAYERS = DEPTH // N_MIXERS

N_NORMS = 8
FFN1_PRE, FFN1_POST, MIX_PRE, MIX_POST, FFN2_PRE, FFN2_POST, PLE_PRE, PLE_POST = range(N_NORMS)

kernel_name = "hybrid_shortconv_retention_macaron"


def rmsnorm(x, g):
    xf = x.astype(jnp.float32)
    y = xf * lax.rsqrt(jnp.mean(xf * xf, axis=-1, keepdims=True) + NORM_EPS)
    return (y * g.astype(jnp.float32)).astype(x.dtype)


def swiglu(x, w_gate, w_up, w_down):
    return (jax.nn.silu(x @ w_gate) * (x @ w_up)) @ w_down


def short_conv_mixer(x, w_in, conv_w, w_out):
    T = x.shape[1]
    b, c, h = jnp.split(x @ w_in, 3, axis=-1)
    u = c * h
    u_pad = jnp.pad(u, ((0, 0), (CONV_WIDTH - 1, 0), (0, 0)))
    v = conv_w[0] * u_pad[:, 0:T]
    for k in range(1, CONV_WIDTH):
        v = v + conv_w[k] * u_pad[:, k:k + T]
    return (b * v) @ w_out


def rotary(x, pos):
    half = x.shape[-1] // 2
    inv_freq = 1.0 / (ROPE_BASE ** jnp.linspace(0.0, 1.0, half, dtype=jnp.float32))
    ang = pos.astype(jnp.float32)[:, None] * inv_freq[None, :]
    cos = jnp.cos(ang)[:, None, :]
    sin = jnp.sin(ang)[:, None, :]
    x1, x2 = x[..., :half], x[..., half:]
    return jnp.concatenate([x1 * cos - x2 * sin, x2 * cos + x1 * sin], axis=-1)


def retention_mixer(x, w_in, w_out):
    Bsz, T, _ = x.shape
    H, dk, dv, C = RET_HEADS, RET_QK_DIM, RET_V_DIM, RET_CHUNK
    n_chunks = T // C
    f32 = jnp.float32
    proj = x @ w_in
    q, k, v, g = jnp.split(proj, [H * dk, 2 * H * dk, 2 * H * dk + H * dv], axis=-1)
    pos = jnp.arange(T)
    q = rotary(q.reshape(Bsz, T, H, dk).astype(f32), pos)
    k = rotary(k.reshape(Bsz, T, H, dk).astype(f32), pos) * (dk ** -0.5)
    v = v.reshape(Bsz, T, H, dv).astype(f32)

    log_gamma = jnp.log1p(-jnp.exp2(-5.0 - jnp.arange(H, dtype=f32)))
    idx = jnp.arange(C, dtype=f32)
    diff = idx[:, None] - idx[None, :]
    intra_decay = jnp.where(diff >= 0.0,
                            jnp.exp(log_gamma[:, None, None] * jnp.maximum(diff, 0.0)[None]),
                            0.0)
    q_decay = jnp.exp(log_gamma[:, None] * (idx + 1.0))[None, :, :, None]
    k_decay = jnp.exp(log_gamma[:, None] * (C - 1.0 - idx))[None, :, :, None]
    chunk_decay = jnp.exp(log_gamma * C)[None, :, None, None]

    def to_chunks(a):
        return a.reshape(Bsz, n_chunks, C, H, a.shape[-1]).transpose(1, 0, 3, 2, 4)

    def step(state, qkv):
        qc, kc, vc = qkv
        scores = jnp.einsum('bhid,bhjd->bhij', qc, kc) * intra_decay
        inner = jnp.einsum('bhij,bhje->bhie', scores, vc)
        cross = jnp.einsum('bhid,bhde->bhie', qc * q_decay, state)
        new_state = chunk_decay * state + jnp.einsum('bhjd,bhje->bhde', kc * k_decay, vc)
        return new_state, inner + cross

    state0 = jnp.zeros((Bsz, H, dk, dv), f32)
    _, out = lax.scan(step, state0, (to_chunks(q), to_chunks(k), to_chunks(v)))
    out = out.transpose(1, 0, 3, 2, 4).reshape(Bsz, T, H, dv)
    out = out * lax.rsqrt(jnp.mean(out * out, axis=-1, keepdims=True) + NORM_EPS)
    y = jax.nn.silu(g) * out.reshape(Bsz, T, H * dv).astype(x.dtype)
    return y @ w_out


def setup_inputs(seed: int = 0) -> dict:
    key = jax.random.key(seed)
    ks = jax.random.split(key, 16)
    f32 = jnp.float32

    def w(k, shape, fan_in):
        return jax.random.normal(k, shape, f32) * (fan_in ** -0.5)

    ret_in_width = 2 * RET_HEADS * RET_QK_DIM + 2 * RET_HEADS * RET_V_DIM
    return {
        "x": jax.random.normal(ks[0], (BATCH, SEQ, D_MODEL), f32),
        "p": jax.random.normal(ks[1], (DEPTH, BATCH, SEQ, D_PLE), f32),
        "norm_g": 1.0 + 0.05 * jax.random.normal(ks[2], (DEPTH, N_NORMS, D_MODEL), f32),
        "ffn1_w_gate": w(ks[3], (DEPTH, D_MODEL, D_FF), D_MODEL),
        "ffn1_w_up": w(ks[4], (DEPTH, D_MODEL, D_FF), D_MODEL),
        "ffn1_w_down": w(ks[5], (DEPTH, D_FF, D_MODEL), D_FF),
        "ffn2_w_gate": w(ks[6], (DEPTH, D_MODEL, D_FF), D_MODEL),
        "ffn2_w_up": w(ks[7], (DEPTH, D_MODEL, D_FF), D_MODEL),
        "ffn2_w_down": w(ks[8], (DEPTH, D_FF, D_MODEL), D_FF),
        "conv_w_in": w(ks[9], (N_CONV_LAYERS, D_MODEL, 3 * D_MODEL), D_MODEL),
        "conv_w": w(ks[10], (N_CONV_LAYERS, CONV_WIDTH, D_MODEL), CONV_WIDTH),
        "conv_w_out": w(ks[11], (N_CONV_LAYERS, D_MODEL, D_MODEL), D_MODEL),
        "ret_w_in": w(ks[12], (N_RET_LAYERS, D_MODEL, ret_in_width), D_MODEL),
        "ret_w_out": w(ks[13], (N_RET_LAYERS, RET_HEADS * RET_V_DIM, D_MODEL), RET_HEADS * RET_V_DIM),
        "ple_w_proj": w(ks[14], (DEPTH, D_PLE, D_MODEL), D_PLE),
        "ple_w_gate": w(ks[15], (DEPTH, D_MODEL, D_MODEL), D_MODEL),
    }


def reference(x, p, norm_g, ffn1_w_gate, ffn1_w_up, ffn1_w_down, ffn2_w_gate, ffn2_w_up, ffn2_w_down,
              conv_w_in, conv_w, conv_w_out, ret_w_in, ret_w_out, ple_w_proj, ple_w_gate):
    for i in range(DEPTH):
        g = norm_g[i]
        h = swiglu(rmsnorm(x, g[FFN1_PRE]), ffn1_w_gate[i], ffn1_w_up[i], ffn1_w_down[i])
        x = x + 0.5 * rmsnorm(h, g[FFN1_POST])
        xn = rmsnorm(x, g[MIX_PRE])
        j = i // N_MIXERS
        if i % N_MIXERS == 0:
            h = short_conv_mixer(xn, conv_w_in[j], conv_w[j], conv_w_out[j])
        else:
            h = retention_mixer(xn, ret_w_in[j], ret_w_out[j])
        x = x + rmsnorm(h, g[MIX_POST])
        h = swiglu(rmsnorm(x, g[FFN2_PRE]), ffn2_w_gate[i], ffn2_w_up[i], ffn2_w_down[i])
        x = x + 0.5 * rmsnorm(h, g[FFN2_POST])
        gate = jax.nn.sigmoid(rmsnorm(x, g[PLE_PRE]) @ ple_w_gate[i])
        e = (p[i].astype(x.dtype) @ ple_w_proj[i]) * gate
        x = x + rmsnorm(e, g[PLE_POST])
    return x
```

```cpp
#include <hip/hip_runtime.h>
#include <cstdio>
#include <cstdint>
namespace pg8 {
#define PG8_LAS __attribute__((address_space(3)))
typedef unsigned short bf16_t;
typedef short bf16x8 __attribute__((ext_vector_type(8)));
typedef float f32x4 __attribute__((ext_vector_type(4)));
typedef unsigned u32x4 __attribute__((ext_vector_type(4)));
constexpr int BM = 256, BK = 64, HALF = 128, HTB = HALF * BK * 2  , STAGE_BYTES = 8 * HTB, NXCD = 8, WGM = 8;

__host__ __device__ __forceinline__ int lds_byte(int r, int c) { const int st = (r >> 4) * 2 + (c >> 5), rr = r & 15, cc = c & 31, ob = rr * 64 + cc * 2; return st * 1024 + (ob ^ (((ob >> 9) & 1) << 5)); }
__host__ __device__ __forceinline__ void stage_rc(int b, int& R, int& C) { const int st = b / 1024, sb = b % 1024, swz = sb ^ (((sb >> 9) & 1) << 5); R = (st >> 1) * 16 + swz / 64; C = (st & 1) * 32 + (swz % 64) / 2; }
__host__ __device__ __forceinline__ int perm32(int rho) { const int n = rho >> 4, i = rho & 15; return 8 * (i >> 2) + 4 * n + (i & 3); }

struct Unit { int pm, pn; };
struct Gemm { const bf16_t* A; const bf16_t* Bt; int M, N, K; };

struct StaticOrder {
    int nM, nN, nwg, G, c;
    __host__ __device__ void init(int M, int N, int G_, int c_) { nM = M / BM; nN = N / BM; nwg = nM * nN; G = G_; c = c_; }
    __host__ __device__ bool next(int i, Unit& u) const {
        const long L = (long)i * G + c; if (L >= nwg) return false;
        int wgid = (int)L; { const int q = nwg / NXCD, r = nwg % NXCD, xcd = wgid % NXCD, off = wgid / NXCD; wgid = (xcd < r ? xcd * (q + 1) : r * (q + 1) + (xcd - r) * q) + off; }
        const int nig = WGM * nN, gid = wgid / nig, fm = gid * WGM, gsz = (nM - fm) < WGM ? (nM - fm) : WGM;
        u.pm = fm + ((wgid % nig) % gsz); u.pn = (wgid % nig) / gsz; return true;
    }
    __device__ __forceinline__ void a_ready(const Unit&) const {}
    __device__ __forceinline__ void done(const Unit&) const {}
};

__device__ __forceinline__ unsigned cvt_pk_bf16(float lo, float hi) { unsigned r; asm volatile("v_cvt_pk_bf16_f32 %0, %1, %2" : "=v"(r) : "v"(lo), "v"(hi)); return r; }
typedef float f32x2 __attribute__((ext_vector_type(2)));
__device__ __forceinline__ float sigmoid_f(float v) { return __builtin_amdgcn_rcpf(1.0f + __builtin_amdgcn_exp2f(v * -1.4426950408889634f)); }
__device__ __forceinline__ u32x4 pack8(const f32x4 a, const f32x4 b) { u32x4 w; w.x = cvt_pk_bf16(a[0], a[1]); w.y = cvt_pk_bf16(a[2], a[3]); w.z = cvt_pk_bf16(b[0], b[1]); w.w = cvt_pk_bf16(b[2], b[3]); return w; }
__device__ __forceinline__ f32x4 bf4_lo(const u32x4 w) { return (f32x4){__uint_as_float(w.x << 16), __uint_as_float(w.x & 0xffff0000u), __uint_as_float(w.y << 16), __uint_as_float(w.y & 0xffff0000u)}; }
__device__ __forceinline__ f32x4 bf4_hi(const u32x4 w) { return (f32x4){__uint_as_float(w.z << 16), __uint_as_float(w.z & 0xffff0000u), __uint_as_float(w.w << 16), __uint_as_float(w.w & 0xffff0000u)}; }

struct EpiF32 {
    static constexpr bool PERM = false, AFTER_DRAIN = false;
    float* C; int ldc;
    __device__ __forceinline__ void operator()(const f32x4 (&acc)[2][2][4][2], const Unit& u, int wr, int wc, int fr, int fq) const {
        const int row0 = u.pm * BM + wr * 64 + fr, col0 = u.pn * BM + wc * 32 + 4 * fq;
#pragma unroll
        for (int ai = 0; ai < 2; ++ai)
#pragma unroll
            for (int m = 0; m < 4; ++m) { float* rowp = C + (size_t)(row0 + ai * HALF + m * 16) * ldc + col0;
#pragma unroll
                for (int bj = 0; bj < 2; ++bj)
#pragma unroll
                    for (int n = 0; n < 2; ++n) *(f32x4*)(rowp + bj * HALF + n * 16) = acc[ai][bj][m][n]; }
    }
};
struct EpiMulSig {
    static constexpr bool PERM = false, AFTER_DRAIN = false;
    float* C; int ldc;
    __device__ __forceinline__ void operator()(const f32x4 (&acc)[2][2][4][2], const Unit& u, int wr, int wc, int fr, int fq) const {
        const int row0 = u.pm * BM + wr * 64 + fr, col0 = u.pn * BM + wc * 32 + 4 * fq;
#pragma unroll
        for (int ai = 0; ai < 2; ++ai)
#pragma unroll
            for (int m = 0; m < 4; ++m) { float* rowp = C + (size_t)(row0 + ai * HALF + m * 16) * ldc + col0;
#pragma unroll
                for (int bj = 0; bj < 2; ++bj)
#pragma unroll
                    for (int n = 0; n < 2; ++n) { const f32x4 g = *(const f32x4*)(rowp + bj * HALF + n * 16); f32x4 o;
                        o[0] = acc[ai][bj][m][n][0] * sigmoid_f(g[0]); o[1] = acc[ai][bj][m][n][1] * sigmoid_f(g[1]); o[2] = acc[ai][bj][m][n][2] * sigmoid_f(g[2]); o[3] = acc[ai][bj][m][n][3] * sigmoid_f(g[3]);
                        *(f32x4*)(rowp + bj * HALF + n * 16) = o; asm volatile("" ::: "memory"); } }
    }
};
template <int ACT  > struct EpiGLU {
    static constexpr bool PERM = true, AFTER_DRAIN = false;
    bf16_t* O; int ldc;
    __device__ __forceinline__ void operator()(const f32x4 (&acc)[2][2][4][2], const Unit& u, int wr, int wc, int fr, int fq) const {
        const int row0 = u.pm * BM + wr * 64 + fr, col0 = u.pn * HALF + wc * 32 + 8 * fq;
#pragma unroll
        for (int ai = 0; ai < 2; ++ai)
#pragma unroll
            for (int m = 0; m < 4; ++m) { bf16_t* rowp = O + (size_t)(row0 + ai * HALF + m * 16) * ldc + col0; f32x4 v[2];
#pragma unroll
                for (int n = 0; n < 2; ++n) { const f32x4 a = acc[ai][0][m][n], b = acc[ai][1][m][n];
#pragma unroll
                    for (int x = 0; x < 4; ++x) v[n][x] = (ACT ? a[x] * sigmoid_f(a[x]) : a[x]) * b[x]; }
                *(u32x4*)rowp = pack8(v[0], v[1]); }
    }
};
struct EpiConv {
    static constexpr bool PERM = true, AFTER_DRAIN = false;
    bf16_t* O; const bf16_t* U; const float* cw; int ldc; int seq;
    __device__ __forceinline__ void operator()(const f32x4 (&acc)[2][2][4][2], const Unit& u, int wr, int wc, int fr, int fq) const {
        const int row0 = u.pm * BM + wr * 64 + fr;
#pragma unroll
        for (int bj = 0; bj < 2; ++bj) { const int col0 = u.pn * BM + bj * HALF + wc * 32 + 8 * fq;
            f32x4 w[3][2];
#pragma unroll
            for (int k = 0; k < 3; ++k)
#pragma unroll
                for (int n = 0; n < 2; ++n) w[k][n] = *(const f32x4*)(cw + (size_t)k * ldc + col0 + 4 * n);
#pragma unroll
            for (int ai = 0; ai < 2; ++ai)
#pragma unroll
                for (int m = 0; m < 4; ++m) { const int row = row0 + ai * HALF + m * 16; const int t = row & (seq - 1); const size_t off = (size_t)row * ldc + col0;
                    const u32x4 u2 = *(const u32x4*)(U + off); u32x4 u1 = (u32x4){0u, 0u, 0u, 0u}, u0 = (u32x4){0u, 0u, 0u, 0u};
                    if (t >= 1) u1 = *(const u32x4*)(U + off - ldc);
                    if (t >= 2) u0 = *(const u32x4*)(U + off - 2 * ldc);
                    const f32x4 c0 = w[0][0] * bf4_lo(u0) + w[1][0] * bf4_lo(u1) + w[2][0] * bf4_lo(u2), c1 = w[0][1] * bf4_hi(u0) + w[1][1] * bf4_hi(u1) + w[2][1] * bf4_hi(u2);
                    *(u32x4*)(O + off) = pack8(acc[ai][bj][m][0] * c0, acc[ai][bj][m][1] * c1);
                    asm volatile("" ::: "memory"); }
        }
    }
};
struct EpiRetQK {
    static constexpr bool PERM = true, AFTER_DRAIN = false;
    bf16_t* Q; bf16_t* Kb; const float* cs; const float* sn; int seq;
    __device__ __forceinline__ void operator()(const f32x4 (&acc)[2][2][4][2], const Unit& u, int wr, int wc, int fr, int fq) const {
        const int row0 = u.pm * BM + wr * 64 + fr;
        const float sc = (u.pn < 4) ? 1.0f : 0.0625f;
        bf16_t* op = ((u.pn < 4) ? Q : Kb) + (size_t)row0 * 1024 + (u.pn & 3) * 256 + wc * 32 + 8 * fq;
        const size_t toff = (size_t)(row0 & (seq - 1)) * 128 + wc * 32 + 8 * fq; const float* cp = cs + toff; const float* sp = sn + toff;
#pragma unroll
        for (int ai = 0; ai < 2; ++ai)
#pragma unroll
            for (int m = 0; m < 4; ++m) { const int dr = ai * HALF + m * 16; f32x4 o1[2], o2[2];
#pragma unroll
                for (int n = 0; n < 2; ++n) { const f32x4 c = *(const f32x4*)(cp + dr * 128 + 4 * n) * sc, sv = *(const f32x4*)(sp + dr * 128 + 4 * n) * sc;
                    const f32x4 x1 = acc[ai][0][m][n], x2 = acc[ai][1][m][n]; o1[n] = x1 * c - x2 * sv; o2[n] = x2 * c + x1 * sv; }
                *(u32x4*)(op + dr * 1024) = pack8(o1[0], o1[1]); *(u32x4*)(op + dr * 1024 + HALF) = pack8(o2[0], o2[1]);
                asm volatile("" ::: "memory"); }
    }
};
struct EpiRetV {
    static constexpr bool PERM = true, AFTER_DRAIN = false;
    bf16_t* V;
    __device__ __forceinline__ void operator()(const f32x4 (&acc)[2][2][4][2], const Unit& u, int wr, int wc, int fr, int fq) const {
        const int row0 = u.pm * BM + wr * 64 + fr;
        const int head = u.pn >> 1; const float lg = __builtin_amdgcn_logf(1.0f - __builtin_amdgcn_exp2f(-5.0f - (float)head));
        bf16_t* op = V + (size_t)row0 * 2048 + u.pn * 256 + wc * 32 + 8 * fq; const int j0 = 127 - (row0 & 127);
#pragma unroll
        for (int ai = 0; ai < 2; ++ai)
#pragma unroll
            for (int m = 0; m < 4; ++m) { const int dr = ai * HALF + m * 16; const float kd = __builtin_amdgcn_exp2f(lg * (float)(j0 - m * 16));
#pragma unroll
                for (int bj = 0; bj < 2; ++bj) *(u32x4*)(op + dr * 2048 + bj * HALF) = pack8(acc[ai][bj][m][0] * kd, acc[ai][bj][m][1] * kd); }
    }
};
struct EpiRetGate {
    static constexpr bool PERM = true, AFTER_DRAIN = false;
    bf16_t* Y; const float* ssq; float eps;
    __device__ __forceinline__ void operator()(const f32x4 (&acc)[2][2][4][2], const Unit& u, int wr, int wc, int fr, int fq) const {
        const int row0 = u.pm * BM + wr * 64 + fr; const int head = u.pn >> 1, col0 = u.pn * BM + wc * 32 + 8 * fq;
#pragma unroll
        for (int ai = 0; ai < 2; ++ai)
#pragma unroll
            for (int m = 0; m < 4; ++m) { const int row = row0 + ai * HALF + m * 16;
                const f32x4 s0 = *(const f32x4*)(ssq + ((size_t)row * 4 + head) * 8), s1 = *(const f32x4*)(ssq + ((size_t)row * 4 + head) * 8 + 4);
                const float tot = ((s0[0] + s0[1]) + (s0[2] + s0[3])) + ((s1[0] + s1[1]) + (s1[2] + s1[3])); const float rn = __builtin_amdgcn_rsqf(tot * (1.0f / 512.0f) + eps);
                bf16_t* rowp = Y + (size_t)row * 2048 + col0;
#pragma unroll
                for (int bj = 0; bj < 2; ++bj) { const u32x4 o = *(const u32x4*)(rowp + bj * HALF); const f32x4 oa = bf4_lo(o), ob = bf4_hi(o); f32x4 va, vb;
#pragma unroll
                    for (int x = 0; x < 4; ++x) { const float a = acc[ai][bj][m][0][x], b = acc[ai][bj][m][1][x]; va[x] = a * sigmoid_f(a) * oa[x] * rn; vb[x] = b * sigmoid_f(b) * ob[x] * rn; }
                    *(u32x4*)(rowp + bj * HALF) = pack8(va, vb); }
                asm volatile("" ::: "memory"); }
    }
};

template <class Epi, class Sched, bool ALIGN_EPI = false, bool SP2 = false>
__device__ __forceinline__ void gemm_phase(PG8_LAS unsigned char* lds, const Gemm g, const Sched& S, const Epi& E) {
    int tid_ = threadIdx.x; asm volatile("" : "+v"(tid_));
    const int tid = tid_, wid = __builtin_amdgcn_readfirstlane(tid >> 6), lane = tid & 63, wr = wid >> 2, wc = wid & 3, fr = lane & 15, fq = lane >> 4;
    int K_ = g.K; asm volatile("" : "+s"(K_));
    const int K = K_, nt = K / BK;
    unsigned voffA[2], voffB[2];
#pragma unroll
    for (int i = 0; i < 2; ++i) { int R, C; stage_rc(tid * 16 + i * 8192, R, C); const int Rb = Epi::PERM ? ((R & ~31) + perm32(R & 31)) : R;
        voffA[i] = (unsigned)(R * K + C) * 2u; voffB[i] = (unsigned)(Rb * K + C) * 2u; }
    const size_t kstep = (size_t)(BK * 2);
    const size_t hstep = (size_t)HALF * K * 2;
    const size_t tstep = 2 * hstep;
    const unsigned ldsw = (unsigned)wid * 1024u;
    const int aoff = lds_byte(wr * 64 + fr, fq * 8), boff = lds_byte(wc * 32 + fr, fq * 8);
#define PG8_SA(b, h) (((b) * 2 + (h)) * HTB)
#define PG8_SB(b, h) ((4 + (b) * 2 + (h)) * HTB)
#define PG8_STAGE(bufoff, gbase, voff) do { _Pragma("unroll") for (int _i = 0; _i < 2; ++_i) \
        __builtin_amdgcn_global_load_lds((const unsigned*)((const char*)(gbase) + (voff)[_i]), (PG8_LAS unsigned*)(lds + (bufoff) + ldsw + _i * 8192), 16, 0, 0); } while (0)
#define PG8_LDA(dst, b, h) do { _Pragma("unroll") for (int m = 0; m < 4; ++m) _Pragma("unroll") for (int k = 0; k < 2; ++k) dst[m][k] = *(const PG8_LAS bf16x8*)(lds + PG8_SA(b, h) + aoff + m * 2048 + k * 1024); } while (0)
#define PG8_LDB(dst, b, h) do { _Pragma("unroll") for (int n = 0; n < 2; ++n) _Pragma("unroll") for (int k = 0; k < 2; ++k) dst[n][k] = *(const PG8_LAS bf16x8*)(lds + PG8_SB(b, h) + boff + n * 2048 + k * 1024); } while (0)
#define PG8_MMA(ai, bj, At, Bt) do { __builtin_amdgcn_s_setprio(1); _Pragma("unroll") for (int m = 0; m < 4; ++m) _Pragma("unroll") for (int n = 0; n < 2; ++n) _Pragma("unroll") for (int k = 0; k < 2; ++k) \
        acc[ai][bj][m][n] = __builtin_amdgcn_mfma_f32_16x16x32_bf16(Bt[n][k], At[m][k], acc[ai][bj][m][n], 0, 0, 0); __builtin_amdgcn_s_setprio(0); } while (0)
#define PG8_WAIT_V(n) asm volatile("s_waitcnt vmcnt(" #n ")" ::: "memory")
#define PG8_WAIT_L(n) asm volatile("s_waitcnt lgkmcnt(" #n ")" ::: "memory")
#define PG8_BAR __builtin_amdgcn_s_barrier()
#define PG8_SCHED __builtin_amdgcn_sched_barrier(0)
    Unit cur, nxt; int ui = 0;
    if (!S.next(0, cur)) return;
    f32x4 acc[2][2][4][2];
#pragma unroll
    for (int a = 0; a < 2; ++a)
#pragma unroll
        for (int b = 0; b < 2; ++b)
#pragma unroll
            for (int m = 0; m < 4; ++m)
#pragma unroll
                for (int n = 0; n < 2; ++n) acc[a][b][m][n] = (f32x4){0.f, 0.f, 0.f, 0.f};
    bf16x8 At[4][2], B0[2][2], B1[2][2];
    const char* cA = (const char*)g.A + (size_t)cur.pm * tstep; const char* cB = (const char*)g.Bt + (size_t)cur.pn * tstep;
    S.a_ready(cur);
    if constexpr (SP2) {
        PG8_STAGE(PG8_SB(0, 0), cB, voffB); PG8_STAGE(PG8_SB(0, 1), cB + hstep, voffB); PG8_STAGE(PG8_SA(0, 0), cA, voffA); PG8_STAGE(PG8_SA(0, 1), cA + hstep, voffA);
        if (wr == 1) PG8_BAR;
        PG8_WAIT_V(2); PG8_BAR;
        PG8_STAGE(PG8_SB(1, 0), cB + kstep, voffB); PG8_STAGE(PG8_SA(1, 0), cA + kstep, voffA); PG8_STAGE(PG8_SB(1, 1), cB + hstep + kstep, voffB);
        PG8_WAIT_V(6); PG8_BAR;
    } else {
        PG8_STAGE(PG8_SB(0, 0), cB, voffB); PG8_STAGE(PG8_SA(0, 0), cA, voffA); PG8_STAGE(PG8_SB(0, 1), cB + hstep, voffB); PG8_STAGE(PG8_SA(0, 1), cA + hstep, voffA);
        if (wr == 1) PG8_BAR;
        PG8_WAIT_V(4); PG8_BAR;
        PG8_STAGE(PG8_SB(1, 0), cB + kstep, voffB); PG8_STAGE(PG8_SA(1, 0), cA + kstep, voffA); PG8_STAGE(PG8_SB(1, 1), cB + hstep + kstep, voffB);
        PG8_WAIT_V(6); PG8_BAR;
    }
    for (;;) {
        const bool has_next = S.next(ui + 1, nxt);
        const char* nA = has_next ? (const char*)g.A + (size_t)nxt.pm * tstep : cA; const char* nB = has_next ? (const char*)g.Bt + (size_t)nxt.pn * tstep : cB;
        for (int t = 0; t < nt; t += 2) {
            const bool last = (t == nt - 2);
            const char* a1 = cA + (size_t)(t + 1) * kstep;
            const char* a2 = last ? nA : cA + (size_t)(t + 2) * kstep; const char* b2 = last ? nB : cB + (size_t)(t + 2) * kstep;
            const char* a3 = a2 + kstep; const char* b3 = b2 + kstep;
            if (last && has_next) S.a_ready(nxt);
            if constexpr (SP2) {
            PG8_LDB(B0, 0, 0); PG8_LDB(B1, 0, 1); PG8_SCHED; PG8_LDA(At, 0, 0); PG8_STAGE(PG8_SA(1, 1), a1 + hstep, voffA);
            PG8_WAIT_V(8); PG8_WAIT_L(0); PG8_BAR; PG8_MMA(0, 0, At, B0); PG8_MMA(0, 1, At, B1); PG8_BAR; PG8_SCHED;
            PG8_LDA(At, 0, 1); PG8_STAGE(PG8_SB(0, 0), b2, voffB); PG8_STAGE(PG8_SB(0, 1), b2 + hstep, voffB); PG8_STAGE(PG8_SA(0, 0), a2, voffA);
            PG8_WAIT_V(8); PG8_WAIT_L(0); PG8_BAR; PG8_MMA(1, 0, At, B0); PG8_MMA(1, 1, At, B1); PG8_BAR; PG8_SCHED;
            PG8_LDB(B0, 1, 0); PG8_LDB(B1, 1, 1); PG8_SCHED; PG8_LDA(At, 1, 0); PG8_STAGE(PG8_SA(0, 1), a2 + hstep, voffA);
            PG8_WAIT_V(8); PG8_WAIT_L(0); PG8_BAR; PG8_MMA(0, 0, At, B0); PG8_MMA(0, 1, At, B1); PG8_BAR; PG8_SCHED;
            PG8_LDA(At, 1, 1); PG8_STAGE(PG8_SB(1, 0), b3, voffB); PG8_STAGE(PG8_SB(1, 1), b3 + hstep, voffB); PG8_STAGE(PG8_SA(1, 0), a3, voffA);
            PG8_WAIT_V(8); PG8_WAIT_L(0); PG8_BAR; PG8_MMA(1, 0, At, B0); PG8_MMA(1, 1, At, B1); PG8_BAR; PG8_SCHED;
            } else {
            PG8_LDB(B0, 0, 0); PG8_SCHED; PG8_LDA(At, 0, 0); PG8_STAGE(PG8_SA(1, 1), a1 + hstep, voffA);
            PG8_WAIT_L(8); PG8_BAR; PG8_WAIT_L(0); PG8_MMA(0, 0, At, B0); PG8_BAR; PG8_SCHED;
            PG8_LDB(B1, 0, 1); PG8_STAGE(PG8_SB(0, 0), b2, voffB);
            PG8_BAR; PG8_WAIT_L(0); PG8_MMA(0, 1, At, B1); PG8_BAR;
            PG8_LDA(At, 0, 1); PG8_STAGE(PG8_SA(0, 0), a2, voffA);
            PG8_BAR; PG8_WAIT_L(0); PG8_MMA(1, 0, At, B0); PG8_BAR; PG8_SCHED;
            PG8_STAGE(PG8_SB(0, 1), b2 + hstep, voffB);
            PG8_WAIT_V(6); PG8_BAR; PG8_MMA(1, 1, At, B1); PG8_BAR;
            PG8_LDB(B0, 1, 0); PG8_SCHED; PG8_LDA(At, 1, 0); PG8_STAGE(PG8_SA(0, 1), a2 + hstep, voffA);
            PG8_WAIT_L(8); PG8_BAR; PG8_WAIT_L(0); PG8_MMA(0, 0, At, B0); PG8_BAR; PG8_SCHED;
            PG8_LDB(B1, 1, 1); PG8_STAGE(PG8_SB(1, 0), b3, voffB);
            PG8_BAR; PG8_WAIT_L(0); PG8_MMA(0, 1, At, B1); PG8_BAR;
            PG8_LDA(At, 1, 1); PG8_STAGE(PG8_SA(1, 0), a3, voffA);
            PG8_BAR; PG8_WAIT_L(0); PG8_MMA(1, 0, At, B0); PG8_BAR; PG8_SCHED;
            PG8_STAGE(PG8_SB(1, 1), b3 + hstep, voffB);
            PG8_WAIT_V(6); PG8_BAR; PG8_MMA(1, 1, At, B1); PG8_BAR;
            }
        }
        if constexpr (ALIGN_EPI) { if (wr == 0) PG8_BAR; }
        if constexpr (!Epi::AFTER_DRAIN) { E(acc, cur, wr, wc, fr, fq); S.done(cur); }
        if (!has_next) break;
#pragma unroll
        for (int a = 0; a < 2; ++a)
#pragma unroll
            for (int b = 0; b < 2; ++b)
#pragma unroll
                for (int m = 0; m < 4; ++m)
#pragma unroll
                    for (int n = 0; n < 2; ++n) acc[a][b][m][n] = (f32x4){0.f, 0.f, 0.f, 0.f};
        cur = nxt; cA = nA; cB = nB; ++ui;
        if constexpr (ALIGN_EPI) { if (wr == 1) PG8_BAR; }
    }
    PG8_WAIT_V(0);
    if constexpr (!ALIGN_EPI) { if (wr == 0) PG8_BAR; }
    PG8_BAR;
    if constexpr (Epi::AFTER_DRAIN) { E.fused(acc, cur, wr, wc, fr, fq, lds, wid, lane); S.done(cur); }
#undef PG8_SA
#undef PG8_SB
#undef PG8_STAGE
#undef PG8_LDA
#undef PG8_LDB
#undef PG8_MMA
#undef PG8_WAIT_V
#undef PG8_WAIT_L
#undef PG8_BAR
#undef PG8_SCHED
}
}
#define GAS __attribute__((address_space(1)))
#define LAS __attribute__((address_space(3)))
typedef unsigned short bf16;
typedef unsigned v4u __attribute__((ext_vector_type(4)));
typedef float f32x4 __attribute__((ext_vector_type(4)));
typedef short bf16x8 __attribute__((ext_vector_type(8)));
typedef GAS unsigned gu32;
typedef GAS unsigned long long gu64;
#define RLX_AGENT __ATOMIC_RELAXED, __HIP_MEMORY_SCOPE_AGENT
#define LDS_WAIT() asm volatile("s_waitcnt lgkmcnt(0)" ::: "memory")
#define VM_WAIT() asm volatile("s_waitcnt vmcnt(0)" ::: "memory")
__device__ __forceinline__ unsigned long long rt() { return __builtin_amdgcn_s_memrealtime(); }
__device__ __forceinline__ unsigned f2bf(float f) { unsigned u = __builtin_bit_cast(unsigned, f); return (u + 0x7fffu + ((u >> 16) & 1u)) >> 16; }
__device__ __forceinline__ unsigned pk2(float lo, float hi) { return f2bf(lo) | (f2bf(hi) << 16); }

#define XB_TMO      128
#define XB_XCNT(j)  (256  + 64 * (j))
#define XB_XSUB(j)  (1280 + 64 * (j))
#define XB_XGEN(j)  (2304 + 64 * (j))
#define XB_TOP      3328
#define XB_TOPGEN   3392
#define XCD_BAR_WORDS 3456
#define XB_SPIN_CAP (1u << 18)

__device__ __forceinline__ unsigned xb_ld(unsigned* p)              { return __hip_atomic_load(p, __ATOMIC_RELAXED, __HIP_MEMORY_SCOPE_AGENT); }
__device__ __forceinline__ unsigned xb_add(unsigned* p, unsigned v) { return __hip_atomic_fetch_add(p, v, __ATOMIC_RELAXED, __HIP_MEMORY_SCOPE_AGENT); }
__device__ __forceinline__ unsigned xb_xcc_id() { return (unsigned)__builtin_amdgcn_s_getreg((3 << 11) | 20) & 0xFu; }
#define XB_SPIN(cond, bar) do { unsigned _sp = 0; while (cond) { __builtin_amdgcn_s_sleep(1); \
    if ((++_sp & 255u) == 0u) { if (xb_ld(&(bar)[XB_TMO])) break; if (_sp > XB_SPIN_CAP) { atomicAdd(&(bar)[XB_TMO], 1u); break; } } } } while (0)

struct XcdBarrier {
    unsigned* bar; unsigned x;
    volatile LAS unsigned* st;
};

__device__ __forceinline__ XcdBarrier xcd_barrier_post(unsigned* bar, volatile LAS unsigned* st) {
    XcdBarrier b; b.bar = bar; b.x = xb_xcc_id(); b.st = st;
    if (threadIdx.x == 0) (void)xb_add(&bar[XB_XCNT(b.x)], 1u);
    return b;
}
__device__ __forceinline__ void xcd_barrier_complete(unsigned* bar, unsigned x, unsigned& nloc, unsigned& nx) {
    const unsigned G = gridDim.x * gridDim.y * gridDim.z;
    unsigned sum, cnt, mine, sp = 0u;
    for (;;) {
        sum = 0u; cnt = 0u; mine = 0u;
#pragma unroll
        for (unsigned j = 0; j < 16; ++j) { const unsigned c = xb_ld(&bar[XB_XCNT(j)]); sum += c; cnt += (c > 0u) ? 1u : 0u; mine = (j == x) ? c : mine; }
        if (sum == G) break;
        __builtin_amdgcn_s_sleep(1);
        if ((++sp & 255u) == 0u) { if (xb_ld(&bar[XB_TMO])) break; if (sp > XB_SPIN_CAP) { atomicAdd(&bar[XB_TMO], 1u); break; } }
    }
    nloc = mine > 0u ? mine : 1u; nx = cnt > 0u ? cnt : 1u;
}

__device__ __forceinline__ void xcd_barrier(const XcdBarrier& b) {
    asm volatile("s_waitcnt vmcnt(0)" ::: "memory");
    __syncthreads();
    if (threadIdx.x == 0) {
        unsigned* bar = b.bar;
        __builtin_amdgcn_s_waitcnt(0);
        unsigned nloc = b.st[0], nx = b.st[1];
        if (nloc == 0u) { xcd_barrier_complete(bar, b.x, nloc, nx); b.st[0] = nloc; b.st[1] = nx; }
        const unsigned old = xb_add(&bar[XB_XSUB(b.x)], 1u);
        const unsigned gen = old / nloc;
        if (old + 1u == (gen + 1u) * nloc) {
            __builtin_amdgcn_fence(__ATOMIC_RELEASE, "agent");
            asm volatile("s_waitcnt vmcnt(0)" ::: "memory");
            const unsigned og = xb_add(&bar[XB_TOP], 1u);
            const unsigned tg = og / nx;
            if (og + 1u == (tg + 1u) * nx) xb_add(&bar[XB_TOPGEN], 1u);
            else XB_SPIN(xb_ld(&bar[XB_TOPGEN]) == tg, bar);
            __builtin_amdgcn_fence(__ATOMIC_ACQUIRE, "agent");
            xb_add(&bar[XB_XGEN(b.x)], 1u);
            asm volatile("s_waitcnt vmcnt(0)" ::: "memory");
        } else {
            XB_SPIN(xb_ld(&bar[XB_XGEN(b.x)]) == gen, bar);
            __builtin_amdgcn_fence(__ATOMIC_ACQUIRE, "agent");
            asm volatile("s_waitcnt vmcnt(0)" ::: "memory");
        }
    }
    __syncthreads();
}
#define RET_HD __host__ __device__ __forceinline__
RET_HD unsigned off_b(unsigned row, unsigned ch) { return 256u * row + 16u * (ch ^ (((row & 3u) << 2) | ((row >> 2) & 3u))); }
RET_HD unsigned koff(unsigned j, unsigned d) { return (d >> 7) * 32768u + off_b(j, (d & 127u) >> 3) + (d & 7u) * 2u; }
RET_HD unsigned vswz(unsigned j) { return ((j >> 1) & 1u) | (((j >> 2) & 3u) << 1); }
RET_HD unsigned voff(unsigned j, unsigned e) { return 128u * j + 16u * ((e >> 3) ^ vswz(j)) + (e & 7u) * 2u; }
RET_HD unsigned soff(unsigned e, unsigned d) { return (d >> 7) * 16384u + off_b(e, (d & 127u) >> 3) + (d & 7u) * 2u; }
constexpr unsigned RET_LDS_K = 0u, RET_LDS_V = 65536u, RET_LDS_S = 81920u, RET_LDS_END = 114688u;
#ifndef PG8_SP2
#define PG8_SP2 true
#endif
#ifndef PG8_ALIGN
#define PG8_ALIGN true
#endif
#ifndef MK_PER_PHASE
#define MK_PER_PHASE 1
#endif
constexpr int NWAVES = 8;

constexpr int BATCH = 8, SEQ = 4096, D = 1024, FF = 2816, DPLE = 256, NHEAD = 4, DK = 256, DV = 512, CHUNK = 128, NCHUNK = SEQ / CHUNK;
constexpr int M = BATCH * SEQ;
constexpr int NRQKV = 2 * NHEAD * DK + NHEAD * DV;
constexpr float NORM_EPS = 1e-6f;
enum { FFN1_PRE = 0, FFN1_POST, MIX_PRE, MIX_POST, FFN2_PRE, FFN2_POST, PLE_PRE, PLE_POST };

constexpr size_t MiB = 1u << 20;
constexpr size_t WS_CTL = 0, CTL_ZERO_BYTES = 1 * MiB;
constexpr size_t WS_COS = 2 * MiB, WS_SIN = 4 * MiB;
constexpr size_t WS_SSQ = 6 * MiB;
constexpr size_t WS_W = 10 * MiB;
constexpr size_t W_GU = 0, W_DN = (size_t)2 * FF * D, W_FFN = W_DN + (size_t)D * FF;
constexpr size_t W_LAYER = 2 * W_FFN + (size_t)D * DPLE + (size_t)D * D;
constexpr size_t W_PP = 2 * W_FFN, W_PG = W_PP + (size_t)D * DPLE;
constexpr size_t W_CCH = 2 * W_LAYER, W_CB = W_CCH + (size_t)2 * D * D, W_CO = W_CB + (size_t)D * D;
constexpr size_t W_RIN = W_CO + (size_t)D * D, W_ROUT = W_RIN + (size_t)6144 * D, W_END = W_ROUT + (size_t)D * 2048;
static_assert(W_END * 2 <= 96 * MiB, "weights fit 96 MiB");
constexpr size_t WS_PB = 106 * MiB;
constexpr size_t WS_XN = 138 * MiB;
constexpr size_t WS_HBUF = 202 * MiB;
constexpr size_t WS_Q = WS_HBUF, WS_K = WS_HBUF + 64 * MiB;
constexpr size_t WS_BIG = 330 * MiB;
constexpr size_t WS_V = WS_BIG, WS_U = WS_BIG, WS_AB = WS_BIG + 64 * MiB;
constexpr size_t WS_END = 506 * MiB;
static_assert(WS_BIG + (size_t)M * FF * 2 <= WS_END, "ws map");
constexpr int CW_TMO = 0, CW_CODE = 1, CW_BAR = 4096;

constexpr int RING_OFF = 0, RING_BYTES = 131072;
constexpr int LDSCTL_OFF = RING_BYTES, MISC_OFF = LDSCTL_OFF + 320;
constexpr int LDS_BYTES = 147456;

struct Frame {
    LAS unsigned char* lds;
    volatile LAS unsigned* MISC;
    gu32* ctl;
    int tid, lane, wave;
    int vcu, G;
};

__device__ __forceinline__ float wave_sum(float v) {
#pragma unroll
    for (int o = 1; o < 64; o <<= 1) v += __shfl_xor(v, o);
    return v;
}
__device__ __forceinline__ void p0_transpose_item(const float* W, int ldw, int K, bf16* WT, int k0, int ncol0, int drow0, LAS float* scr, int lane) {
#pragma unroll 8
    for (int i = 0; i < 32; ++i) { const int kk = 2 * i + (lane >> 5); scr[kk * 33 + (lane & 31)] = W[(size_t)(k0 + kk) * ldw + ncol0 + (lane & 31)]; }
    LDS_WAIT(); asm volatile("" ::: "memory");
    const int c = lane & 7;
#pragma unroll
    for (int j = 0; j < 4; ++j) { const int n = (lane >> 3) + 8 * j; const LAS float* s = scr + (8 * c) * 33 + n;
        v4u o; o.x = pk2(s[0 * 33], s[1 * 33]); o.y = pk2(s[2 * 33], s[3 * 33]); o.z = pk2(s[4 * 33], s[5 * 33]); o.w = pk2(s[6 * 33], s[7 * 33]);
        *(GAS v4u*)(WT + (size_t)(drow0 + n) * K + k0 + 8 * c) = o; }
    LDS_WAIT(); asm volatile("" ::: "memory");
}
struct WJob { const float* W; int ldw, col0, K, N; bf16* WT; int glu_off; };
struct KArgs { const float* in[16]; float* out; unsigned char* ws; int ph_lo, ph_hi; };
__device__ __forceinline__ WJob wjob(const KArgs& a, bf16* wb, int j) {
    WJob r;
    if (j < 16) { const int l = j >> 3, k = j & 7; bf16* lw = wb + (size_t)l * W_LAYER;
        switch (k) {
        case 0: r = WJob{a.in[3] + (size_t)l * D * FF, FF, 0, D, FF, lw + W_GU, 0}; break;
        case 1: r = WJob{a.in[4] + (size_t)l * D * FF, FF, 0, D, FF, lw + W_GU, 128}; break;
        case 2: r = WJob{a.in[5] + (size_t)l * D * FF, D, 0, FF, D, lw + W_DN, -1}; break;
        case 3: r = WJob{a.in[6] + (size_t)l * D * FF, FF, 0, D, FF, lw + W_FFN + W_GU, 0}; break;
        case 4: r = WJob{a.in[7] + (size_t)l * D * FF, FF, 0, D, FF, lw + W_FFN + W_GU, 128}; break;
        case 5: r = WJob{a.in[8] + (size_t)l * D * FF, D, 0, FF, D, lw + W_FFN + W_DN, -1}; break;
        case 6: r = WJob{a.in[14] + (size_t)l * DPLE * D, D, 0, DPLE, D, lw + W_PP, -1}; break;
        default: r = WJob{a.in[15] + (size_t)l * D * D, D, 0, D, D, lw + W_PG, -1}; break;
        }
        return r; }
    switch (j) {
    case 16: r = WJob{a.in[9], 3 * D, 0, D, D, wb + W_CB, -1}; break;
    case 17: r = WJob{a.in[9], 3 * D, D, D, D, wb + W_CCH, 0}; break;
    case 18: r = WJob{a.in[9], 3 * D, 2 * D, D, D, wb + W_CCH, 128}; break;
    case 19: r = WJob{a.in[11], D, 0, D, D, wb + W_CO, -1}; break;
    case 20: r = WJob{a.in[12], 6144, 0, D, 6144, wb + W_RIN, -1}; break;
    default: r = WJob{a.in[13], D, 0, 2048, D, wb + W_ROUT, -1}; break;
    }
    return r;
}
constexpr int N_WJOBS = 22;

__device__ __forceinline__ void norm_rows(Frame& F, const float* hsrc, const float* xsrc, float* xdst, bf16* xn, const float* g_post, const float* g_next, float scale) {
    const int gw = F.vcu * NWAVES + F.wave, NGW = F.G * NWAVES;
    int lane = F.lane; asm volatile("" : "+v"(lane));
    f32x4 gp[4], gn[4];
#pragma unroll
    for (int j = 0; j < 4; ++j) { gp[j] = hsrc ? ((const f32x4*)g_post)[lane + 64 * j] : (f32x4){0.f, 0.f, 0.f, 0.f}; gn[j] = g_next ? ((const f32x4*)g_next)[lane + 64 * j] : (f32x4){0.f, 0.f, 0.f, 0.f}; }
    for (int m = gw; m < M; m += NGW) {
        const GAS f32x4* xr = (const GAS f32x4*)(xsrc + (size_t)m * D) + lane;
        f32x4 xv[4];
#pragma unroll
        for (int j = 0; j < 4; ++j) xv[j] = xr[64 * j];
        if (hsrc) {
            const GAS f32x4* hr = (const GAS f32x4*)(hsrc + (size_t)m * D) + lane; f32x4 hv[4]; float s = 0.f;
#pragma unroll
            for (int j = 0; j < 4; ++j) { hv[j] = hr[64 * j]; s += (hv[j].x * hv[j].x + hv[j].y * hv[j].y) + (hv[j].z * hv[j].z + hv[j].w * hv[j].w); }
            const float r1 = scale / sqrtf(wave_sum(s) * (1.f / D) + NORM_EPS);
            GAS f32x4* xo = (GAS f32x4*)(xdst + (size_t)m * D) + lane;
#pragma unroll
            for (int j = 0; j < 4; ++j) { xv[j] = xv[j] + hv[j] * gp[j] * r1; xo[64 * j] = xv[j]; }
        }
        if (g_next) {
            float s2 = 0.f;
#pragma unroll
            for (int j = 0; j < 4; ++j) s2 += (xv[j].x * xv[j].x + xv[j].y * xv[j].y) + (xv[j].z * xv[j].z + xv[j].w * xv[j].w);
            const float r2 = 1.f / sqrtf(wave_sum(s2) * (1.f / D) + NORM_EPS);
            GAS unsigned long long* o8 = (GAS unsigned long long*)(xn + (size_t)m * D) + lane;
#pragma unroll
            for (int j = 0; j < 4; ++j) { const f32x4 o = xv[j] * gn[j] * r2; o8[64 * j] = (unsigned long long)pk2(o.x, o.y) | ((unsigned long long)pk2(o.z, o.w) << 32); }
        }
    }
}

__device__ __forceinline__ void p0_prologue(Frame& F, const KArgs& a) {
    unsigned char* ws = a.ws;
    LAS float* scr = (LAS float*)(F.lds + RING_OFF + F.wave * 16384);
    const int gw = F.vcu * NWAVES + F.wave, NGW = F.G * NWAVES;
    bf16* wb = (bf16*)(ws + WS_W);
    for (int j = 0; j < N_WJOBS; ++j) {
        const WJob jb = wjob(a, wb, j); const int nblk = jb.N / 32, nitems = (jb.K / 64) * nblk;
        for (int it = gw; it < nitems; it += NGW) { const int kb = it / nblk, nb = it % nblk, n0 = 32 * nb;
            const int drow0 = jb.glu_off < 0 ? n0 : ((n0 >> 7) * 256 + jb.glu_off + (n0 & 127));
            p0_transpose_item(jb.W, jb.ldw, jb.K, jb.WT, 64 * kb, jb.col0 + n0, drow0, scr, F.lane); }
    }
    { const int gt = (F.vcu * NWAVES + F.wave) * 64 + F.lane, NGT = NGW * 64; const f32x4* src = (const f32x4*)a.in[1]; v4u* dst = (v4u*)(ws + WS_PB);
      for (int i = gt; i < 2 * M * DPLE / 8; i += NGT) { const f32x4 v0 = src[2 * i], v1 = src[2 * i + 1]; v4u o; o.x = pk2(v0.x, v0.y); o.y = pk2(v0.z, v0.w); o.z = pk2(v1.x, v1.y); o.w = pk2(v1.z, v1.w); dst[i] = o; }
      float* cs = (float*)(ws + WS_COS); float* sn = (float*)(ws + WS_SIN);
      for (int i = gt; i < SEQ * 128; i += NGT) { const int pos = i >> 7, fi = i & 127;
          const float inv = 1.0f / exp2f((float)fi * (13.287712379549449f / 127.0f)); const float ang = (float)pos * inv;
          double tr = (double)ang * 0.15915494309189535; tr -= __builtin_rint(tr); const float tf = (float)tr;
          cs[i] = __builtin_amdgcn_cosf(tf); sn[i] = __builtin_amdgcn_sinf(tf); }
    }
    norm_rows(F, nullptr, a.in[0], nullptr, (bf16*)(ws + WS_XN), nullptr, a.in[2] + FFN1_PRE * D, 1.f);
}

typedef short s16x4 __attribute__((ext_vector_type(4)));
typedef short v4i16_t __attribute__((ext_vector_type(4)));
typedef float f32x16 __attribute__((ext_vector_type(16)));
__device__ __forceinline__ s16x4 tr_rd(LAS unsigned char* p) { return __builtin_bit_cast(s16x4, __builtin_amdgcn_ds_read_tr16_b64_v4i16((LAS v4i16_t*)p)); }
__device__ __forceinline__ bf16x8 cat8(const s16x4 a, const s16x4 b) { return (bf16x8){a[0], a[1], a[2], a[3], b[0], b[1], b[2], b[3]}; }
__device__ __forceinline__ unsigned cvtpk(float lo, float hi) { unsigned r; asm volatile("v_cvt_pk_bf16_f32 %0, %1, %2" : "=v"(r) : "v"(lo), "v"(hi)); return r; }

__device__ __forceinline__ void ret_core_unit(LAS unsigned char* lds, const bf16* Qg, const bf16* Kg, bf16* Vg, float* ssq, int b, int h, int es, int tid_in, int lane_in, int w) {
    int tid = tid_in, lane = lane_in; asm volatile("" : "+v"(tid), "+v"(lane));
    const int c16 = lane & 15, q = lane >> 4, r32 = lane & 31, hh = lane >> 5, blk = (lane >> 4) & 1, qq = c16 >> 2, pp = c16 & 3;
    const float lg = __builtin_amdgcn_logf(1.0f - __builtin_amdgcn_exp2f(-5.0f - (float)h));
    const float cd = __builtin_amdgcn_exp2f(lg * 128.0f);
    const float fi = __builtin_amdgcn_exp2f(lg * (float)(16 * w + c16 - 127));
    float qd[4];
#pragma unroll
    for (int r = 0; r < 4; ++r) qd[r] = __builtin_amdgcn_exp2f(lg * (float)(16 * w + 4 * q + r + 1));
    const size_t rowbase = (size_t)b * SEQ;
    const bf16* Qh = Qg + rowbase * 1024 + h * 256;
    const bf16* Kh = Kg + rowbase * 1024 + h * 256;
    bf16* Vh = Vg + rowbase * 2048 + h * 512 + es * 64;
    LAS unsigned char* ldK = lds + RET_LDS_K; LAS unsigned char* ldV = lds + RET_LDS_V; LAS unsigned char* ldS = lds + RET_LDS_S;
    unsigned rx[4], kt[2], vt[2][2], vdx[4], st[4], kst_a, vst_a;
    { const unsigned rbase = 256u * c16 + 16u * (q ^ ((c16 >> 2) & 3)), sig64 = 64u * (c16 & 3);
#pragma unroll
      for (int k = 0; k < 4; ++k) { rx[k] = rbase + ((64u * k) ^ sig64); asm volatile("" : "+v"(rx[k])); }
      const unsigned L = (2 * blk + (pp >> 1)) ^ (2 * hh);
#pragma unroll
      for (int t = 0; t < 2; ++t) { kt[t] = 256u * (8 * hh + qq) + 8u * (pp & 1) + 32768u * (w >> 2) + 64u * ((w & 3) ^ qq) + 1024u * t + 16u * (L ^ t); asm volatile("" : "+v"(kt[t])); }
      const unsigned vb = 128u * (8 * hh + qq) + 16u * ((pp >> 1) ^ (qq >> 1)) + 8u * (pp & 1);
#pragma unroll
      for (int eb = 0; eb < 2; ++eb)
#pragma unroll
          for (int t = 0; t < 2; ++t) { vt[eb][t] = vb + 512u * t + 64u * (eb ^ hh) + 32u * (blk ^ t); asm volatile("" : "+v"(vt[eb][t])); }
      const unsigned vd = 128u * (4 * q + qq) + 16u * ((pp >> 1) ^ (qq >> 1)) + 8u * (pp & 1);
#pragma unroll
      for (int cc = 0; cc < 4; ++cc) { vdx[cc] = vd + 32u * (cc ^ q); asm volatile("" : "+v"(vdx[cc])); }
      const unsigned ssb = 256u * r32 + 8u * hh + 64u * ((w & 3) ^ (r32 & 3)) + 16384u * (w >> 2);
#pragma unroll
      for (int g = 0; g < 4; ++g) { st[g] = ssb + 16u * (g ^ ((r32 >> 2) & 3)); asm volatile("" : "+v"(st[g])); }
      kst_a = koff(tid >> 5, (tid & 31) * 8); vst_a = voff(tid >> 3, (tid & 7) * 8); asm volatile("" : "+v"(kst_a), "+v"(vst_a));
    }
    f32x16 S0, S1;
#pragma unroll
    for (int r = 0; r < 16; ++r) { S0[r] = 0.f; S1[r] = 0.f; }
    v4u kst[8], vst[2]; bf16x8 qf[8];
    const bf16* kgp = Kh + (size_t)(tid >> 5) * 1024 + (tid & 31) * 8;
    const bf16* vgp = Vh + (size_t)(tid >> 3) * 2048 + (tid & 7) * 8;
    const bf16* qgp = Qh + (size_t)(16 * w + c16) * 1024 + 8 * q;
#define RET_LOAD_KV(c) do { const size_t t0_ = (size_t)(c) * CHUNK; \
        _Pragma("unroll") for (int n = 0; n < 8; ++n) kst[n] = *(const GAS v4u*)(kgp + (t0_ + 16 * n) * 1024); \
        _Pragma("unroll") for (int n = 0; n < 2; ++n) vst[n] = *(const GAS v4u*)(vgp + (t0_ + 64 * n) * 2048); } while (0)
#define RET_STORE_KV() do { \
        _Pragma("unroll") for (int n = 0; n < 8; ++n) *(LAS v4u*)(ldK + kst_a + 4096 * n) = kst[n]; \
        _Pragma("unroll") for (int n = 0; n < 2; ++n) *(LAS v4u*)(ldV + vst_a + 8192 * n) = vst[n]; } while (0)
#define RET_LOAD_Q(c) do { const size_t t0_ = (size_t)(c) * CHUNK; \
        _Pragma("unroll") for (int ks = 0; ks < 8; ++ks) qf[ks] = *(const GAS bf16x8*)(qgp + t0_ * 1024 + 32 * ks); } while (0)
#define RET_STORE_S() do { \
        _Pragma("unroll") for (int g = 0; g < 4; ++g) { \
            unsigned long long v0 = (unsigned long long)cvtpk(S0[4 * g], S0[4 * g + 1]) | ((unsigned long long)cvtpk(S0[4 * g + 2], S0[4 * g + 3]) << 32); \
            unsigned long long v1 = (unsigned long long)cvtpk(S1[4 * g], S1[4 * g + 1]) | ((unsigned long long)cvtpk(S1[4 * g + 2], S1[4 * g + 3]) << 32); \
            *(LAS unsigned long long*)(ldS + st[g]) = v0; *(LAS unsigned long long*)(ldS + st[g] + 8192) = v1; } } while (0)
    RET_LOAD_KV(0); RET_LOAD_Q(0);
    RET_STORE_S();
    RET_STORE_KV();
    RET_LOAD_KV(1);
    __syncthreads();
    for (int c = 0; c < NCHUNK; ++c) {
        const int t0 = c * CHUNK;
        f32x4 O[4];
#pragma unroll
        for (int cc = 0; cc < 4; ++cc) O[cc] = (f32x4){0.f, 0.f, 0.f, 0.f};
#pragma unroll
        for (int ks = 0; ks < 8; ++ks)
#pragma unroll
            for (int cc = 0; cc < 4; ++cc) { const bf16x8 sb = *(const LAS bf16x8*)(ldS + rx[ks & 3] + (4096 * cc + 16384 * (ks >> 2))); O[cc] = __builtin_amdgcn_mfma_f32_16x16x32_bf16(qf[ks], sb, O[cc], 0, 0, 0); }
#pragma unroll
        for (int cc = 0; cc < 4; ++cc)
#pragma unroll
            for (int r = 0; r < 4; ++r) O[cc][r] *= qd[r];
        f32x4 X[8];
#pragma unroll
        for (int jb = 0; jb < 8; ++jb) { X[jb] = (f32x4){0.f, 0.f, 0.f, 0.f};
            if (jb <= w) {
#pragma unroll
                for (int ks = 0; ks < 8; ++ks) { const bf16x8 ka = *(const LAS bf16x8*)(ldK + rx[ks & 3] + (4096 * jb + 32768 * (ks >> 2))); X[jb] = __builtin_amdgcn_mfma_f32_16x16x32_bf16(ka, qf[ks], X[jb], 0, 0, 0); }
#pragma unroll
                for (int r = 0; r < 4; ++r) { float v = X[jb][r] * fi; if (jb == w && 4 * q + r > c16) v = 0.f; X[jb][r] = v; }
            } }
        if (c + 1 < NCHUNK) RET_LOAD_Q(c + 1);
#pragma unroll
        for (int s = 0; s < 4; ++s) {
            if (2 * s <= w) {
                v4u aw; aw.x = cvtpk(X[2 * s][0], X[2 * s][1]); aw.y = cvtpk(X[2 * s][2], X[2 * s][3]); aw.z = cvtpk(X[2 * s + 1][0], X[2 * s + 1][1]); aw.w = cvtpk(X[2 * s + 1][2], X[2 * s + 1][3]);
                const bf16x8 af = __builtin_bit_cast(bf16x8, aw);
#pragma unroll
                for (int cc = 0; cc < 4; ++cc) { const s16x4 b0 = tr_rd(ldV + vdx[cc] + 4096 * s), b1 = tr_rd(ldV + vdx[cc] + (4096 * s + 2048));
                    O[cc] = __builtin_amdgcn_mfma_f32_16x16x32_bf16(af, cat8(b0, b1), O[cc], 0, 0, 0); }
            } }
        {
            bf16* orow = Vh + (size_t)(t0 + 16 * w + 4 * q) * 2048 + c16; float* srow = ssq + ((rowbase + t0 + 16 * w + 4 * q) * 4 + h) * 8 + es;
#pragma unroll
            for (int r = 0; r < 4; ++r) { float sq = 0.f;
#pragma unroll
                for (int cc = 0; cc < 4; ++cc) { sq += O[cc][r] * O[cc][r]; orow[(size_t)r * 2048 + 16 * cc] = (bf16)f2bf(O[cc][r]); }
                sq += __shfl_xor(sq, 1); sq += __shfl_xor(sq, 2); sq += __shfl_xor(sq, 4); sq += __shfl_xor(sq, 8);
                if (c16 == 0) srow[r * 32] = sq; }
        }
        if (c + 1 < NCHUNK) {
#pragma unroll
            for (int r = 0; r < 16; ++r) { S0[r] *= cd; S1[r] *= cd; }
#pragma unroll
            for (int ks = 0; ks < 8; ++ks) {
                const s16x4 a0 = tr_rd(ldK + kt[0] + 4096 * ks), a1 = tr_rd(ldK + kt[1] + 4096 * ks);
                const s16x4 b00 = tr_rd(ldV + vt[0][0] + 2048 * ks), b01 = tr_rd(ldV + vt[0][1] + 2048 * ks);
                const s16x4 b10 = tr_rd(ldV + vt[1][0] + 2048 * ks), b11 = tr_rd(ldV + vt[1][1] + 2048 * ks);
                const bf16x8 af = cat8(a0, a1);
                S0 = __builtin_amdgcn_mfma_f32_32x32x16_bf16(af, cat8(b00, b01), S0, 0, 0, 0);
                S1 = __builtin_amdgcn_mfma_f32_32x32x16_bf16(af, cat8(b10, b11), S1, 0, 0, 0);
            }
        }
        __syncthreads();
        if (c + 1 < NCHUNK) {
            RET_STORE_S();
            RET_STORE_KV();
            if (c + 2 < NCHUNK) RET_LOAD_KV(c + 2);
        }
        __syncthreads();
    }
#undef RET_LOAD_KV
#undef RET_STORE_KV
#undef RET_LOAD_Q
#undef RET_STORE_S
}
__device__ __forceinline__ void ret_core_phase(Frame& F, unsigned char* ws) {
    for (int unit = F.vcu; unit < BATCH * NHEAD * 8; unit += F.G)
        ret_core_unit(F.lds + RING_OFF, (const bf16*)(ws + WS_Q), (const bf16*)(ws + WS_K), (bf16*)(ws + WS_V), (float*)(ws + WS_SSQ), unit >> 5, (unit >> 3) & 3, unit & 7, F.tid, F.lane, F.wave);
}

__global__ void __launch_bounds__(NWAVES * 64, 2) hybrid_fwd(KArgs args) {
    extern __shared__ __attribute__((aligned(16))) unsigned char lds[];
    Frame F;
    F.lds = (LAS unsigned char*)lds;
    F.MISC = (volatile LAS unsigned*)(F.lds + MISC_OFF);
    F.tid = threadIdx.x; F.lane = F.tid & 63; F.wave = __builtin_amdgcn_readfirstlane(F.tid >> 6);
    F.G = gridDim.x; { const int bx = blockIdx.x; F.vcu = (F.G % 8 == 0) ? (bx % 8) * (F.G / 8) + bx / 8 : bx; }
    unsigned char* ws = args.ws;
    F.ctl = (gu32*)(ws + WS_CTL);
    for (int u = F.tid; u < (LDS_BYTES - LDSCTL_OFF) / 4; u += NWAVES * 64) ((LAS unsigned*)(F.lds + LDSCTL_OFF))[u] = 0u;
    __syncthreads();
#if MK_PER_PHASE
#define GRID_BAR() do { } while (0)
#else
    XcdBarrier bar = xcd_barrier_post((unsigned*)(F.ctl + CW_BAR), F.MISC + 8);
#define GRID_BAR() xcd_barrier(bar)
#endif
    const int lo = args.ph_lo, hi = args.ph_hi; int ph = 0;
#ifndef SITES
#define SITES 0xFFFFFFFF
#endif
#define PH_BEGIN if (lo <= ph && ph < hi) {
#define PH_END if (ph + 1 < hi) GRID_BAR(); } ++ph;
    bf16* const wb = (bf16*)(ws + WS_W);
    bf16* const XN = (bf16*)(ws + WS_XN); float* const HB = (float*)(ws + WS_HBUF); bf16* const HID = (bf16*)(ws + WS_BIG);
    const float* const gains = args.in[2];

    PH_BEGIN
#if (SITES >> 0) & 1
 p0_prologue(F, args);
#endif
PH_END

    _Pragma("nounroll") for (int l = 0; l < 2; ++l) {
        bf16* const lw = wb + (size_t)l * W_LAYER; const float* const g = gains + (size_t)l * 8 * D;
        _Pragma("nounroll") for (int f = 0; f < 2; ++f) {
            bf16* const fw = lw + (size_t)f * W_FFN;
            PH_BEGIN
#if (SITES >> 1) & 1
 { pg8::Gemm gm{XN, fw + W_GU, M, 2 * FF, D}; pg8::StaticOrder S; S.init(M, 2 * FF, F.G, (int)blockIdx.x); pg8::EpiGLU<1> E{HID, FF};
                pg8::gemm_phase<pg8::EpiGLU<1>, pg8::StaticOrder, PG8_ALIGN, PG8_SP2>(F.lds + RING_OFF, gm, S, E); }
#endif
PH_END
            PH_BEGIN
#if (SITES >> 2) & 1
 { pg8::Gemm gm{HID, fw + W_DN, M, D, FF}; pg8::StaticOrder S; S.init(M, D, F.G, (int)blockIdx.x); pg8::EpiF32 E{HB, D};
                pg8::gemm_phase<pg8::EpiF32, pg8::StaticOrder, PG8_ALIGN, PG8_SP2>(F.lds + RING_OFF, gm, S, E); }
#endif
PH_END
            PH_BEGIN
#if (SITES >> 3) & 1
 norm_rows(F, HB, (l == 0 && f == 0) ? args.in[0] : args.out, args.out, XN, g + (f ? FFN2_POST : FFN1_POST) * D, g + (f ? PLE_PRE : MIX_PRE) * D, 0.5f);
#endif
PH_END
            if (f == 0) {
                if (l == 0) {
                    PH_BEGIN
#if (SITES >> 4) & 1
 { pg8::Gemm gm{XN, wb + W_CCH, M, 2 * D, D}; pg8::StaticOrder S; S.init(M, 2 * D, F.G, (int)blockIdx.x); pg8::EpiGLU<0> E{(bf16*)(ws + WS_U), D};
                        pg8::gemm_phase<pg8::EpiGLU<0>, pg8::StaticOrder, PG8_ALIGN, PG8_SP2>(F.lds + RING_OFF, gm, S, E); }
#endif
PH_END
                    PH_BEGIN
#if (SITES >> 5) & 1
 { pg8::Gemm gm{XN, wb + W_CB, M, D, D}; pg8::StaticOrder S; S.init(M, D, F.G, (int)blockIdx.x); pg8::EpiConv E{(bf16*)(ws + WS_AB), (const bf16*)(ws + WS_U), args.in[10], D, SEQ};
                        pg8::gemm_phase<pg8::EpiConv, pg8::StaticOrder, PG8_ALIGN, PG8_SP2>(F.lds + RING_OFF, gm, S, E); }
#endif
PH_END
                    PH_BEGIN
#if (SITES >> 6) & 1
 { pg8::Gemm gm{(const bf16*)(ws + WS_AB), wb + W_CO, M, D, D}; pg8::StaticOrder S; S.init(M, D, F.G, (int)blockIdx.x); pg8::EpiF32 E{HB, D};
                        pg8::gemm_phase<pg8::EpiF32, pg8::StaticOrder, PG8_ALIGN, PG8_SP2>(F.lds + RING_OFF, gm, S, E); }
#endif
PH_END
                } else {
                    PH_BEGIN
#if (SITES >> 7) & 1
 { pg8::Gemm gm{XN, wb + W_RIN, M, 2048, D}; pg8::StaticOrder S; S.init(M, 2048, F.G, (int)blockIdx.x);
                        pg8::EpiRetQK E{(bf16*)(ws + WS_Q), (bf16*)(ws + WS_K), (const float*)(ws + WS_COS), (const float*)(ws + WS_SIN), SEQ};
                        pg8::gemm_phase<pg8::EpiRetQK, pg8::StaticOrder, PG8_ALIGN, PG8_SP2>(F.lds + RING_OFF, gm, S, E); }
#endif
PH_END
                    PH_BEGIN
#if (SITES >> 16) & 1
 { pg8::Gemm gm{XN, wb + W_RIN + (size_t)2048 * D, M, 2048, D}; pg8::StaticOrder S; S.init(M, 2048, F.G, (int)blockIdx.x);
                        pg8::EpiRetV E{(bf16*)(ws + WS_V)};
                        pg8::gemm_phase<pg8::EpiRetV, pg8::StaticOrder, PG8_ALIGN, PG8_SP2>(F.lds + RING_OFF, gm, S, E); }
#endif
PH_END
                    PH_BEGIN
#if (SITES >> 8) & 1
 ret_core_phase(F, ws);
#endif
PH_END
                    PH_BEGIN
#if (SITES >> 9) & 1
 { pg8::Gemm gm{XN, wb + W_RIN + (size_t)NRQKV * D, M, 2048, D}; pg8::StaticOrder S; S.init(M, 2048, F.G, (int)blockIdx.x); pg8::EpiRetGate E{(bf16*)(ws + WS_V), (const float*)(ws + WS_SSQ), NORM_EPS};
                        pg8::gemm_phase<pg8::EpiRetGate, pg8::StaticOrder, PG8_ALIGN, PG8_SP2>(F.lds + RING_OFF, gm, S, E); }
#endif
PH_END
                    PH_BEGIN
#if (SITES >> 10) & 1
 { pg8::Gemm gm{(const bf16*)(ws + WS_V), wb + W_ROUT, M, D, 2048}; pg8::StaticOrder S; S.init(M, D, F.G, (int)blockIdx.x); pg8::EpiF32 E{HB, D};
                        pg8::gemm_phase<pg8::EpiF32, pg8::StaticOrder, PG8_ALIGN, PG8_SP2>(F.lds + RING_OFF, gm, S, E); }
#endif
PH_END
                }
                PH_BEGIN
#if (SITES >> 11) & 1
 norm_rows(F, HB, args.out, args.out, XN, g + MIX_POST * D, g + FFN2_PRE * D, 1.0f);
#endif
PH_END
            } else {
                PH_BEGIN
#if (SITES >> 12) & 1
 { pg8::Gemm gm{XN, lw + W_PG, M, D, D}; pg8::StaticOrder S; S.init(M, D, F.G, (int)blockIdx.x); pg8::EpiF32 E{HB, D};
                    pg8::gemm_phase<pg8::EpiF32, pg8::StaticOrder, PG8_ALIGN, PG8_SP2>(F.lds + RING_OFF, gm, S, E); }
#endif
PH_END
                PH_BEGIN
#if (SITES >> 13) & 1
 { pg8::Gemm gm{(const bf16*)(ws + WS_PB) + (size_t)l * M * DPLE, lw + W_PP, M, D, DPLE}; pg8::StaticOrder S; S.init(M, D, F.G, (int)blockIdx.x); pg8::EpiMulSig E{HB, D};
                    pg8::gemm_phase<pg8::EpiMulSig, pg8::StaticOrder, PG8_ALIGN, PG8_SP2>(F.lds + RING_OFF, gm, S, E); }
#endif
PH_END
                PH_BEGIN
#if (SITES >> 14) & 1
 norm_rows(F, HB, args.out, args.out, XN, g + PLE_POST * D, (l == 0) ? gains + (size_t)8 * D + FFN1_PRE * D : nullptr, 1.0f);
#endif
PH_END
            }
        }
    }
#undef PH_BEGIN
#undef PH_END
}
constexpr int N_PHASES = 29;

extern "C" void kernel_launch(void* const* d_in, const int* in_sizes, int n_in, void* d_out, int out_size, void* d_ws, size_t ws_size, hipStream_t stream) {
    static int grid = 0;
    if (grid == 0) {
        if (n_in != 16 || in_sizes[0] != M * D || out_size != M * D || ws_size < WS_END) { fprintf(stderr, "kernel_launch: unexpected shapes / workspace (n_in %d, in0 %d, out %d, ws %zu, need %zu)\n", n_in, n_in > 0 ? in_sizes[0] : -1, out_size, ws_size, (size_t)WS_END); grid = -1; return; }
        int dev = 0, cus = 0;
        if (hipGetDevice(&dev) != hipSuccess || hipDeviceGetAttribute(&cus, hipDeviceAttributeMultiprocessorCount, dev) != hipSuccess) { grid = -1; return; }
        if (hipFuncSetAttribute((const void*)hybrid_fwd, hipFuncAttributeMaxDynamicSharedMemorySize, LDS_BYTES) != hipSuccess) { fprintf(stderr, "kernel_launch: hipFuncSetAttribute failed\n"); grid = -1; return; }
        int per_cu = 0;
        if (hipOccupancyMaxActiveBlocksPerMultiprocessor(&per_cu, (const void*)hybrid_fwd, NWAVES * 64, LDS_BYTES) != hipSuccess || per_cu < 1) fprintf(stderr, "kernel_launch: occupancy query reports %d\n", per_cu);
        (void)hipGetLastError();
        grid = cus;
    }
    if (grid < 0) return;
    if (hipMemsetAsync((char*)d_ws + WS_CTL, 0, CTL_ZERO_BYTES, stream) != hipSuccess) return;
    KArgs a{};
    for (int i = 0; i < 16; ++i) a.in[i] = (const float*)d_in[i];
    a.out = (float*)d_out; a.ws = (unsigned char*)d_ws;
#if MK_PER_PHASE
    for (int ph = 0; ph < N_PHASES; ++ph) { a.ph_lo = ph; a.ph_hi = ph + 1; hipLaunchKernelGGL(hybrid_fwd, dim3(grid), dim3(NWAVES * 64), LDS_BYTES, stream, a); }
#else
    a.ph_lo = 0; a.ph_hi = N_PHASES; hipLaunchKernelGGL(hybrid_fwd, dim3(grid), dim3(NWAVES * 64), LDS_BYTES, stream, a);
#endif
}
```

```cpp
#include <hip/hip_runtime.h>
#include <cstdio>
#include <cstdint>
#define EPI_WS_XB ((size_t)138 << 20)
#define EPI_WS_RS ((size_t)1 << 20)
#define EPI_WS_GATE ((size_t)202 << 20)
#define EPI_WS_XBUF ((size_t)506 << 20)
#define EPI_LDV 2816
#ifndef PG8_PAIR
#define PG8_PAIR 0
#endif
#ifndef PG8_XROT
#define PG8_XROT 1
#endif
#ifndef PG8_LATE_STAGE
#define PG8_LATE_STAGE 0
#endif
#ifndef PG8_ASM_STAGE
#define PG8_ASM_STAGE 1
#endif
namespace pg8 {
#define PG8_LAS __attribute__((address_space(3)))
#define PG8_GAS __attribute__((address_space(1)))
typedef unsigned short bf16_t;
typedef short bf16x8 __attribute__((ext_vector_type(8)));
typedef float f32x4 __attribute__((ext_vector_type(4)));
typedef unsigned u32x4 __attribute__((ext_vector_type(4)));
typedef int i32x4 __attribute__((ext_vector_type(4)));
constexpr int BM = 256, BK = 64, HALF = 128, HTB = HALF * BK * 2  , STAGE_BYTES = 8 * HTB, NXCD = 8, WGM = 8;

__host__ __device__ __forceinline__ int lds_byte(int r, int c) { const int st = (r >> 4) * 2 + (c >> 5), rr = r & 15, cc = c & 31, ob = rr * 64 + cc * 2; return st * 1024 + (ob ^ (((ob >> 9) & 1) << 5)); }
__host__ __device__ __forceinline__ void stage_rc(int b, int& R, int& C) { const int st = b / 1024, sb = b % 1024, swz = sb ^ (((sb >> 9) & 1) << 5); R = (st >> 1) * 16 + swz / 64; C = (st & 1) * 32 + (swz % 64) / 2; }
__host__ __device__ __forceinline__ int perm32(int rho) { const int n = rho >> 4, i = rho & 15; return 8 * (i >> 2) + 4 * n + (i & 3); }

struct Unit { int pm, pn; };
struct Gemm { const bf16_t* A; const bf16_t* Bt; int M, N, K; int lda = 0; };

struct StaticOrder {
    int nM, nN, nwg, G, c;
    __host__ __device__ void init(int M, int N, int G_, int c_) { nM = M / BM; nN = N / BM; nwg = nM * nN; G = G_; c = c_; }
    __host__ __device__ bool next(int i, Unit& u) const {
        if (PG8_PAIR && G == 256 && nM == 128 && (nN & 1) == 0) { const int k = c >> 6, p0 = 16 * (c & 7) + ((c >> 3) & 7), nper = nN >> 2;
            if (i < 2 * nper) { u.pm = p0 + 8 * (i & 1); u.pn = k + 4 * (i >> 1); return true; }
            if ((nN & 3) == 2 && i == 2 * nper) { u.pm = p0 + 8 * (k & 1); u.pn = 4 * nper + (k >> 1); return true; }
            return false; }
        if (PG8_XROT && G == 256 && nM == 128 && nwg % G == 0) { const int rounds = nwg / G; if (i >= rounds) return false; i = (i + (c & 7)) % rounds; }
        const long L = (long)i * G + c; if (L >= nwg) return false;
        int wgid = (int)L; { const int q = nwg / NXCD, r = nwg % NXCD, xcd = wgid % NXCD, off = wgid / NXCD; wgid = (xcd < r ? xcd * (q + 1) : r * (q + 1) + (xcd - r) * q) + off; }
        const int nig = WGM * nN, gid = wgid / nig, fm = gid * WGM, gsz = (nM - fm) < WGM ? (nM - fm) : WGM;
        u.pm = fm + ((wgid % nig) % gsz); u.pn = (wgid % nig) / gsz; return true;
    }
    __device__ __forceinline__ void a_ready(const Unit&) const {}
    __device__ __forceinline__ void done(const Unit&) const {}
};

__device__ __forceinline__ unsigned cvt_pk_bf16(float lo, float hi) { unsigned r; asm volatile("v_cvt_pk_bf16_f32 %0, %1, %2" : "=v"(r) : "v"(lo), "v"(hi)); return r; }
typedef float f32x2 __attribute__((ext_vector_type(2)));
__device__ __forceinline__ float sigmoid_f(float v) { return __builtin_amdgcn_rcpf(1.0f + __builtin_amdgcn_exp2f(v * -1.4426950408889634f)); }
__device__ __forceinline__ u32x4 pack8(const f32x4 a, const f32x4 b) { u32x4 w; w.x = cvt_pk_bf16(a[0], a[1]); w.y = cvt_pk_bf16(a[2], a[3]); w.z = cvt_pk_bf16(b[0], b[1]); w.w = cvt_pk_bf16(b[2], b[3]); return w; }
__device__ __forceinline__ f32x4 bf4_lo(const u32x4 w) { return (f32x4){__uint_as_float(w.x << 16), __uint_as_float(w.x & 0xffff0000u), __uint_as_float(w.y << 16), __uint_as_float(w.y & 0xffff0000u)}; }
__device__ __forceinline__ f32x4 bf4_hi(const u32x4 w) { return (f32x4){__uint_as_float(w.z << 16), __uint_as_float(w.z & 0xffff0000u), __uint_as_float(w.w << 16), __uint_as_float(w.w & 0xffff0000u)}; }

struct EpiNull {
    static constexpr bool PERM = true, AFTER_DRAIN = false;
    float* sink;
    __device__ __forceinline__ void operator()(const f32x4 (&acc)[2][2][4][2], const Unit& u, int wr, int wc, int fr, int fq) const {
        float s = 0.f;
#pragma unroll
        for (int ai = 0; ai < 2; ++ai)
#pragma unroll
            for (int bj = 0; bj < 2; ++bj)
#pragma unroll
                for (int m = 0; m < 4; ++m)
#pragma unroll
                    for (int n = 0; n < 2; ++n) s += acc[ai][bj][m][n][0] + acc[ai][bj][m][n][1] + acc[ai][bj][m][n][2] + acc[ai][bj][m][n][3];
        if (s == 1.2345e30f) ((PG8_GAS float*)sink)[0] = s;
    }
};
struct EpiF32S {
    static constexpr bool PERM = false, AFTER_DRAIN = false;
    float* C; int ldc; const float* rs;
    __device__ __forceinline__ void operator()(const f32x4 (&acc)[2][2][4][2], const Unit& u, int wr, int wc, int fr, int fq) const {
        const int row0 = u.pm * BM + wr * 64 + fr, col0 = u.pn * BM + wc * 32 + 4 * fq;
#pragma unroll
        for (int ai = 0; ai < 2; ++ai)
#pragma unroll
            for (int m = 0; m < 4; ++m) { const int row = row0 + ai * HALF + m * 16; const float r = ((const PG8_GAS float*)rs)[row]; float* rowp = C + (size_t)row * ldc + col0;
#pragma unroll
                for (int bj = 0; bj < 2; ++bj)
#pragma unroll
                    for (int n = 0; n < 2; ++n) *(PG8_GAS f32x4*)(rowp + bj * HALF + n * 16) = acc[ai][bj][m][n] * r; }
    }
};
template <int MODE> struct EpiH {
    static constexpr bool PERM = true, AFTER_DRAIN = false;
    bf16_t* O; int ldc; const float* rs;
    __device__ __forceinline__ void operator()(const f32x4 (&acc)[2][2][4][2], const Unit& u, int wr, int wc, int fr, int fq) const {
        const int row0 = u.pm * BM + wr * 64 + fr, col0 = u.pn * BM + wc * 32 + 8 * fq;
#pragma unroll
        for (int ai = 0; ai < 2; ++ai)
#pragma unroll
            for (int m = 0; m < 4; ++m) { const int row = row0 + ai * HALF + m * 16; bf16_t* rowp = O + (size_t)row * ldc + col0; const float r = (MODE == 1) ? ((const PG8_GAS float*)rs)[row] : 1.0f;
#pragma unroll
                for (int bj = 0; bj < 2; ++bj) { f32x4 v0 = acc[ai][bj][m][0], v1 = acc[ai][bj][m][1];
                    if (MODE == 1) { v0 = v0 * r; v1 = v1 * r; }
                    if (MODE == 2) { const u32x4 gw = *(const PG8_GAS u32x4*)(rowp + bj * HALF); const f32x4 g0 = bf4_lo(gw), g1 = bf4_hi(gw);
#pragma unroll
                        for (int x = 0; x < 4; ++x) { v0[x] *= sigmoid_f(g0[x]); v1[x] *= sigmoid_f(g1[x]); } }
                    *(PG8_GAS u32x4*)(rowp + bj * HALF) = pack8(v0, v1); }
                if (MODE == 2) asm volatile("" ::: "memory"); }
    }
};
template <int ACT  > struct EpiGLU {
    static constexpr bool PERM = true, AFTER_DRAIN = false;
    bf16_t* O; int ldc; const float* rs;
    __device__ __forceinline__ void operator()(const f32x4 (&acc)[2][2][4][2], const Unit& u, int wr, int wc, int fr, int fq) const {
        const int row0 = u.pm * BM + wr * 64 + fr, col0 = u.pn * HALF + wc * 32 + 8 * fq;
#pragma unroll
        for (int ai = 0; ai < 2; ++ai)
#pragma unroll
            for (int m = 0; m < 4; ++m) { const int row = row0 + ai * HALF + m * 16; const float r = ((const PG8_GAS float*)rs)[row]; bf16_t* rowp = O + (size_t)row * ldc + col0; f32x4 v[2];
#pragma unroll
                for (int n = 0; n < 2; ++n) { const f32x4 a = acc[ai][0][m][n] * r, b = acc[ai][1][m][n] * r;
#pragma unroll
                    for (int x = 0; x < 4; ++x) v[n][x] = (ACT ? a[x] * sigmoid_f(a[x]) : a[x]) * b[x]; }
                *(PG8_GAS u32x4*)rowp = pack8(v[0], v[1]); }
    }
};
struct EpiGLUq {
    static constexpr bool PERM = true, AFTER_DRAIN = false;
    bf16_t* O; int ldc; const float* ra; const float* cw;
    static constexpr bool HAS_PRE = true;
    struct Pre { f32x4 cg[2], cu[2]; float rv[2][4]; };
    __device__ __forceinline__ Pre preload(const Unit& u, int wr, int wc, int fr, int fq) const {
        const int row0 = u.pm * BM + wr * 64 + fr, wcol0 = u.pn * BM + wc * 32 + 8 * fq; Pre P;
#pragma unroll
        for (int n = 0; n < 2; ++n) { P.cg[n] = *(const PG8_GAS f32x4*)(cw + wcol0 + 4 * n); P.cu[n] = *(const PG8_GAS f32x4*)(cw + wcol0 + HALF + 4 * n); }
#pragma unroll
        for (int ai = 0; ai < 2; ++ai)
#pragma unroll
            for (int m = 0; m < 4; ++m) P.rv[ai][m] = ((const PG8_GAS float*)ra)[row0 + ai * HALF + m * 16];
        return P;
    }
    __device__ __forceinline__ void operator()(const f32x4 (&acc)[2][2][4][2], const Unit& u, int wr, int wc, int fr, int fq) const { (*this)(acc, u, wr, wc, fr, fq, preload(u, wr, wc, fr, fq)); }
    __device__ __forceinline__ void operator()(const f32x4 (&acc)[2][2][4][2], const Unit& u, int wr, int wc, int fr, int fq, const Pre& P) const {
        const int row0 = u.pm * BM + wr * 64 + fr, col0 = u.pn * HALF + wc * 32 + 8 * fq;
        f32x2 kl[2][2], kk[2][2];
#pragma unroll
        for (int n = 0; n < 2; ++n) { const f32x4 cg = P.cg[n], cu = P.cu[n];
#pragma unroll
            for (int h = 0; h < 2; ++h) { kl[n][h] = (f32x2){cg[2 * h] * -1.4426950408889634f, cg[2 * h + 1] * -1.4426950408889634f}; kk[n][h] = (f32x2){cg[2 * h] * cu[2 * h], cg[2 * h + 1] * cu[2 * h + 1]}; } }
        float rv[2][4];
#pragma unroll
        for (int ai = 0; ai < 2; ++ai)
#pragma unroll
            for (int m = 0; m < 4; ++m) rv[ai][m] = P.rv[ai][m];
#pragma unroll
        for (int ai = 0; ai < 2; ++ai)
#pragma unroll
            for (int m = 0; m < 4; ++m) { const int row = row0 + ai * HALF + m * 16; const float r = rv[ai][m], r2 = r * r; bf16_t* rowp = O + (size_t)row * ldc + col0;
                f32x2 fa[4], fb[4], e[4], q[4];
#pragma unroll
                for (int n = 0; n < 2; ++n) { const i32x4 ia = __builtin_bit_cast(i32x4, acc[ai][0][m][n]), ib = __builtin_bit_cast(i32x4, acc[ai][1][m][n]);
#pragma unroll
                    for (int h = 0; h < 2; ++h) { fa[2 * n + h] = (f32x2){(float)ia[2 * h], (float)ia[2 * h + 1]}; fb[2 * n + h] = (f32x2){(float)ib[2 * h], (float)ib[2 * h + 1]}; } }
#pragma unroll
                for (int j = 0; j < 4; ++j) { const f32x2 t = fa[j] * (kl[j >> 1][j & 1] * r); e[j] = (f32x2){__builtin_amdgcn_exp2f(t.x), __builtin_amdgcn_exp2f(t.y)}; }
#pragma unroll
                for (int j = 0; j < 4; ++j) { q[j] = (fa[j] * fb[j]) * (kk[j >> 1][j & 1] * r2); e[j] = e[j] + 1.0f; }
#pragma unroll
                for (int j = 0; j < 4; ++j) e[j] = (f32x2){__builtin_amdgcn_rcpf(e[j].x), __builtin_amdgcn_rcpf(e[j].y)};
#pragma unroll
                for (int j = 0; j < 4; ++j) q[j] = q[j] * e[j];
                u32x4 w; w.x = cvt_pk_bf16(q[0].x, q[0].y); w.y = cvt_pk_bf16(q[1].x, q[1].y); w.z = cvt_pk_bf16(q[2].x, q[2].y); w.w = cvt_pk_bf16(q[3].x, q[3].y);
                *(PG8_GAS u32x4*)rowp = w; }
    }
};
struct EpiConv {
    static constexpr bool PERM = true, AFTER_DRAIN = false;
    bf16_t* O; const bf16_t* U; const float* cw; int ldc; int seq; const float* rs; int ldr;
    __device__ __forceinline__ void operator()(const f32x4 (&acc)[2][2][4][2], const Unit& u, int wr, int wc, int fr, int fq) const {
        const int row0 = u.pm * BM + wr * 64 + fr;
        float rv[2][4];
#pragma unroll
        for (int ai = 0; ai < 2; ++ai)
#pragma unroll
            for (int m = 0; m < 4; ++m) rv[ai][m] = ((const PG8_GAS float*)rs)[row0 + ai * HALF + m * 16];
#pragma unroll
        for (int bj = 0; bj < 2; ++bj) { const int col0 = u.pn * BM + bj * HALF + wc * 32 + 8 * fq;
            f32x4 w[3][2];
#pragma unroll
            for (int k = 0; k < 3; ++k)
#pragma unroll
                for (int n = 0; n < 2; ++n) w[k][n] = *(const PG8_GAS f32x4*)(cw + (size_t)k * ldc + col0 + 4 * n);
#pragma unroll
            for (int ai = 0; ai < 2; ++ai)
#pragma unroll
                for (int m = 0; m < 4; ++m) { const int row = row0 + ai * HALF + m * 16; const int t = row & (seq - 1); const size_t off = (size_t)row * ldr + col0; const float r = rv[ai][m];
                    const u32x4 u2 = *(const PG8_GAS u32x4*)(U + off); u32x4 u1 = (u32x4){0u, 0u, 0u, 0u}, u0 = (u32x4){0u, 0u, 0u, 0u};
                    if (t >= 1) u1 = *(const PG8_GAS u32x4*)(U + off - ldr);
                    if (t >= 2) u0 = *(const PG8_GAS u32x4*)(U + off - 2 * ldr);
                    const f32x4 c0 = (w[0][0] * bf4_lo(u0) + w[1][0] * bf4_lo(u1) + w[2][0] * bf4_lo(u2)) * r, c1 = (w[0][1] * bf4_hi(u0) + w[1][1] * bf4_hi(u1) + w[2][1] * bf4_hi(u2)) * r;
                    *(PG8_GAS u32x4*)(O + off) = pack8(acc[ai][bj][m][0] * c0, acc[ai][bj][m][1] * c1);
                    if (m & 1) asm volatile("" ::: "memory"); }
        }
    }
};
struct EpiRetQK {
    static constexpr bool PERM = true, AFTER_DRAIN = false;
    bf16_t* Q; bf16_t* Kb; const float* cs; const float* sn; int seq; const float* rs; const float* step;
    __device__ __forceinline__ void operator()(const f32x4 (&acc)[2][2][4][2], const Unit& u, int wr, int wc, int fr, int fq) const {
        const int row0 = u.pm * BM + wr * 64 + fr;
        const float sc = (u.pn < 4) ? 1.0f : 0.0625f;
        bf16_t* op = ((u.pn < 4) ? Q : Kb) + (size_t)row0 * 1024 + (u.pn & 3) * 256 + wc * 32 + 8 * fq;
        const int fcol = wc * 32 + 8 * fq; const size_t toff = (size_t)(row0 & (seq - 1)) * 128 + fcol; const float* rp = rs + row0;
        float rv[2][4]; f32x4 c[2][2], sv[2][2], cst[2], sst[2];
#pragma unroll
        for (int ai = 0; ai < 2; ++ai) {
#pragma unroll
            for (int m = 0; m < 4; ++m) rv[ai][m] = ((const PG8_GAS float*)rp)[ai * HALF + m * 16] * sc;
#pragma unroll
            for (int n = 0; n < 2; ++n) { c[ai][n] = *(const PG8_GAS f32x4*)(cs + toff + (size_t)ai * HALF * 128 + 4 * n); sv[ai][n] = *(const PG8_GAS f32x4*)(sn + toff + (size_t)ai * HALF * 128 + 4 * n); } }
#pragma unroll
        for (int n = 0; n < 2; ++n) { cst[n] = *(const PG8_GAS f32x4*)(step + fcol + 4 * n); sst[n] = *(const PG8_GAS f32x4*)(step + 128 + fcol + 4 * n); }
#pragma unroll
        for (int ai = 0; ai < 2; ++ai)
#pragma unroll
            for (int m = 0; m < 4; ++m) { const int dr = ai * HALF + m * 16; f32x4 o1[2], o2[2]; const float r = rv[ai][m];
#pragma unroll
                for (int n = 0; n < 2; ++n) { const f32x4 cc = c[ai][n] * r, ss = sv[ai][n] * r;
                    const f32x4 x1 = acc[ai][0][m][n], x2 = acc[ai][1][m][n]; o1[n] = x1 * cc - x2 * ss; o2[n] = x2 * cc + x1 * ss;
                    const f32x4 cn = c[ai][n] * cst[n] - sv[ai][n] * sst[n], sn2 = sv[ai][n] * cst[n] + c[ai][n] * sst[n]; c[ai][n] = cn; sv[ai][n] = sn2; }
                *(PG8_GAS u32x4*)(op + dr * 1024) = pack8(o1[0], o1[1]); *(PG8_GAS u32x4*)(op + dr * 1024 + HALF) = pack8(o2[0], o2[1]); }
    }
};
struct EpiRetV {
    static constexpr bool PERM = true, AFTER_DRAIN = false;
    bf16_t* V; const float* rs;
    __device__ __forceinline__ void operator()(const f32x4 (&acc)[2][2][4][2], const Unit& u, int wr, int wc, int fr, int fq) const {
        const int row0 = u.pm * BM + wr * 64 + fr;
        const int head = u.pn >> 1; const float lg = __builtin_amdgcn_logf(1.0f - __builtin_amdgcn_exp2f(-5.0f - (float)head));
        bf16_t* op = V + (size_t)row0 * EPI_LDV + u.pn * 256 + wc * 32 + 8 * fq; const int j0 = 127 - (row0 & 127); const float* rp = rs + row0;
#pragma unroll
        for (int ai = 0; ai < 2; ++ai)
#pragma unroll
            for (int m = 0; m < 4; ++m) { const int dr = ai * HALF + m * 16; const float kd = __builtin_amdgcn_exp2f(lg * (float)(j0 - m * 16)) * ((const PG8_GAS float*)rp)[dr];
#pragma unroll
                for (int bj = 0; bj < 2; ++bj) *(PG8_GAS u32x4*)(op + dr * EPI_LDV + bj * HALF) = pack8(acc[ai][bj][m][0] * kd, acc[ai][bj][m][1] * kd); }
    }
};
struct EpiRetQKV {
    static constexpr bool PERM = true, AFTER_DRAIN = false;
    EpiRetQK qk; EpiRetV v;
    __device__ __forceinline__ void operator()(const f32x4 (&acc)[2][2][4][2], const Unit& u, int wr, int wc, int fr, int fq) const {
        if (u.pn < 8) qk(acc, u, wr, wc, fr, fq); else { Unit uv = u; uv.pn = u.pn - 8; v(acc, uv, wr, wc, fr, fq); }
    }
};
struct EpiRetGate {
    static constexpr bool PERM = true, AFTER_DRAIN = false;
    bf16_t* Y; const float* ssq; float eps; const float* rs;
    __device__ __forceinline__ void operator()(const f32x4 (&acc)[2][2][4][2], const Unit& u, int wr, int wc, int fr, int fq) const {
        const int row0 = u.pm * BM + wr * 64 + fr; const int head = u.pn >> 1, col0 = u.pn * BM + wc * 32 + 8 * fq;
        float rv[2][4], rn[2][4];
#pragma unroll
        for (int ai = 0; ai < 2; ++ai)
#pragma unroll
            for (int m = 0; m < 4; ++m) { const int row = row0 + ai * HALF + m * 16; rv[ai][m] = ((const PG8_GAS float*)rs)[row];
                const f32x4 s0 = *(const PG8_GAS f32x4*)(ssq + ((size_t)row * 4 + head) * 8), s1 = *(const PG8_GAS f32x4*)(ssq + ((size_t)row * 4 + head) * 8 + 4);
                const float tot = ((s0[0] + s0[1]) + (s0[2] + s0[3])) + ((s1[0] + s1[1]) + (s1[2] + s1[3])); rn[ai][m] = __builtin_amdgcn_rsqf(tot * (1.0f / 512.0f) + eps); }
#pragma unroll
        for (int ai = 0; ai < 2; ++ai)
#pragma unroll
            for (int m = 0; m < 4; ++m) { const int row = row0 + ai * HALF + m * 16; const float r = rv[ai][m], rnn = rn[ai][m];
                bf16_t* rowp = Y + (size_t)row * EPI_LDV + col0;
#pragma unroll
                for (int bj = 0; bj < 2; ++bj) { const u32x4 o = *(const PG8_GAS u32x4*)(rowp + bj * HALF); const f32x4 oa = bf4_lo(o), ob = bf4_hi(o); f32x4 va, vb;
#pragma unroll
                    for (int x = 0; x < 4; ++x) { const float a = acc[ai][bj][m][0][x] * r, b = acc[ai][bj][m][1][x] * r; va[x] = a * sigmoid_f(a) * oa[x] * rnn; vb[x] = b * sigmoid_f(b) * ob[x] * rnn; }
                    *(PG8_GAS u32x4*)(rowp + bj * HALF) = pack8(va, vb); }
                if (m & 1) asm volatile("" ::: "memory"); }
    }
};
struct EpiRetGateQ {
    static constexpr bool PERM = true, AFTER_DRAIN = false;
    bf16_t* Y; const float* ssq; float eps; const float* ra; const float* cw;
    static constexpr bool HAS_PRE = true;
    struct Pre { f32x4 cv[2][2]; float rv[2][4]; };
    __device__ __forceinline__ Pre preload(const Unit& u, int wr, int wc, int fr, int fq) const {
        const int row0 = u.pm * BM + wr * 64 + fr, col0 = u.pn * BM + wc * 32 + 8 * fq; Pre P;
#pragma unroll
        for (int bj = 0; bj < 2; ++bj)
#pragma unroll
            for (int n = 0; n < 2; ++n) P.cv[bj][n] = *(const PG8_GAS f32x4*)(cw + col0 + bj * HALF + 4 * n);
#pragma unroll
        for (int ai = 0; ai < 2; ++ai)
#pragma unroll
            for (int m = 0; m < 4; ++m) P.rv[ai][m] = ((const PG8_GAS float*)ra)[row0 + ai * HALF + m * 16];
        return P;
    }
    __device__ __forceinline__ void operator()(const f32x4 (&acc)[2][2][4][2], const Unit& u, int wr, int wc, int fr, int fq) const { (*this)(acc, u, wr, wc, fr, fq, preload(u, wr, wc, fr, fq)); }
    __device__ __forceinline__ void operator()(const f32x4 (&acc)[2][2][4][2], const Unit& u, int wr, int wc, int fr, int fq, const Pre& P) const {
        const int row0 = u.pm * BM + wr * 64 + fr; const int head = u.pn >> 1, col0 = u.pn * BM + wc * 32 + 8 * fq;
        f32x2 kl[2][4], kk[2][4];
#pragma unroll
        for (int bj = 0; bj < 2; ++bj)
#pragma unroll
            for (int n = 0; n < 2; ++n) { const f32x4 cv = P.cv[bj][n];
#pragma unroll
                for (int h = 0; h < 2; ++h) { kk[bj][2 * n + h] = (f32x2){cv[2 * h], cv[2 * h + 1]}; kl[bj][2 * n + h] = (f32x2){cv[2 * h] * -1.4426950408889634f, cv[2 * h + 1] * -1.4426950408889634f}; } }
        float rv[2][4], rr[2][4];
#pragma unroll
        for (int ai = 0; ai < 2; ++ai)
#pragma unroll
            for (int m = 0; m < 4; ++m) { const int row = row0 + ai * HALF + m * 16; const float r = P.rv[ai][m];
                const f32x4 s0 = *(const PG8_GAS f32x4*)(ssq + ((size_t)row * 4 + head) * 8), s1 = *(const PG8_GAS f32x4*)(ssq + ((size_t)row * 4 + head) * 8 + 4);
                const float tot = ((s0[0] + s0[1]) + (s0[2] + s0[3])) + ((s1[0] + s1[1]) + (s1[2] + s1[3])); rv[ai][m] = r; rr[ai][m] = r * __builtin_amdgcn_rsqf(tot * (1.0f / 512.0f) + eps); }
#pragma unroll
        for (int ai = 0; ai < 2; ++ai)
#pragma unroll
            for (int m = 0; m < 4; ++m) { const int row = row0 + ai * HALF + m * 16; const float r = rv[ai][m], rq = rr[ai][m];
                bf16_t* rowp = Y + (size_t)row * EPI_LDV + col0;
#pragma unroll
                for (int bj = 0; bj < 2; ++bj) { const u32x4 o = *(const PG8_GAS u32x4*)(rowp + bj * HALF); const f32x4 oa = bf4_lo(o), ob = bf4_hi(o);
                    const f32x2 op[4] = {(f32x2){oa[0], oa[1]}, (f32x2){oa[2], oa[3]}, (f32x2){ob[0], ob[1]}, (f32x2){ob[2], ob[3]}};
                    f32x2 fa[4], e[4], q[4];
#pragma unroll
                    for (int j = 0; j < 4; ++j) { const i32x4 ia = __builtin_bit_cast(i32x4, acc[ai][bj][m][j >> 1]); fa[j] = (f32x2){(float)ia[2 * (j & 1)], (float)ia[2 * (j & 1) + 1]}; }
#pragma unroll
                    for (int j = 0; j < 4; ++j) { const f32x2 t = fa[j] * (kl[bj][j] * r); e[j] = (f32x2){__builtin_amdgcn_exp2f(t.x), __builtin_amdgcn_exp2f(t.y)}; }
#pragma unroll
                    for (int j = 0; j < 4; ++j) { q[j] = (fa[j] * op[j]) * (kk[bj][j] * rq); e[j] = e[j] + 1.0f; }
#pragma unroll
                    for (int j = 0; j < 4; ++j) e[j] = (f32x2){__builtin_amdgcn_rcpf(e[j].x), __builtin_amdgcn_rcpf(e[j].y)};
#pragma unroll
                    for (int j = 0; j < 4; ++j) q[j] = q[j] * e[j];
                    u32x4 w; w.x = cvt_pk_bf16(q[0].x, q[0].y); w.y = cvt_pk_bf16(q[1].x, q[1].y); w.z = cvt_pk_bf16(q[2].x, q[2].y); w.w = cvt_pk_bf16(q[3].x, q[3].y);
                    *(PG8_GAS u32x4*)(rowp + bj * HALF) = w; }
                if (m & 1) asm volatile("" ::: "memory"); }
    }
};
template <class Inner> struct EpiDeq {
    static constexpr bool PERM = true, AFTER_DRAIN = false; static_assert(Inner::PERM, "EpiDeq: column map of PERM epilogues");
    Inner in; const float* cw;
    static constexpr bool HAS_PRE = true;
    struct Pre { f32x4 cv[2][2]; };
    __device__ __forceinline__ Pre preload(const Unit& u, int wr, int wc, int fr, int fq) const {
        const int wcol0 = u.pn * BM + wc * 32 + 8 * fq; Pre P;
#pragma unroll
        for (int bj = 0; bj < 2; ++bj)
#pragma unroll
            for (int n = 0; n < 2; ++n) P.cv[bj][n] = *(const PG8_GAS f32x4*)(cw + wcol0 + bj * HALF + 4 * n);
        return P;
    }
    __device__ __forceinline__ void operator()(f32x4 (&acc)[2][2][4][2], const Unit& u, int wr, int wc, int fr, int fq) const { (*this)(acc, u, wr, wc, fr, fq, preload(u, wr, wc, fr, fq)); }
    __device__ __forceinline__ void operator()(f32x4 (&acc)[2][2][4][2], const Unit& u, int wr, int wc, int fr, int fq, const Pre& P) const {
#pragma unroll
        for (int bj = 0; bj < 2; ++bj)
#pragma unroll
            for (int n = 0; n < 2; ++n) { const f32x4 cv = P.cv[bj][n];
#pragma unroll
                for (int ai = 0; ai < 2; ++ai)
#pragma unroll
                    for (int m = 0; m < 4; ++m) { const i32x4 iv = __builtin_bit_cast(i32x4, acc[ai][bj][m][n]); acc[ai][bj][m][n] = (f32x4){(float)iv[0], (float)iv[1], (float)iv[2], (float)iv[3]} * cv; } }
        in(acc, u, wr, wc, fr, fq);
    }
};

struct RowSsq {
    unsigned* xbuf;
    unsigned* cnt;
    unsigned* tmo;
    float eps; unsigned code;
    __device__ __forceinline__ bool run(const f32x4 (&v)[2][2][4][2], int panel, int pn, int wr, int wc, int fr, int fq, PG8_LAS unsigned char* lds, int wid, int lane) const {
        PG8_LAS float* P = (PG8_LAS float*)lds;
        PG8_LAS float* S = (PG8_LAS float*)(lds + 8192);
        PG8_LAS unsigned* flag = (PG8_LAS unsigned*)(lds + 8192 + 2048);
#pragma unroll
        for (int ai = 0; ai < 2; ++ai)
#pragma unroll
            for (int m = 0; m < 4; ++m) { float s = 0.f;
#pragma unroll
                for (int bj = 0; bj < 2; ++bj)
#pragma unroll
                    for (int n = 0; n < 2; ++n) { const f32x4 x = v[ai][bj][m][n]; s += (x[0] * x[0] + x[1] * x[1]) + (x[2] * x[2] + x[3] * x[3]); }
                s += __shfl_xor(s, 16); s += __shfl_xor(s, 32);
                if (fq == 0) P[(ai * HALF + wr * 64 + m * 16 + fr) * 4 + wc] = s; }
        asm volatile("s_waitcnt lgkmcnt(0)" ::: "memory"); __builtin_amdgcn_s_barrier(); asm volatile("" ::: "memory");
        const int row = wid * 32 + (lane & 31);
        if (lane < 32) { const float t = (P[row * 4 + 0] + P[row * 4 + 1]) + (P[row * 4 + 2] + P[row * 4 + 3]);
            unsigned long long* slot = (unsigned long long*)xbuf + ((size_t)(panel * BM + row) * 4 + pn);
            __hip_atomic_store(slot, (unsigned long long)__float_as_uint(t), __ATOMIC_RELAXED, __HIP_MEMORY_SCOPE_AGENT); }
        asm volatile("s_waitcnt vmcnt(0)" ::: "memory");
        if (lane == 0) __hip_atomic_fetch_add(cnt + 64 * panel, 1u, __ATOMIC_RELAXED, __HIP_MEMORY_SCOPE_AGENT);
        if (wid == 0) {
            bool dead = false; const unsigned long long t0 = __builtin_amdgcn_s_memrealtime(); const unsigned want = 32u;
            for (;;) {
                if ((unsigned)__builtin_amdgcn_readfirstlane(__hip_atomic_load(cnt + 64 * panel, __ATOMIC_RELAXED, __HIP_MEMORY_SCOPE_AGENT)) >= want) break;
                if (__builtin_amdgcn_s_memrealtime() - t0 > 2000000ull) {
                    if (lane == 0) { unsigned expect = 0u; __hip_atomic_compare_exchange_strong(tmo + 1, &expect, code | (unsigned)(panel & 0xff), __ATOMIC_RELAXED, __ATOMIC_RELAXED, __HIP_MEMORY_SCOPE_AGENT);
                                     __hip_atomic_store(tmo, 1u, __ATOMIC_RELAXED, __HIP_MEMORY_SCOPE_AGENT); }
                    dead = true; break; }
                __builtin_amdgcn_s_sleep(2);
            }
            __builtin_amdgcn_fence(__ATOMIC_ACQUIRE, "agent");
            if (lane == 0) flag[0] = dead ? 1u : 0u;
        }
        asm volatile("s_waitcnt vmcnt(0) lgkmcnt(0)" ::: "memory"); __builtin_amdgcn_s_barrier(); asm volatile("" ::: "memory");
        const bool bad = flag[0] != 0u;
        if (lane < 32) { const unsigned long long* slot = (const unsigned long long*)xbuf + (size_t)(panel * BM + row) * 4; float tot = 0.f;
#pragma unroll
            for (int t = 0; t < 4; ++t) { const unsigned long long w = __hip_atomic_load(slot + t, __ATOMIC_RELAXED, __HIP_MEMORY_SCOPE_AGENT); tot += __uint_as_float((unsigned)w); }
            S[row] = 1.0f / sqrtf(tot * (1.0f / 1024.0f) + eps); }
        asm volatile("s_waitcnt lgkmcnt(0)" ::: "memory"); __builtin_amdgcn_s_barrier(); asm volatile("" ::: "memory");
        return bad;
    }
};
template <bool GATED> struct EpiRmsRes {
    static constexpr bool PERM = true, AFTER_DRAIN = true;
    bf16_t* xb; float* out32; float* rs; const float* gate; const float* g_post; float scale; int row_off;
    RowSsq st1, st2; unsigned poison;
    __device__ __forceinline__ void fused(f32x4 (&acc)[2][2][4][2], const Unit& u, int wr, int wc, int fr, int fq, PG8_LAS unsigned char* lds, int wid, int lane) const {
        const PG8_LAS float* S = (const PG8_LAS float*)(lds + 8192);
        const int col0 = u.pn * BM + wc * 32 + 8 * fq, prow0 = row_off + u.pm * BM, panel = prow0 >> 8;
        if (GATED) {
#pragma unroll
            for (int ai = 0; ai < 2; ++ai)
#pragma unroll
                for (int m = 0; m < 4; ++m) { const size_t off = (size_t)(prow0 + ai * HALF + wr * 64 + m * 16 + fr) * 1024 + col0;
#pragma unroll
                    for (int bj = 0; bj < 2; ++bj)
#pragma unroll
                        for (int n = 0; n < 2; ++n) { const f32x4 gv = *(const PG8_GAS f32x4*)(gate + off + bj * HALF + n * 4);
#pragma unroll
                            for (int x = 0; x < 4; ++x) acc[ai][bj][m][n][x] *= sigmoid_f(gv[x]); }
                    asm volatile("" : "+v"(acc[ai][0][m][0]), "+v"(acc[ai][0][m][1]), "+v"(acc[ai][1][m][0]), "+v"(acc[ai][1][m][1]) :: "memory"); }
        }
        bool bad = st1.run(acc, panel, u.pn, wr, wc, fr, fq, lds, wid, lane) || poison != 0u;
        const float qnan = __builtin_nanf("");
        {
            f32x4 gp[2][2];
#pragma unroll
            for (int bj = 0; bj < 2; ++bj)
#pragma unroll
                for (int n = 0; n < 2; ++n) gp[bj][n] = *(const PG8_GAS f32x4*)(g_post + col0 + bj * HALF + n * 4);
#pragma unroll
            for (int ai = 0; ai < 2; ++ai)
#pragma unroll
                for (int m = 0; m < 4; ++m) { const int r = ai * HALF + wr * 64 + m * 16 + fr; const float sr = S[r] * scale; const size_t off = (size_t)(prow0 + r) * 1024 + col0;
#pragma unroll
                    for (int bj = 0; bj < 2; ++bj) { const u32x4 xw = *(const PG8_GAS u32x4*)(xb + off + bj * HALF);
                        const f32x4 x0 = bf4_lo(xw) + acc[ai][bj][m][0] * gp[bj][0] * sr, x1 = bf4_hi(xw) + acc[ai][bj][m][1] * gp[bj][1] * sr;
                        if (out32) { *(PG8_GAS f32x4*)(out32 + off + bj * HALF) = bad ? (f32x4){qnan, qnan, qnan, qnan} : x0; *(PG8_GAS f32x4*)(out32 + off + bj * HALF + 4) = bad ? (f32x4){qnan, qnan, qnan, qnan} : x1; }
                        const u32x4 w = pack8(x0, x1); *(PG8_GAS u32x4*)(xb + off + bj * HALF) = w;
                        acc[ai][bj][m][0] = bf4_lo(w); acc[ai][bj][m][1] = bf4_hi(w); }
                    asm volatile("" : "+v"(acc[ai][0][m][0]), "+v"(acc[ai][0][m][1]), "+v"(acc[ai][1][m][0]), "+v"(acc[ai][1][m][1]));
                    if (m & 1) asm volatile("" ::: "memory"); }
        }
        bad = st2.run(acc, panel, u.pn, wr, wc, fr, fq, lds, wid, lane) || bad;
        if (u.pn == 0 && wc == 0 && fq == 0) {
#pragma unroll
            for (int ai = 0; ai < 2; ++ai)
#pragma unroll
                for (int m = 0; m < 4; ++m) { const int r = ai * HALF + wr * 64 + m * 16 + fr; rs[prow0 + r] = bad ? qnan : S[r]; }
        }
    }
};

template <bool GATED> struct EpiRmsRes1 {
    static constexpr bool PERM = true, AFTER_DRAIN = true, XKEEP = false;
    unsigned char* wsb; float* out32; const float* g_post; float scale, eps; int cnt_word; PG8_LAS unsigned char* tab; unsigned poison; int row_off;
    static constexpr size_t O_XB = EPI_WS_XB, O_RS = EPI_WS_RS, O_GATE = EPI_WS_GATE, O_XBUF = EPI_WS_XBUF;
    __device__ __forceinline__ void fused(f32x4 (&acc)[2][2][4][2], const Unit& u, int wr, int wc, int fr, int fq, PG8_LAS unsigned char*, int wid, int lane) const {
        typedef float f32x2v __attribute__((ext_vector_type(2)));
        PG8_LAS f32x4* P = (PG8_LAS f32x4*)tab;
        PG8_LAS f32x2v* S = (PG8_LAS f32x2v*)(tab + 16384);
        PG8_LAS unsigned* flag = (PG8_LAS unsigned*)(tab + 16384 + 2048);
        bf16_t* const xb = (bf16_t*)(wsb + O_XB); float* const rs = (float*)(wsb + O_RS); const float* const gate = (const float*)(wsb + O_GATE);
        unsigned* const xbuf = (unsigned*)(wsb + O_XBUF); unsigned* const tmo = (unsigned*)wsb; unsigned* const cnt = (unsigned*)wsb + cnt_word;
        const int col0 = u.pn * BM + wc * 32 + 8 * fq, prow0 = row_off + u.pm * BM, panel = prow0 >> 8;
        u32x4 xk[4][2];
#pragma unroll
        for (int m = 0; m < 4; ++m)
#pragma unroll
            for (int bj = 0; bj < 2; ++bj) xk[m][bj] = XKEEP ? *(const PG8_GAS u32x4*)(xb + (size_t)(prow0 + wr * 64 + m * 16 + fr) * 1024 + col0 + bj * HALF) : (u32x4){0u, 0u, 0u, 0u};
        if (GATED) {
#pragma unroll
            for (int ai = 0; ai < 2; ++ai)
#pragma unroll
                for (int m = 0; m < 4; ++m) { const size_t off = (size_t)(prow0 + ai * HALF + wr * 64 + m * 16 + fr) * 1024 + col0;
#pragma unroll
                    for (int bj = 0; bj < 2; ++bj)
#pragma unroll
                        for (int n = 0; n < 2; ++n) { const f32x4 gv = *(const PG8_GAS f32x4*)(gate + off + bj * HALF + n * 4);
#pragma unroll
                            for (int x = 0; x < 4; ++x) acc[ai][bj][m][n][x] *= sigmoid_f(gv[x]); }
                    asm volatile("" : "+v"(acc[ai][0][m][0]), "+v"(acc[ai][0][m][1]), "+v"(acc[ai][1][m][0]), "+v"(acc[ai][1][m][1])); }
        }
        f32x4 gp[2][2];
#pragma unroll
        for (int bj = 0; bj < 2; ++bj)
#pragma unroll
            for (int n = 0; n < 2; ++n) gp[bj][n] = *(const PG8_GAS f32x4*)(g_post + col0 + bj * HALF + n * 4);
#pragma unroll
        for (int ai = 0; ai < 2; ++ai)
#pragma unroll
            for (int m = 0; m < 4; ++m) { float sa = 0.f, sb = 0.f, sc = 0.f, sd = 0.f;
#pragma unroll
                for (int bj = 0; bj < 2; ++bj) { u32x4 xv; if (ai == 0 && XKEEP) xv = xk[m][bj]; else xv = *(const PG8_GAS u32x4*)(xb + (size_t)(prow0 + ai * HALF + wr * 64 + m * 16 + fr) * 1024 + col0 + bj * HALF);
                    const f32x4 xl = bf4_lo(xv), xh = bf4_hi(xv);
#pragma unroll
                    for (int x = 0; x < 4; ++x) { const float h0 = acc[ai][bj][m][0][x], h1 = acc[ai][bj][m][1][x], g0 = gp[bj][0][x] * h0, g1 = gp[bj][1][x] * h1;
                        sa += h0 * h0 + h1 * h1; sc += g0 * g0 + g1 * g1; sb += xl[x] * g0 + xh[x] * g1; sd += xl[x] * xl[x] + xh[x] * xh[x]; } }
                sa += __shfl_xor(sa, 16); sb += __shfl_xor(sb, 16); sc += __shfl_xor(sc, 16); sd += __shfl_xor(sd, 16);
                sa += __shfl_xor(sa, 32); sb += __shfl_xor(sb, 32); sc += __shfl_xor(sc, 32); sd += __shfl_xor(sd, 32);
                if (fq == 0) P[(ai * HALF + wr * 64 + m * 16 + fr) * 4 + wc] = (f32x4){sa, sb, sc, sd};
                if (ai == 0 && XKEEP) asm volatile("" : "+v"(xk[m][0]), "+v"(xk[m][1]));
                asm volatile("" : "+v"(acc[ai][0][m][0]), "+v"(acc[ai][0][m][1]), "+v"(acc[ai][1][m][0]), "+v"(acc[ai][1][m][1]) :: "memory"); }
        asm volatile("s_waitcnt lgkmcnt(0)" ::: "memory"); __builtin_amdgcn_s_barrier(); asm volatile("" ::: "memory");
        const int row = wid * 32 + (lane & 31);
        if (lane < 32) { const f32x4 t = (P[row * 4 + 0] + P[row * 4 + 1]) + (P[row * 4 + 2] + P[row * 4 + 3]);
            unsigned long long* slot = (unsigned long long*)xbuf + ((size_t)(prow0 + row) * 4 + u.pn) * 2;
            __hip_atomic_store(slot, ((unsigned long long)__float_as_uint(t[1]) << 32) | __float_as_uint(t[0]), __ATOMIC_RELAXED, __HIP_MEMORY_SCOPE_AGENT);
            __hip_atomic_store(slot + 1, ((unsigned long long)__float_as_uint(t[3]) << 32) | __float_as_uint(t[2]), __ATOMIC_RELAXED, __HIP_MEMORY_SCOPE_AGENT); }
        asm volatile("s_waitcnt vmcnt(0)" ::: "memory");
        if (lane == 0) __hip_atomic_fetch_add(cnt + 64 * panel, 1u, __ATOMIC_RELAXED, __HIP_MEMORY_SCOPE_AGENT);
        if (wid == 0) {
            bool dead = false; const unsigned long long t0 = __builtin_amdgcn_s_memrealtime();
            for (;;) {
                if ((unsigned)__builtin_amdgcn_readfirstlane(__hip_atomic_load(cnt + 64 * panel, __ATOMIC_RELAXED, __HIP_MEMORY_SCOPE_AGENT)) >= 32u) break;
                if (__builtin_amdgcn_s_memrealtime() - t0 > 2000000ull) {
                    if (lane == 0) { unsigned expect = 0u; __hip_atomic_compare_exchange_strong(tmo + 1, &expect, 0x700u | (unsigned)(panel & 0xff), __ATOMIC_RELAXED, __ATOMIC_RELAXED, __HIP_MEMORY_SCOPE_AGENT);
                                     __hip_atomic_store(tmo, 1u, __ATOMIC_RELAXED, __HIP_MEMORY_SCOPE_AGENT); }
                    dead = true; break; }
                __builtin_amdgcn_s_sleep(1);
            }
            __builtin_amdgcn_fence(__ATOMIC_ACQUIRE, "agent");
            if (lane == 0) flag[0] = dead ? 1u : 0u;
        }
        asm volatile("s_waitcnt vmcnt(0) lgkmcnt(0)" ::: "memory"); __builtin_amdgcn_s_barrier(); asm volatile("" ::: "memory");
        const bool bad = flag[0] != 0u || poison != 0u;
        if (lane < 32) { const unsigned long long* slot = (const unsigned long long*)xbuf + (size_t)(prow0 + row) * 8; float ta = 0.f, tb = 0.f, tc = 0.f, td = 0.f;
#pragma unroll
            for (int t = 0; t < 4; ++t) { const unsigned long long w0 = __hip_atomic_load(slot + 2 * t, __ATOMIC_RELAXED, __HIP_MEMORY_SCOPE_AGENT), w1 = __hip_atomic_load(slot + 2 * t + 1, __ATOMIC_RELAXED, __HIP_MEMORY_SCOPE_AGENT);
                ta += __uint_as_float((unsigned)w0); tb += __uint_as_float((unsigned)(w0 >> 32)); tc += __uint_as_float((unsigned)w1); td += __uint_as_float((unsigned)(w1 >> 32)); }
            const float r1 = scale / sqrtf(ta * (1.0f / 1024.0f) + eps); const float s1 = td + r1 * ((tb + tb) + r1 * tc);
            S[row] = (f32x2v){r1, 1.0f / sqrtf(fmaxf(s1, 0.f) * (1.0f / 1024.0f) + eps)}; }
        asm volatile("s_waitcnt lgkmcnt(0)" ::: "memory"); __builtin_amdgcn_s_barrier(); asm volatile("" ::: "memory");
        const float qnan = __builtin_nanf("");
#pragma unroll
        for (int bj = 0; bj < 2; ++bj)
#pragma unroll
            for (int n = 0; n < 2; ++n) gp[bj][n] = *(const PG8_GAS f32x4*)(g_post + col0 + bj * HALF + n * 4);
#pragma unroll
        for (int ai = 0; ai < 2; ++ai)
#pragma unroll
            for (int m = 0; m < 4; ++m) { const int r = ai * HALF + wr * 64 + m * 16 + fr; const f32x2v sr = S[r]; const size_t off = (size_t)(prow0 + r) * 1024 + col0;
#pragma unroll
                for (int bj = 0; bj < 2; ++bj) { u32x4 xv; if (ai == 0 && XKEEP) xv = xk[m][bj]; else xv = *(const PG8_GAS u32x4*)(xb + off + bj * HALF);
                    f32x4 x0 = bf4_lo(xv) + acc[ai][bj][m][0] * gp[bj][0] * sr.x, x1 = bf4_hi(xv) + acc[ai][bj][m][1] * gp[bj][1] * sr.x;
                    if (bad) { x0 = (f32x4){qnan, qnan, qnan, qnan}; x1 = x0; }
                    if (out32) { *(PG8_GAS f32x4*)(out32 + off + bj * HALF) = x0; *(PG8_GAS f32x4*)(out32 + off + bj * HALF + 4) = x1; }
                    *(PG8_GAS u32x4*)(xb + off + bj * HALF) = pack8(x0, x1); }
                if (u.pn == 0 && wc == 0 && fq == 0) rs[prow0 + r] = bad ? qnan : sr.y; }
    }
};

template <bool I8> __device__ __forceinline__ f32x4 mma_frag(const bf16x8 b, const bf16x8 a, const f32x4 c) {
    if constexpr (I8) return __builtin_bit_cast(f32x4, __builtin_amdgcn_mfma_i32_16x16x64_i8(__builtin_bit_cast(i32x4, b), __builtin_bit_cast(i32x4, a), __builtin_bit_cast(i32x4, c), 0, 0, 0));
    else return __builtin_amdgcn_mfma_f32_16x16x32_bf16(b, a, c, 0, 0, 0);
}
struct NoPre {};
template <class E, class = void> struct epi_has_pre { static constexpr bool value = false; };
template <class E> struct epi_has_pre<E, decltype((void)E::HAS_PRE)> { static constexpr bool value = E::HAS_PRE; };
template <class E, bool H> struct epi_pre_t { typedef NoPre type; };
template <class E> struct epi_pre_t<E, true> { typedef typename E::Pre type; };
template <class Epi, class Sched, bool ALIGN_EPI = false, bool SP2 = false, bool I8 = false, bool BNT = false  >
__device__ __forceinline__ void gemm_phase(PG8_LAS unsigned char* lds, const Gemm g, const Sched& S, const Epi& E, int wave  ) {
    int tid_; asm volatile("v_mbcnt_lo_u32_b32 %0, -1, 0\n\tv_mbcnt_hi_u32_b32 %0, -1, %0" : "=v"(tid_)); tid_ += wave * 64;
    const int tid = tid_, wid = __builtin_amdgcn_readfirstlane(tid >> 6), lane = tid & 63, wr = wid >> 2, wc = wid & 3, fr = lane & 15, fq = lane >> 4;
    int K_ = g.K; asm volatile("" : "+s"(K_));
    const int K = K_, nt = K / BK;
    int lda_ = g.lda ? g.lda : g.K; asm volatile("" : "+s"(lda_)); const int lda = lda_;
    unsigned voffA[2], voffB[2];
#pragma unroll
    for (int i = 0; i < 2; ++i) { int R, C; stage_rc(tid * 16 + i * 8192, R, C); const int Rb = Epi::PERM ? ((R & ~31) + perm32(R & 31)) : R;
        voffA[i] = (unsigned)(R * lda + C) * 2u; voffB[i] = (unsigned)(Rb * K + C) * 2u; }
    const size_t kstep = (size_t)(BK * 2);
    const size_t hstep = (size_t)HALF * K * 2;
    const size_t hstepA = (size_t)HALF * lda * 2, tstepA = 2 * hstepA;
    const size_t tstep = 2 * hstep;
    const unsigned ldsw = (unsigned)wid * 1024u;
    const int aoff = lds_byte(wr * 64 + fr, fq * 8), boff = lds_byte(wc * 32 + fr, fq * 8);
#define PG8_SA(b, h) (((b) * 2 + (h)) * HTB)
#define PG8_SB(b, h) ((4 + (b) * 2 + (h)) * HTB)
#if PG8_ASM_STAGE
    const unsigned ldsb = (unsigned)__builtin_amdgcn_readfirstlane((int)(unsigned)(size_t)lds) + ldsw;
#define PG8_STAGE(bufoff, gbase, voff) do { _Pragma("unroll") for (int _i = 0; _i < 2; ++_i) { unsigned keep_; \
        asm volatile("s_mov_b32 %0, m0\n\ts_mov_b32 m0, %3\n\ts_nop 0\n\tglobal_load_lds_dwordx4 %1, %2\n\ts_mov_b32 m0, %0" : "=&s"(keep_) : "v"((voff)[_i]), "s"((const char*)(gbase)), "s"(ldsb + (unsigned)((bufoff) + _i * 8192)) : "memory"); } } while (0)
#define PG8_STAGE_B(bufoff, gbase, voff) do { if constexpr (BNT) { _Pragma("unroll") for (int _i = 0; _i < 2; ++_i) { unsigned keep_; \
        asm volatile("s_mov_b32 %0, m0\n\ts_mov_b32 m0, %3\n\ts_nop 0\n\tglobal_load_lds_dwordx4 %1, %2 nt\n\ts_mov_b32 m0, %0" : "=&s"(keep_) : "v"((voff)[_i]), "s"((const char*)(gbase)), "s"(ldsb + (unsigned)((bufoff) + _i * 8192)) : "memory"); } } else PG8_STAGE(bufoff, gbase, voff); } while (0)
#else
#define PG8_STAGE(bufoff, gbase, voff) do { _Pragma("unroll") for (int _i = 0; _i < 2; ++_i) \
        __builtin_amdgcn_global_load_lds((const unsigned*)((const char*)(gbase) + (voff)[_i]), (PG8_LAS unsigned*)(lds + (bufoff) + ldsw + _i * 8192), 16, 0, 0); } while (0)
#define PG8_STAGE_B(bufoff, gbase, voff) PG8_STAGE(bufoff, gbase, voff)
#endif
#define PG8_LDA(dst, b, h) do { _Pragma("unroll") for (int m = 0; m < 4; ++m) _Pragma("unroll") for (int k = 0; k < 2; ++k) dst[m][k] = *(const PG8_LAS bf16x8*)(lds + PG8_SA(b, h) + aoff + m * 2048 + k * 1024); } while (0)
#define PG8_LDB(dst, b, h) do { _Pragma("unroll") for (int n = 0; n < 2; ++n) _Pragma("unroll") for (int k = 0; k < 2; ++k) dst[n][k] = *(const PG8_LAS bf16x8*)(lds + PG8_SB(b, h) + boff + n * 2048 + k * 1024); } while (0)
#define PG8_MMA(ai, bj, At, Bt) do { __builtin_amdgcn_s_setprio(1); _Pragma("unroll") for (int m = 0; m < 4; ++m) _Pragma("unroll") for (int n = 0; n < 2; ++n) _Pragma("unroll") for (int k = 0; k < 2; ++k) \
        acc[ai][bj][m][n] = mma_frag<I8>(Bt[n][k], At[m][k], acc[ai][bj][m][n]); __builtin_amdgcn_s_setprio(0); } while (0)
#define PG8_WAIT_V(n) asm volatile("s_waitcnt vmcnt(" #n ")" ::: "memory")
#define PG8_WAIT_L(n) asm volatile("s_waitcnt lgkmcnt(" #n ")" ::: "memory")
#define PG8_BAR __builtin_amdgcn_s_barrier()
#define PG8_SCHED __builtin_amdgcn_sched_barrier(0)
    Unit cur, nxt; int ui = 0;
    typename epi_pre_t<Epi, epi_has_pre<Epi>::value>::type pre;
    if (!S.next(0, cur)) return;
    f32x4 acc[2][2][4][2];
#pragma unroll
    for (int a = 0; a < 2; ++a)
#pragma unroll
        for (int b = 0; b < 2; ++b)
#pragma unroll
            for (int m = 0; m < 4; ++m)
#pragma unroll
                for (int n = 0; n < 2; ++n) acc[a][b][m][n] = (f32x4){0.f, 0.f, 0.f, 0.f};
    bf16x8 At[4][2], B0[2][2], B1[2][2];
    const char* cA = (const char*)g.A + (size_t)cur.pm * tstepA; const char* cB = (const char*)g.Bt + (size_t)cur.pn * tstep;
    S.a_ready(cur);
    if constexpr (SP2) {
        PG8_STAGE_B(PG8_SB(0, 0), cB, voffB); PG8_STAGE_B(PG8_SB(0, 1), cB + hstep, voffB); PG8_STAGE(PG8_SA(0, 0), cA, voffA); PG8_STAGE(PG8_SA(0, 1), cA + hstepA, voffA);
        if (wr == 1) PG8_BAR;
        PG8_WAIT_V(2); PG8_BAR;
        PG8_STAGE_B(PG8_SB(1, 0), cB + kstep, voffB); PG8_STAGE(PG8_SA(1, 0), cA + kstep, voffA); PG8_STAGE_B(PG8_SB(1, 1), cB + hstep + kstep, voffB);
        PG8_WAIT_V(6); PG8_BAR;
    } else {
        PG8_STAGE_B(PG8_SB(0, 0), cB, voffB); PG8_STAGE(PG8_SA(0, 0), cA, voffA); PG8_STAGE_B(PG8_SB(0, 1), cB + hstep, voffB); PG8_STAGE(PG8_SA(0, 1), cA + hstepA, voffA);
        if (wr == 1) PG8_BAR;
        PG8_WAIT_V(4); PG8_BAR;
        PG8_STAGE_B(PG8_SB(1, 0), cB + kstep, voffB); PG8_STAGE(PG8_SA(1, 0), cA + kstep, voffA); PG8_STAGE_B(PG8_SB(1, 1), cB + hstep + kstep, voffB);
        PG8_WAIT_V(6); PG8_BAR;
    }
    for (;;) {
        const bool has_next = S.next(ui + 1, nxt);
        const char* nA = has_next ? (const char*)g.A + (size_t)nxt.pm * tstepA : cA; const char* nB = has_next ? (const char*)g.Bt + (size_t)nxt.pn * tstep : cB;
        for (int t = 0; t < nt; t += 2) {
            const bool last = (t == nt - 2);
            if constexpr (epi_has_pre<Epi>::value) { if (last) pre = E.preload(cur, wr, wc, fr, fq); }
            const char* a1 = cA + (size_t)(t + 1) * kstep;
            const char* a2 = last ? nA : cA + (size_t)(t + 2) * kstep; const char* b2 = last ? nB : cB + (size_t)(t + 2) * kstep;
            const char* a3 = a2 + kstep; const char* b3 = b2 + kstep;
            if (last && has_next) S.a_ready(nxt);
            if constexpr (SP2) {
#if PG8_LATE_STAGE
            PG8_LDB(B0, 0, 0); PG8_LDB(B1, 0, 1); PG8_SCHED; PG8_LDA(At, 0, 0);
            PG8_WAIT_V(6); PG8_WAIT_L(0); PG8_BAR; PG8_MMA(0, 0, At, B0); PG8_STAGE(PG8_SA(1, 1), a1 + hstepA, voffA); PG8_MMA(0, 1, At, B1); PG8_BAR; PG8_SCHED;
            PG8_LDA(At, 0, 1);
            PG8_WAIT_V(2); PG8_WAIT_L(0); PG8_BAR; PG8_MMA(1, 0, At, B0); PG8_STAGE_B(PG8_SB(0, 0), b2, voffB); PG8_STAGE_B(PG8_SB(0, 1), b2 + hstep, voffB); PG8_STAGE(PG8_SA(0, 0), a2, voffA); PG8_MMA(1, 1, At, B1); PG8_BAR; PG8_SCHED;
            PG8_LDB(B0, 1, 0); PG8_LDB(B1, 1, 1); PG8_SCHED; PG8_LDA(At, 1, 0);
            PG8_WAIT_V(6); PG8_WAIT_L(0); PG8_BAR; PG8_MMA(0, 0, At, B0); PG8_STAGE(PG8_SA(0, 1), a2 + hstepA, voffA); PG8_MMA(0, 1, At, B1); PG8_BAR; PG8_SCHED;
            PG8_LDA(At, 1, 1);
            PG8_WAIT_V(2); PG8_WAIT_L(0); PG8_BAR; PG8_MMA(1, 0, At, B0); PG8_STAGE_B(PG8_SB(1, 0), b3, voffB); PG8_STAGE_B(PG8_SB(1, 1), b3 + hstep, voffB); PG8_STAGE(PG8_SA(1, 0), a3, voffA); PG8_MMA(1, 1, At, B1); PG8_BAR; PG8_SCHED;
#else
            PG8_LDB(B0, 0, 0); PG8_LDB(B1, 0, 1); PG8_SCHED; PG8_LDA(At, 0, 0); PG8_STAGE(PG8_SA(1, 1), a1 + hstepA, voffA);
            PG8_WAIT_V(8); PG8_WAIT_L(0); PG8_BAR; PG8_MMA(0, 0, At, B0); PG8_MMA(0, 1, At, B1); PG8_BAR; PG8_SCHED;
            PG8_LDA(At, 0, 1); PG8_STAGE_B(PG8_SB(0, 0), b2, voffB); PG8_STAGE_B(PG8_SB(0, 1), b2 + hstep, voffB); PG8_STAGE(PG8_SA(0, 0), a2, voffA);
            PG8_WAIT_V(8); PG8_WAIT_L(0); PG8_BAR; PG8_MMA(1, 0, At, B0); PG8_MMA(1, 1, At, B1); PG8_BAR; PG8_SCHED;
            PG8_LDB(B0, 1, 0); PG8_LDB(B1, 1, 1); PG8_SCHED; PG8_LDA(At, 1, 0); PG8_STAGE(PG8_SA(0, 1), a2 + hstepA, voffA);
            PG8_WAIT_V(8); PG8_WAIT_L(0); PG8_BAR; PG8_MMA(0, 0, At, B0); PG8_MMA(0, 1, At, B1); PG8_BAR; PG8_SCHED;
            PG8_LDA(At, 1, 1); PG8_STAGE_B(PG8_SB(1, 0), b3, voffB); PG8_STAGE_B(PG8_SB(1, 1), b3 + hstep, voffB); PG8_STAGE(PG8_SA(1, 0), a3, voffA);
            PG8_WAIT_V(8); PG8_WAIT_L(0); PG8_BAR; PG8_MMA(1, 0, At, B0); PG8_MMA(1, 1, At, B1); PG8_BAR; PG8_SCHED;
#endif
            } else {
            PG8_LDB(B0, 0, 0); PG8_SCHED; PG8_LDA(At, 0, 0); PG8_STAGE(PG8_SA(1, 1), a1 + hstepA, voffA);
            PG8_WAIT_L(8); PG8_BAR; PG8_WAIT_L(0); PG8_MMA(0, 0, At, B0); PG8_BAR; PG8_SCHED;
            PG8_LDB(B1, 0, 1); PG8_STAGE_B(PG8_SB(0, 0), b2, voffB);
            PG8_BAR; PG8_WAIT_L(0); PG8_MMA(0, 1, At, B1); PG8_BAR;
            PG8_LDA(At, 0, 1); PG8_STAGE(PG8_SA(0, 0), a2, voffA);
            PG8_BAR; PG8_WAIT_L(0); PG8_MMA(1, 0, At, B0); PG8_BAR; PG8_SCHED;
            PG8_STAGE_B(PG8_SB(0, 1), b2 + hstep, voffB);
            PG8_WAIT_V(6); PG8_BAR; PG8_MMA(1, 1, At, B1); PG8_BAR;
            PG8_LDB(B0, 1, 0); PG8_SCHED; PG8_LDA(At, 1, 0); PG8_STAGE(PG8_SA(0, 1), a2 + hstepA, voffA);
            PG8_WAIT_L(8); PG8_BAR; PG8_WAIT_L(0); PG8_MMA(0, 0, At, B0); PG8_BAR; PG8_SCHED;
            PG8_LDB(B1, 1, 1); PG8_STAGE_B(PG8_SB(1, 0), b3, voffB);
            PG8_BAR; PG8_WAIT_L(0); PG8_MMA(0, 1, At, B1); PG8_BAR;
            PG8_LDA(At, 1, 1); PG8_STAGE(PG8_SA(1, 0), a3, voffA);
            PG8_BAR; PG8_WAIT_L(0); PG8_MMA(1, 0, At, B0); PG8_BAR; PG8_SCHED;
            PG8_STAGE_B(PG8_SB(1, 1), b3 + hstep, voffB);
            PG8_WAIT_V(6); PG8_BAR; PG8_MMA(1, 1, At, B1); PG8_BAR;
            }
        }
        if constexpr (ALIGN_EPI) { if (wr == 0) PG8_BAR; }
        if constexpr (!Epi::AFTER_DRAIN) { if constexpr (epi_has_pre<Epi>::value) E(acc, cur, wr, wc, fr, fq, pre); else E(acc, cur, wr, wc, fr, fq); S.done(cur); }
        if (!has_next) break;
#pragma unroll
        for (int a = 0; a < 2; ++a)
#pragma unroll
            for (int b = 0; b < 2; ++b)
#pragma unroll
                for (int m = 0; m < 4; ++m)
#pragma unroll
                    for (int n = 0; n < 2; ++n) acc[a][b][m][n] = (f32x4){0.f, 0.f, 0.f, 0.f};
        cur = nxt; cA = nA; cB = nB; ++ui;
        if constexpr (ALIGN_EPI) { if (wr == 1) PG8_BAR; }
    }
    PG8_WAIT_V(0);
    if constexpr (!ALIGN_EPI) { if (wr == 0) PG8_BAR; }
    PG8_BAR;
    if constexpr (Epi::AFTER_DRAIN) { E.fused(acc, cur, wr, wc, fr, fq, lds, wid, lane); S.done(cur); }
#undef PG8_SA
#undef PG8_SB
#undef PG8_STAGE
#undef PG8_STAGE_B
#undef PG8_LDA
#undef PG8_LDB
#undef PG8_MMA
#undef PG8_WAIT_V
#undef PG8_WAIT_L
#undef PG8_BAR
#undef PG8_SCHED
}
}
#define GAS __attribute__((address_space(1)))
#define LAS __attribute__((address_space(3)))
typedef unsigned short bf16;
typedef unsigned v4u __attribute__((ext_vector_type(4)));
typedef float f32x4 __attribute__((ext_vector_type(4)));
typedef short bf16x8 __attribute__((ext_vector_type(8)));
typedef GAS unsigned gu32;
typedef GAS unsigned long long gu64;
#define RLX_AGENT __ATOMIC_RELAXED, __HIP_MEMORY_SCOPE_AGENT
#define LDS_WAIT() asm volatile("s_waitcnt lgkmcnt(0)" ::: "memory")
#define VM_WAIT() asm volatile("s_waitcnt vmcnt(0)" ::: "memory")
__device__ __forceinline__ unsigned long long rt() { return __builtin_amdgcn_s_memrealtime(); }
__device__ __forceinline__ unsigned f2bf(float f) { unsigned u = __builtin_bit_cast(unsigned, f); return (u + 0x7fffu + ((u >> 16) & 1u)) >> 16; }
__device__ __forceinline__ unsigned pk2(float lo, float hi) { return f2bf(lo) | (f2bf(hi) << 16); }

#define XB_TMO      128
#define XB_XCNT(j)  (256  + 64 * (j))
#define XB_XSUB(j)  (1280 + 64 * (j))
#define XB_XGEN(j)  (2304 + 64 * (j))
#define XB_TOP      3328
#define XB_TOPGEN   3392
#define XCD_BAR_WORDS 3456
#define XB_SPIN_CAP (1u << 18)

__device__ __forceinline__ unsigned xb_ld(unsigned* p)              { return __hip_atomic_load(p, __ATOMIC_RELAXED, __HIP_MEMORY_SCOPE_AGENT); }
__device__ __forceinline__ unsigned xb_add(unsigned* p, unsigned v) { return __hip_atomic_fetch_add(p, v, __ATOMIC_RELAXED, __HIP_MEMORY_SCOPE_AGENT); }
__device__ __forceinline__ unsigned xb_xcc_id() { return (unsigned)__builtin_amdgcn_s_getreg((3 << 11) | 20) & 0xFu; }
#define XB_SPIN(cond, bar) do { unsigned _sp = 0; while (cond) { __builtin_amdgcn_s_sleep(1); \
    if ((++_sp & 255u) == 0u) { if (xb_ld(&(bar)[XB_TMO])) break; if (_sp > XB_SPIN_CAP) { atomicAdd(&(bar)[XB_TMO], 1u); break; } } } } while (0)

struct XcdBarrier {
    unsigned* bar; unsigned x; int wave;
    volatile LAS unsigned* st;
};

__device__ __forceinline__ int cur_lane() { int r; asm volatile("v_mbcnt_lo_u32_b32 %0, -1, 0\n\tv_mbcnt_hi_u32_b32 %0, -1, %0" : "=v"(r)); return r; }
__device__ __forceinline__ bool xb_thread0(int wave) { return wave == 0 && cur_lane() == 0; }
__device__ __forceinline__ XcdBarrier xcd_barrier_post(unsigned* bar, volatile LAS unsigned* st, int wave) {
    XcdBarrier b; b.bar = bar; b.x = xb_xcc_id(); b.st = st; b.wave = wave;
    if (xb_thread0(wave)) (void)xb_add(&bar[XB_XCNT(b.x)], 1u);
    return b;
}
__device__ __forceinline__ void xcd_barrier_complete(unsigned* bar, unsigned x, unsigned& nloc, unsigned& nx) {
    const unsigned G = gridDim.x * gridDim.y * gridDim.z;
    unsigned sum, cnt, mine, sp = 0u;
    for (;;) {
        sum = 0u; cnt = 0u; mine = 0u;
#pragma unroll
        for (unsigned j = 0; j < 16; ++j) { const unsigned c = xb_ld(&bar[XB_XCNT(j)]); sum += c; cnt += (c > 0u) ? 1u : 0u; mine = (j == x) ? c : mine; }
        if (sum == G) break;
        __builtin_amdgcn_s_sleep(1);
        if ((++sp & 255u) == 0u) { if (xb_ld(&bar[XB_TMO])) break; if (sp > XB_SPIN_CAP) { atomicAdd(&bar[XB_TMO], 1u); break; } }
    }
    nloc = mine > 0u ? mine : 1u; nx = cnt > 0u ? cnt : 1u;
}

__device__ __forceinline__ void xcd_barrier(const XcdBarrier& b) {
    asm volatile("s_waitcnt vmcnt(0)" ::: "memory");
    __syncthreads();
    if (xb_thread0(b.wave)) {
        unsigned* bar = b.bar;
        __builtin_amdgcn_s_waitcnt(0);
        unsigned nloc = b.st[0], nx = b.st[1];
        if (nloc == 0u) { xcd_barrier_complete(bar, b.x, nloc, nx); b.st[0] = nloc; b.st[1] = nx; }
        const unsigned old = xb_add(&bar[XB_XSUB(b.x)], 1u);
        const unsigned gen = old / nloc;
        if (old + 1u == (gen + 1u) * nloc) {
            __builtin_amdgcn_fence(__ATOMIC_RELEASE, "agent");
            asm volatile("s_waitcnt vmcnt(0)" ::: "memory");
            const unsigned og = xb_add(&bar[XB_TOP], 1u);
            const unsigned tg = og / nx;
            if (og + 1u == (tg + 1u) * nx) xb_add(&bar[XB_TOPGEN], 1u);
            else XB_SPIN(xb_ld(&bar[XB_TOPGEN]) == tg, bar);
            __builtin_amdgcn_fence(__ATOMIC_ACQUIRE, "agent");
            xb_add(&bar[XB_XGEN(b.x)], 1u);
            asm volatile("s_waitcnt vmcnt(0)" ::: "memory");
        } else {
            XB_SPIN(xb_ld(&bar[XB_XGEN(b.x)]) == gen, bar);
            __builtin_amdgcn_fence(__ATOMIC_ACQUIRE, "agent");
            asm volatile("s_waitcnt vmcnt(0)" ::: "memory");
        }
    }
    __syncthreads();
}

#define GRP_SPIN_CAP (1u << 22)
struct GroupBar { gu32* cnt; volatile LAS unsigned* st; int wave; unsigned n; };
__device__ __forceinline__ void group_barrier(const GroupBar& gb) {
    asm volatile("s_waitcnt vmcnt(0)" ::: "memory");
    __syncthreads();
    if (xb_thread0(gb.wave)) {
        const unsigned gen = gb.st[0] + 1u; gb.st[0] = gen;
        (void)__hip_atomic_fetch_add(gb.cnt, 1u, RLX_AGENT);
        unsigned sp = 0u;
        while (__hip_atomic_load(gb.cnt, RLX_AGENT) < gb.n * gen) { __builtin_amdgcn_s_sleep(1); if (++sp > GRP_SPIN_CAP) break; }
        __builtin_amdgcn_fence(__ATOMIC_ACQUIRE, "agent");
        asm volatile("s_waitcnt vmcnt(0)" ::: "memory");
    }
    __syncthreads();
}
__device__ __forceinline__ unsigned grp_mode_decide(gu32* masks, int G) {
    unsigned ok = (G == 256) ? 1u : 0u;
    for (int x = 0; x < 8; ++x) { const unsigned m0 = __hip_atomic_load(masks + 64 * (8 * x), RLX_AGENT); ok &= (m0 != 0u && (m0 & (m0 - 1u)) == 0u) ? 1u : 0u;
        for (int y = 1; y < 8; ++y) ok &= (__hip_atomic_load(masks + 64 * (8 * x + y), RLX_AGENT) == m0) ? 1u : 0u; }
    return ok ? 1u : 2u;
}
#define RET_HD __host__ __device__ __forceinline__
RET_HD unsigned off_b(unsigned row, unsigned ch) { return 256u * row + 16u * (ch ^ (((row & 3u) << 2) | ((row >> 2) & 3u))); }
RET_HD unsigned koff(unsigned j, unsigned d) { return (d >> 7) * 32768u + off_b(j, (d & 127u) >> 3) + (d & 7u) * 2u; }
RET_HD unsigned vswz(unsigned j) { return ((j >> 1) & 1u) | (((j >> 2) & 3u) << 1); }
RET_HD unsigned voff(unsigned j, unsigned e) { return 128u * j + 16u * ((e >> 3) ^ vswz(j)) + (e & 7u) * 2u; }
RET_HD unsigned soff(unsigned e, unsigned d) { return (d >> 7) * 16384u + off_b(e, (d & 127u) >> 3) + (d & 7u) * 2u; }
constexpr unsigned RET_LDS_K = 0u, RET_LDS_V = 65536u, RET_LDS_S = 81920u, RET_LDS_END = 114688u;
#ifndef PG8_SP2
#define PG8_SP2 true
#endif
#ifndef PG8_ALIGN
#define PG8_ALIGN true
#endif
#ifndef GROUP_MERGE
#define GROUP_MERGE 1
#endif
#ifndef NORM_NT
#define NORM_NT 1
#endif
#if NORM_NT
#define NORM_LD(p) __builtin_nontemporal_load(p)
#else
#define NORM_LD(p) (*(p))
#endif
#ifndef MK_PER_PHASE
#define MK_PER_PHASE 0
#endif
constexpr int NWAVES = 8;

constexpr int BATCH = 8, SEQ = 4096, D = 1024, FF = 2816, DPLE = 256, NHEAD = 4, DK = 256, DV = 512, CHUNK = 128, NCHUNK = SEQ / CHUNK;
constexpr int M = BATCH * SEQ;
constexpr int NRQKV = 2 * NHEAD * DK + NHEAD * DV;
constexpr float NORM_EPS = 1e-6f;
enum { FFN1_PRE = 0, FFN1_POST, MIX_PRE, MIX_POST, FFN2_PRE, FFN2_POST, PLE_PRE, PLE_POST };

constexpr size_t MiB = 1u << 20;
constexpr size_t WS_CTL = 0, CTL_ZERO_BYTES = 1 * MiB;
constexpr size_t WS_RS = 1 * MiB;
constexpr size_t WS_RA = 1 * MiB + 256 * 1024;
constexpr size_t WS_CW = 1 * MiB + 512 * 1024;
constexpr size_t WS_CW2 = 1 * MiB + 512 * 1024 + 96 * 1024;
constexpr size_t WS_COS = 2 * MiB, WS_SIN = 4 * MiB;
constexpr size_t WS_SSQ = 6 * MiB;
constexpr size_t WS_W = 10 * MiB;
constexpr size_t W_GU = 0, W_DN = (size_t)2 * FF * D, W_FFN = W_DN + (size_t)D * FF;
constexpr size_t W_LAYER = 2 * W_FFN + (size_t)D * DPLE + (size_t)D * D;
constexpr size_t W_PP = 2 * W_FFN, W_PG = W_PP + (size_t)D * DPLE;
constexpr size_t W_CCH = 2 * W_LAYER, W_CB = W_CCH + (size_t)2 * D * D, W_CO = W_CB + (size_t)D * D;
constexpr size_t W_RIN = W_CO + (size_t)D * D, W_ROUT = W_RIN + (size_t)6144 * D, W_END = W_ROUT + (size_t)D * 2048;
static_assert(W_END * 2 <= 96 * MiB, "weights fit 96 MiB");
constexpr size_t WS_STEP = 105 * MiB;
constexpr size_t WS_PB = 106 * MiB;
constexpr size_t WS_XN = 138 * MiB;
constexpr size_t WS_HBUF = 202 * MiB;
constexpr size_t WS_Q = WS_HBUF, WS_K = WS_HBUF + 64 * MiB;
constexpr size_t WS_XQ = WS_HBUF + 64 * MiB;
constexpr size_t WS_BIG = 330 * MiB;
constexpr size_t WS_V = WS_BIG, WS_U = WS_BIG, WS_AB = WS_BIG + (size_t)D * 2;
constexpr int LDV = FF, XQ_LD = 2 * D;
static_assert(LDV == EPI_LDV, "epilogue copy of the row stride");
constexpr size_t WS_XB = 506 * MiB;
constexpr size_t WS_END = 508 * MiB;
static_assert(WS_BIG + (size_t)M * FF * 2 <= WS_XB, "ws map");
static_assert(EPI_WS_XB == WS_XN && EPI_WS_RS == WS_RS && EPI_WS_GATE == WS_HBUF && EPI_WS_XBUF == WS_XB && WS_CTL == 0, "the fused epilogue's copies of the workspace offsets");
constexpr int CW_TMO = 0, CW_CODE = 1, CW_BAR = 4096;

constexpr int RING_OFF = 0, RING_BYTES = 131072;
constexpr int LDSCTL_OFF = RING_BYTES, MISC_OFF = LDSCTL_OFF + 320;
constexpr int TAB_OFF = RING_BYTES + 1024, TAB_BYTES = 16384 + 2048 + 64;
constexpr int LDS_BYTES = 151552;
static_assert(TAB_OFF + TAB_BYTES <= LDS_BYTES && MISC_OFF + 128 <= TAB_OFF, "LDS map");

struct Frame {
    LAS unsigned char* lds;
    volatile LAS unsigned* MISC;
    gu32* ctl;
    int wave;
    int vcu, G;
};


__device__ __forceinline__ float wave_max(float v) {
#pragma unroll
    for (int o = 1; o < 64; o <<= 1) v = fmaxf(v, __shfl_xor(v, o));
    return v;
}
__device__ __forceinline__ unsigned q4(float a, float b, float c, float d) {
    return ((unsigned)(int)__builtin_rintf(a) & 0xffu) | (((unsigned)(int)__builtin_rintf(b) & 0xffu) << 8) | (((unsigned)(int)__builtin_rintf(c) & 0xffu) << 16) | ((unsigned)(int)__builtin_rintf(d) << 24);
}
__device__ __forceinline__ float wave_sum(float v) {
#pragma unroll
    for (int o = 1; o < 64; o <<= 1) v += __shfl_xor(v, o);
    return v;
}
__device__ __forceinline__ void p0_transpose_item(const float* W, int ldw, int K, bf16* WT, int k0, int ncol0, int drow0, LAS float* scr, int lane, const float* gk) {
    const int c = lane & 7;
    f32x4 ga = (f32x4){1.f, 1.f, 1.f, 1.f}, gb = ga;
    if (gk) { ga = *(const GAS f32x4*)(gk + k0 + 8 * c); gb = *(const GAS f32x4*)(gk + k0 + 8 * c + 4); }
#pragma unroll 8
    for (int i = 0; i < 32; ++i) { const int kk = 2 * i + (lane >> 5); scr[kk * 33 + (lane & 31)] = NORM_LD((const GAS float*)W + (size_t)(k0 + kk) * ldw + ncol0 + (lane & 31)); }
    LDS_WAIT(); asm volatile("" ::: "memory");
#pragma unroll
    for (int j = 0; j < 4; ++j) { const int n = (lane >> 3) + 8 * j; const LAS float* s = scr + (8 * c) * 33 + n;
        v4u o; o.x = pk2(s[0 * 33] * ga.x, s[1 * 33] * ga.y); o.y = pk2(s[2 * 33] * ga.z, s[3 * 33] * ga.w); o.z = pk2(s[4 * 33] * gb.x, s[5 * 33] * gb.y); o.w = pk2(s[6 * 33] * gb.z, s[7 * 33] * gb.w);
        *(GAS v4u*)(WT + (size_t)(drow0 + n) * K + k0 + 8 * c) = o; }
    LDS_WAIT(); asm volatile("" ::: "memory");
}
struct WJob { const float* W; int ldw, col0, K, N; bf16* WT; int glu_off; const float* gk; };
struct KArgs { const float* in[16]; float* out; unsigned char* ws; int ph_lo, ph_hi; };
__device__ __forceinline__ WJob wjob(const KArgs& a, bf16* wb, int j) {
    WJob r; const float* gains = a.in[2];
    if (j < 16) { const int l = j >> 3, k = j & 7; bf16* lw = wb + (size_t)l * W_LAYER; const float* g = gains + (size_t)l * 8 * D;
        switch (k) {
        case 0: r = WJob{a.in[3] + (size_t)l * D * FF, FF, 0, D, FF, lw + W_GU, 0, g + FFN1_PRE * D}; break;
        case 1: r = WJob{a.in[4] + (size_t)l * D * FF, FF, 0, D, FF, lw + W_GU, 128, g + FFN1_PRE * D}; break;
        case 2: r = WJob{a.in[5] + (size_t)l * D * FF, D, 0, FF, D, lw + W_DN, -1, nullptr}; break;
        case 3: r = WJob{a.in[6] + (size_t)l * D * FF, FF, 0, D, FF, lw + W_FFN + W_GU, 0, g + FFN2_PRE * D}; break;
        case 4: r = WJob{a.in[7] + (size_t)l * D * FF, FF, 0, D, FF, lw + W_FFN + W_GU, 128, g + FFN2_PRE * D}; break;
        case 5: r = WJob{a.in[8] + (size_t)l * D * FF, D, 0, FF, D, lw + W_FFN + W_DN, -1, nullptr}; break;
        case 6: r = WJob{a.in[14] + (size_t)l * DPLE * D, D, 0, DPLE, D, lw + W_PP, -1, nullptr}; break;
        default: r = WJob{a.in[15] + (size_t)l * D * D, D, 0, D, D, lw + W_PG, -1, g + PLE_PRE * D}; break;
        }
        return r; }
    switch (j) {
    case 16: r = WJob{a.in[9], 3 * D, 0, D, D, wb + W_CB, -1, gains + MIX_PRE * D}; break;
    case 17: r = WJob{a.in[9], 3 * D, D, D, D, wb + W_CCH, 0, gains + MIX_PRE * D}; break;
    case 18: r = WJob{a.in[9], 3 * D, 2 * D, D, D, wb + W_CCH, 128, gains + MIX_PRE * D}; break;
    case 19: r = WJob{a.in[11], D, 0, D, D, wb + W_CO, -1, nullptr}; break;
    case 20: r = WJob{a.in[12], 6144, 0, D, NRQKV, wb + W_RIN, -1, gains + (size_t)8 * D + MIX_PRE * D}; break;
    default: r = WJob{a.in[13], D, 0, 2048, D, wb + W_ROUT, -1, nullptr}; break;
    }
    return r;
}
constexpr int N_WJOBS = 22;

__device__ __forceinline__ void xb_rows(Frame& F, const float* xsrc, bf16* xb, float* rs, signed char* xq, float* ra) {
    const int gw = F.vcu * NWAVES + F.wave, NGW = F.G * NWAVES;
    int lane = cur_lane(); asm volatile("" : "+v"(lane));
    for (int m = gw; m < M; m += NGW) {
        const GAS f32x4* xr = (const GAS f32x4*)(xsrc + (size_t)m * D) + lane;
        GAS unsigned long long* o8 = (GAS unsigned long long*)(xb + (size_t)m * D) + lane; float s2 = 0.f, am = 0.f; f32x4 z[4];
#pragma unroll
        for (int j = 0; j < 4; ++j) { const f32x4 v = NORM_LD(xr + 64 * j); const unsigned w0 = pk2(v.x, v.y), w1 = pk2(v.z, v.w);
            z[j] = (f32x4){__uint_as_float(w0 << 16), __uint_as_float(w0 & 0xffff0000u), __uint_as_float(w1 << 16), __uint_as_float(w1 & 0xffff0000u)};
            s2 += (z[j].x * z[j].x + z[j].y * z[j].y) + (z[j].z * z[j].z + z[j].w * z[j].w); am = fmaxf(fmaxf(am, fmaxf(fabsf(z[j].x), fabsf(z[j].y))), fmaxf(fabsf(z[j].z), fabsf(z[j].w)));
            o8[64 * j] = (unsigned long long)w0 | ((unsigned long long)w1 << 32); }
        const float r2 = 1.f / sqrtf(wave_sum(s2) * (1.f / D) + NORM_EPS); am = wave_max(am); const float qs = am > 0.f ? 127.f / am : 0.f;
        GAS unsigned* oq = (GAS unsigned*)(xq + (size_t)m * XQ_LD) + lane;
#pragma unroll
        for (int j = 0; j < 4; ++j) oq[64 * j] = q4(z[j].x * qs, z[j].y * qs, z[j].z * qs, z[j].w * qs);
        if (lane == 0) { ((GAS float*)rs)[m] = r2; ((GAS float*)ra)[m] = r2 * am * (1.f / 127.f); }
    }
}

__device__ __forceinline__ void norm_pair(const bf16* hsrc, bf16* xb, float* rs, float scale, float* out32, signed char* xq, float* ra, const int m0, const int lane, const f32x4 (&gp)[2][2], const float omul, const int xq_ld) {
    v4u hw[2][2], xw[2][2];
#pragma unroll
    for (int q = 0; q < 2; ++q)
#pragma unroll
        for (int j = 0; j < 2; ++j) { hw[q][j] = NORM_LD((const GAS v4u*)(hsrc + (size_t)(m0 + q) * D + 512 * j + 8 * lane)); xw[q][j] = NORM_LD((const GAS v4u*)(xb + (size_t)(m0 + q) * D + 512 * j + 8 * lane)); }
#pragma unroll
    for (int q = 0; q < 2; ++q) {
        f32x4 h[2][2], x[2][2]; float s = 0.f;
#pragma unroll
        for (int j = 0; j < 2; ++j) { h[j][0] = pg8::bf4_lo(hw[q][j]); h[j][1] = pg8::bf4_hi(hw[q][j]); x[j][0] = pg8::bf4_lo(xw[q][j]); x[j][1] = pg8::bf4_hi(xw[q][j]);
#pragma unroll
            for (int n = 0; n < 2; ++n) s += (h[j][n].x * h[j][n].x + h[j][n].y * h[j][n].y) + (h[j][n].z * h[j][n].z + h[j][n].w * h[j][n].w); }
        const float r1 = scale / sqrtf(wave_sum(s) * (1.f / D) + NORM_EPS); float s2 = 0.f;
#pragma unroll
        for (int j = 0; j < 2; ++j) { const f32x4 y0 = x[j][0] + h[j][0] * gp[j][0] * r1, y1 = x[j][1] + h[j][1] * gp[j][1] * r1;
            if (out32) { __builtin_nontemporal_store(y0 * omul, (GAS f32x4*)(out32 + (size_t)(m0 + q) * D + 512 * j + 8 * lane)); __builtin_nontemporal_store(y1 * omul, (GAS f32x4*)(out32 + (size_t)(m0 + q) * D + 512 * j + 8 * lane + 4)); }
            const v4u w = pg8::pack8(y0, y1); if (!out32) *(GAS v4u*)(xb + (size_t)(m0 + q) * D + 512 * j + 8 * lane) = w;
            const f32x4 z0 = pg8::bf4_lo(w), z1 = pg8::bf4_hi(w); s2 += ((z0.x * z0.x + z0.y * z0.y) + (z0.z * z0.z + z0.w * z0.w)) + ((z1.x * z1.x + z1.y * z1.y) + (z1.z * z1.z + z1.w * z1.w));
            x[j][0] = z0; x[j][1] = z1; }
        const float r2 = 1.f / sqrtf(wave_sum(s2) * (1.f / D) + NORM_EPS);
        if (lane == 0) ((GAS float*)rs)[m0 + q] = r2;
        if (xq) { float am = 0.f;
#pragma unroll
            for (int j = 0; j < 2; ++j)
#pragma unroll
                for (int n = 0; n < 2; ++n) am = fmaxf(fmaxf(am, fmaxf(fabsf(x[j][n].x), fabsf(x[j][n].y))), fmaxf(fabsf(x[j][n].z), fabsf(x[j][n].w)));
            am = wave_max(am); const float qs = am > 0.f ? 127.f / am : 0.f;
#pragma unroll
            for (int j = 0; j < 2; ++j) { const unsigned long long pk = (unsigned long long)q4(x[j][0].x * qs, x[j][0].y * qs, x[j][0].z * qs, x[j][0].w * qs) | ((unsigned long long)q4(x[j][1].x * qs, x[j][1].y * qs, x[j][1].z * qs, x[j][1].w * qs) << 32);
                *(GAS unsigned long long*)(xq + (size_t)(m0 + q) * xq_ld + 512 * j + 8 * lane) = pk; }
            if (lane == 0) ((GAS float*)ra)[m0 + q] = r2 * am * (1.f / 127.f); }
    }
}
__device__ __forceinline__ void norm_gains(const float* g_post, int lane, f32x4 (&gp)[2][2]) {
#pragma unroll
    for (int j = 0; j < 2; ++j) { gp[j][0] = *(const GAS f32x4*)(g_post + 512 * j + 8 * lane); gp[j][1] = *(const GAS f32x4*)(g_post + 512 * j + 8 * lane + 4); }
}
template <class Sched>
__device__ __forceinline__ void norm_rows_g(Frame& F, const Sched& S, const bf16* hsrc, bf16* xb, float* rs, const float* g_post, float scale, float* out32, signed char* xq, float* ra, const float omul = 1.0f, const int xq_ld = XQ_LD) {
    int lane = cur_lane();
    f32x4 gp[2][2]; norm_gains(g_post, lane, gp);
    pg8::Unit u;
    for (int i = 0; S.next(i, u); ++i) { const int base = u.pm * pg8::BM + u.pn * (pg8::BM / 4) + 2 * F.wave;
        for (int k = 0; k < 4; ++k) norm_pair(hsrc, xb, rs, scale, out32, xq, ra, base + 16 * k, lane, gp, omul, xq_ld); }
}

struct QJob { const float* W; const float* gk; signed char* WQ; float* cwf; int glu_off; int ldw; };
struct QSrc { const float* g1; const float* u1; const float* g2; const float* u2; const float* gains; const float* pg; const float* rin; };
constexpr int Q_STRIPS_GU = 8 * (FF / 32), Q_STRIPS_PG = 2 * (D / 32), Q_STRIPS_RG = 6144 / 32, Q_STRIPS = Q_STRIPS_GU + Q_STRIPS_PG + Q_STRIPS_RG;
__device__ __forceinline__ QJob qjob(const QSrc a, unsigned char* ws, int st, int& n0) {
    const float* gains = a.gains; QJob r; bf16* wb = (bf16*)(ws + WS_W);
    if (st >= Q_STRIPS_GU + Q_STRIPS_PG) {
        n0 = 32 * (st - Q_STRIPS_GU - Q_STRIPS_PG); r.W = a.rin; r.ldw = 6144; r.gk = gains + (size_t)8 * D + MIX_PRE * D; r.WQ = (signed char*)(wb + W_RIN); r.cwf = (float*)(ws + WS_CW2) + 2 * D; r.glu_off = -1; return r; }
    if (st >= Q_STRIPS_GU) { const int q = st - Q_STRIPS_GU, l = q / (D / 32);
        n0 = 32 * (q % (D / 32)); r.W = a.pg + (size_t)l * D * D; r.ldw = D; r.gk = gains + (size_t)l * 8 * D + PLE_PRE * D; r.WQ = (signed char*)(wb + (size_t)l * W_LAYER + W_PG); r.cwf = (float*)(ws + WS_CW2) + l * D; r.glu_off = -1; return r; }
    const int j = st / (FF / 32), l = j >> 2, f = (j >> 1) & 1, which = j & 1; n0 = 32 * (st % (FF / 32));
    { const float* w0 = f ? (which ? a.u2 : a.g2) : (which ? a.u1 : a.g1); r.W = w0 + (size_t)l * D * FF; } r.gk = gains + (size_t)l * 8 * D + (f ? FFN2_PRE : FFN1_PRE) * D; r.ldw = FF;
    r.WQ = (signed char*)(wb + (size_t)l * W_LAYER + (size_t)f * W_FFN + W_GU); r.cwf = (float*)(ws + WS_CW) + (l * 2 + f) * 2 * FF; r.glu_off = which * 128;
    return r;
}
__device__ __forceinline__ void q_strip(const QJob& jb, int n0, LAS float* scr  , LAS float* red  , int wave, int lane) {
    { const int n = lane & 31, hf = lane >> 5; float mx = 0.f;
#pragma unroll
      for (int t = 0; t < 2; ++t) { const int k0 = 128 * wave + 64 * t;
#pragma unroll
          for (int i4 = 0; i4 < 8; ++i4) { const f32x4 gv = *(const GAS f32x4*)(jb.gk + k0 + 32 * hf + 4 * i4);
#pragma unroll
              for (int x = 0; x < 4; ++x) { const float v = NORM_LD((const GAS float*)jb.W + (size_t)(k0 + 32 * hf + 4 * i4 + x) * jb.ldw + n0 + n) * gv[x]; scr[t * 2048 + (32 * hf + 4 * i4 + x) * 32 + n] = v; mx = fmaxf(mx, fabsf(v)); } } }
      mx = fmaxf(mx, __shfl_xor(mx, 32));
      if (hf == 0) red[wave * 32 + n] = mx; }
    __syncthreads();
    const int n = lane >> 1, hf = lane & 1;
    float cm = 0.f;
#pragma unroll
    for (int w8 = 0; w8 < 8; ++w8) cm = fmaxf(cm, red[w8 * 32 + n]);
    const float qs = cm > 0.f ? 127.f / cm : 0.f;
    const int drow = jb.glu_off < 0 ? (n0 + n) : (((n0 + n) >> 7) * 256 + jb.glu_off + ((n0 + n) & 127));
#pragma unroll
    for (int t = 0; t < 2; ++t) { const LAS float* s = scr + t * 2048 + (32 * hf) * 32 + n; unsigned w[8];
#pragma unroll
        for (int i4 = 0; i4 < 8; ++i4) w[i4] = q4(s[(4 * i4 + 0) * 32] * qs, s[(4 * i4 + 1) * 32] * qs, s[(4 * i4 + 2) * 32] * qs, s[(4 * i4 + 3) * 32] * qs);
        GAS v4u* dst = (GAS v4u*)(jb.WQ + (size_t)drow * D + 128 * wave + 64 * t + 32 * hf);
        dst[0] = (v4u){w[0], w[1], w[2], w[3]}; dst[1] = (v4u){w[4], w[5], w[6], w[7]}; }
    if (wave == 0 && hf == 0) ((GAS float*)jb.cwf)[drow] = cm * (1.f / 127.f);
    __syncthreads();
}

#ifndef PRO_REP
#define PRO_REP 0
#endif
__device__ __forceinline__ void p0_prologue(Frame& F, const KArgs& a) {
    unsigned char* ws = a.ws;
    LAS float* scr = (LAS float*)(F.lds + RING_OFF + F.wave * 16384);
    const int gw = F.vcu * NWAVES + F.wave, NGW = F.G * NWAVES; const int lane0 = cur_lane();
    bf16* wb = (bf16*)(ws + WS_W);
    for (int rp_ = 0; rp_ <= ((PRO_REP >> 0) & 1); ++rp_)
    { const QSrc qs{a.in[3], a.in[4], a.in[6], a.in[7], a.in[2], a.in[15], a.in[12]};
      for (int st = F.vcu; st < Q_STRIPS; st += F.G) { int n0; const QJob jb = qjob(qs, ws, st, n0);
          q_strip(jb, n0, scr, (LAS float*)(F.lds + TAB_OFF), F.wave, lane0); } }
    for (int rp_ = 0; rp_ <= ((PRO_REP >> 1) & 1); ++rp_)
    for (int j = 0; j < N_WJOBS; ++j) {
        if ((j < 16 && ((j & 7) == 0 || (j & 7) == 1 || (j & 7) == 3 || (j & 7) == 4 || (j & 7) == 7)) || j == 20) continue;
        const WJob jb = wjob(a, wb, j); const int nblk = jb.N / 32, nitems = (jb.K / 64) * nblk;
        for (int it = gw; it < nitems; it += NGW) { const int kb = it / nblk, nb = it % nblk, n0 = 32 * nb;
            const int drow0 = jb.glu_off < 0 ? n0 : ((n0 >> 7) * 256 + jb.glu_off + (n0 & 127));
            p0_transpose_item(jb.W, jb.ldw, jb.K, jb.WT, 64 * kb, jb.col0 + n0, drow0, scr, lane0, jb.gk); }
    }
    { const int gt = (F.vcu * NWAVES + F.wave) * 64 + lane0, NGT = NGW * 64; const f32x4* src = (const f32x4*)a.in[1]; v4u* dst = (v4u*)(ws + WS_PB);
      for (int rp_ = 0; rp_ <= ((PRO_REP >> 2) & 1); ++rp_)
      for (int i = gt; i < 2 * M * DPLE / 8; i += NGT) { const f32x4 v0 = NORM_LD((const GAS f32x4*)src + 2 * i), v1 = NORM_LD((const GAS f32x4*)src + 2 * i + 1); v4u o; o.x = pk2(v0.x, v0.y); o.y = pk2(v0.z, v0.w); o.z = pk2(v1.x, v1.y); o.w = pk2(v1.z, v1.w); ((GAS v4u*)dst)[i] = o; }
      float* cs = (float*)(ws + WS_COS); float* sn = (float*)(ws + WS_SIN);
      float* stp = (float*)(ws + WS_STEP);
      for (int i = gt; i < (SEQ + 1) * 128; i += NGT) { const bool is_step = (i >> 7) == SEQ; const int pos = is_step ? 16 : (i >> 7), fi = i & 127;
          const float inv = 1.0f / exp2f((float)fi * (13.287712379549449f / 127.0f)); const float ang = (float)pos * inv;
          double tr = (double)ang * 0.15915494309189535; tr -= __builtin_rint(tr); const float tf = (float)tr;
          const float cv = __builtin_amdgcn_cosf(tf), sv = __builtin_amdgcn_sinf(tf);
          if (is_step) { ((GAS float*)stp)[fi] = cv; ((GAS float*)stp)[128 + fi] = sv; } else { ((GAS float*)cs)[i] = cv; ((GAS float*)sn)[i] = sv; } }
    }
    for (int rp_ = 0; rp_ <= ((PRO_REP >> 3) & 1); ++rp_)
    xb_rows(F, a.in[0], (bf16*)(ws + WS_XN), (float*)(ws + WS_RS), (signed char*)(ws + WS_XQ), (float*)(ws + WS_RA));
}
typedef short s16x4 __attribute__((ext_vector_type(4)));
typedef short v4i16_t __attribute__((ext_vector_type(4)));
typedef float f32x16 __attribute__((ext_vector_type(16)));
__device__ __forceinline__ s16x4 tr_rd(LAS unsigned char* p) { return __builtin_bit_cast(s16x4, __builtin_amdgcn_ds_read_tr16_b64_v4i16((LAS v4i16_t*)p)); }
__device__ __forceinline__ bf16x8 cat8(const s16x4 a, const s16x4 b) { return (bf16x8){a[0], a[1], a[2], a[3], b[0], b[1], b[2], b[3]}; }
__device__ __forceinline__ unsigned cvtpk(float lo, float hi) { unsigned r; asm volatile("v_cvt_pk_bf16_f32 %0, %1, %2" : "=v"(r) : "v"(lo), "v"(hi)); return r; }

__device__ __forceinline__ void ret_core_unit(LAS unsigned char* lds, const bf16* Qg, const bf16* Kg, bf16* Vg, float* ssq, int b, int h, int es, int tid_in, int lane_in, int w, bool do_store, int pmask = 31) {
    int tid = tid_in, lane = lane_in; asm volatile("" : "+v"(tid), "+v"(lane));
    const int c16 = lane & 15, q = lane >> 4, r32 = lane & 31, hh = lane >> 5, blk = (lane >> 4) & 1, qq = c16 >> 2, pp = c16 & 3;
    const int ib = (w < 4) ? w : 11 - w;
    const float lg = __builtin_amdgcn_logf(1.0f - __builtin_amdgcn_exp2f(-5.0f - (float)h));
    const float cd = __builtin_amdgcn_exp2f(lg * 128.0f);
    const float fi = __builtin_amdgcn_exp2f(lg * (float)(16 * ib + c16 - 127));
    float qd[4];
#pragma unroll
    for (int r = 0; r < 4; ++r) qd[r] = __builtin_amdgcn_exp2f(lg * (float)(16 * ib + 4 * q + r + 1));
    const size_t rowbase = (size_t)b * SEQ;
    const bf16* Qh = Qg + rowbase * 1024 + h * 256;
    const bf16* Kh = Kg + rowbase * 1024 + h * 256;
    bf16* Vh = Vg + rowbase * LDV + h * 512 + es * 64;
    LAS unsigned char* ldK = lds + RET_LDS_K; LAS unsigned char* ldV = lds + RET_LDS_V; LAS unsigned char* ldS = lds + RET_LDS_S;
    unsigned rx[4], kt[2], vt[2][2], vdx[4], st[4], kst_a, vst_a;
    { const unsigned rbase = 256u * c16 + 16u * (q ^ ((c16 >> 2) & 3)), sig64 = 64u * (c16 & 3);
#pragma unroll
      for (int k = 0; k < 4; ++k) { rx[k] = rbase + ((64u * k) ^ sig64); asm volatile("" : "+v"(rx[k])); }
      const unsigned L = (2 * blk + (pp >> 1)) ^ (2 * hh);
#pragma unroll
      for (int t = 0; t < 2; ++t) { kt[t] = 256u * (8 * hh + qq) + 8u * (pp & 1) + 32768u * (w >> 2) + 64u * ((w & 3) ^ qq) + 1024u * t + 16u * (L ^ t); asm volatile("" : "+v"(kt[t])); }
      const unsigned vb = 128u * (8 * hh + qq) + 16u * ((pp >> 1) ^ (qq >> 1)) + 8u * (pp & 1);
#pragma unroll
      for (int eb = 0; eb < 2; ++eb)
#pragma unroll
          for (int t = 0; t < 2; ++t) { vt[eb][t] = vb + 512u * t + 64u * (eb ^ hh) + 32u * (blk ^ t); asm volatile("" : "+v"(vt[eb][t])); }
      const unsigned vd = 128u * (4 * q + qq) + 16u * ((pp >> 1) ^ (qq >> 1)) + 8u * (pp & 1);
#pragma unroll
      for (int cc = 0; cc < 4; ++cc) { vdx[cc] = vd + 32u * (cc ^ q); asm volatile("" : "+v"(vdx[cc])); }
      const unsigned ssb = 256u * r32 + 8u * hh + 64u * ((w & 3) ^ (r32 & 3)) + 16384u * (w >> 2);
#pragma unroll
      for (int g = 0; g < 4; ++g) { st[g] = ssb + 16u * (g ^ ((r32 >> 2) & 3)); asm volatile("" : "+v"(st[g])); }
      kst_a = koff(tid >> 5, (tid & 31) * 8); vst_a = voff(tid >> 3, (tid & 7) * 8); asm volatile("" : "+v"(kst_a), "+v"(vst_a));
    }
    f32x16 S0, S1;
#pragma unroll
    for (int r = 0; r < 16; ++r) { S0[r] = 0.f; S1[r] = 0.f; }
    v4u kst[8], vst[2]; bf16x8 qf[8];
    const bf16* kgp = Kh + (size_t)(tid >> 5) * 1024 + (tid & 31) * 8;
    const bf16* vgp = Vh + (size_t)(tid >> 3) * LDV + (tid & 7) * 8;
    const bf16* qgp = Qh + (size_t)(16 * ib + c16) * 1024 + 8 * q;
#define RET_LOAD_KV(c) do { const size_t t0_ = (size_t)(c) * CHUNK; \
        _Pragma("unroll") for (int n = 0; n < 8; ++n) kst[n] = *(const GAS v4u*)(kgp + (t0_ + 16 * n) * 1024); \
        _Pragma("unroll") for (int n = 0; n < 2; ++n) vst[n] = *(const GAS v4u*)(vgp + (t0_ + 64 * n) * LDV); } while (0)
#define RET_STORE_KV() do { \
        _Pragma("unroll") for (int n = 0; n < 8; ++n) *(LAS v4u*)(ldK + kst_a + 4096 * n) = kst[n]; \
        _Pragma("unroll") for (int n = 0; n < 2; ++n) *(LAS v4u*)(ldV + vst_a + 8192 * n) = vst[n]; } while (0)
#define RET_LOAD_Q(c) do { const size_t t0_ = (size_t)(c) * CHUNK; \
        _Pragma("unroll") for (int ks = 0; ks < 8; ++ks) qf[ks] = *(const GAS bf16x8*)(qgp + t0_ * 1024 + 32 * ks); } while (0)
#define RET_STORE_S() do { \
        _Pragma("unroll") for (int g = 0; g < 4; ++g) { \
            unsigned long long v0 = (unsigned long long)cvtpk(S0[4 * g], S0[4 * g + 1]) | ((unsigned long long)cvtpk(S0[4 * g + 2], S0[4 * g + 3]) << 32); \
            unsigned long long v1 = (unsigned long long)cvtpk(S1[4 * g], S1[4 * g + 1]) | ((unsigned long long)cvtpk(S1[4 * g + 2], S1[4 * g + 3]) << 32); \
            *(LAS unsigned long long*)(ldS + st[g]) = v0; *(LAS unsigned long long*)(ldS + st[g] + 8192) = v1; } } while (0)
    RET_LOAD_KV(0); RET_LOAD_Q(0);
    RET_STORE_S();
    RET_STORE_KV();
    RET_LOAD_KV(1);
    __syncthreads();
    for (int c = 0; c < NCHUNK; ++c) {
        const int t0 = c * CHUNK;
        f32x4 O[4];
#pragma unroll
        for (int cc = 0; cc < 4; ++cc) O[cc] = (f32x4){0.f, 0.f, 0.f, 0.f};
        if (pmask & 1)
#pragma unroll
        for (int ks = 0; ks < 8; ++ks)
#pragma unroll
            for (int cc = 0; cc < 4; ++cc) { const bf16x8 sb = *(const LAS bf16x8*)(ldS + rx[ks & 3] + (4096 * cc + 16384 * (ks >> 2))); O[cc] = __builtin_amdgcn_mfma_f32_16x16x32_bf16(qf[ks], sb, O[cc], 0, 0, 0); }
#pragma unroll
        for (int cc = 0; cc < 4; ++cc)
#pragma unroll
            for (int r = 0; r < 4; ++r) O[cc][r] *= qd[r];
        f32x4 X[8];
        {
            bf16x8 kf[8];
            if (pmask & 2) {
#pragma unroll
                for (int ks = 0; ks < 8; ++ks) kf[ks] = *(const LAS bf16x8*)(ldK + rx[ks & 3] + (32768 * (ks >> 2)));
            }
#pragma unroll
            for (int jb = 0; jb < 8; ++jb) { X[jb] = (f32x4){0.f, 0.f, 0.f, 0.f};
                if (jb <= ib && (pmask & 2)) {
#pragma unroll
                    for (int ks = 0; ks < 8; ++ks) { X[jb] = __builtin_amdgcn_mfma_f32_16x16x32_bf16(kf[ks], qf[ks], X[jb], 0, 0, 0);
                        if (jb < 7) kf[ks] = *(const LAS bf16x8*)(ldK + rx[ks & 3] + (4096 * (jb + 1) + 32768 * (ks >> 2))); }
#pragma unroll
                    for (int r = 0; r < 4; ++r) { float v = X[jb][r] * fi; if (jb == ib && 4 * q + r > c16) v = 0.f; X[jb][r] = v; }
                } }
        }
        if (c + 1 < NCHUNK) RET_LOAD_Q(c + 1);
#pragma unroll
        for (int s = 0; s < 4; ++s) {
            if (2 * s <= ib && (pmask & 16)) {
                v4u aw; aw.x = cvtpk(X[2 * s][0], X[2 * s][1]); aw.y = cvtpk(X[2 * s][2], X[2 * s][3]); aw.z = cvtpk(X[2 * s + 1][0], X[2 * s + 1][1]); aw.w = cvtpk(X[2 * s + 1][2], X[2 * s + 1][3]);
                const bf16x8 af = __builtin_bit_cast(bf16x8, aw);
#pragma unroll
                for (int cc = 0; cc < 4; ++cc) { const s16x4 b0 = tr_rd(ldV + vdx[cc] + 4096 * s), b1 = tr_rd(ldV + vdx[cc] + (4096 * s + 2048));
                    O[cc] = __builtin_amdgcn_mfma_f32_16x16x32_bf16(af, cat8(b0, b1), O[cc], 0, 0, 0); }
            } }
        if (do_store) {
            bf16* orow = Vh + (size_t)(t0 + 16 * ib + 4 * q) * LDV + c16; float* srow = ssq + ((rowbase + t0 + 16 * ib + 4 * q) * 4 + h) * 8 + es;
#pragma unroll
            for (int r = 0; r < 4; ++r) { float sq = 0.f;
#pragma unroll
                for (int cc = 0; cc < 4; ++cc) { sq += O[cc][r] * O[cc][r]; ((GAS bf16*)orow)[(size_t)r * LDV + 16 * cc] = (bf16)f2bf(O[cc][r]); }
                sq += __shfl_xor(sq, 1); sq += __shfl_xor(sq, 2); sq += __shfl_xor(sq, 4); sq += __shfl_xor(sq, 8);
                if (c16 == 0) ((GAS float*)srow)[r * 32] = sq; }
        }
        if (c + 1 < NCHUNK && (pmask & 4)) {
#pragma unroll
            for (int r = 0; r < 16; ++r) { S0[r] *= cd; S1[r] *= cd; }
#pragma unroll
            for (int ks = 0; ks < 8; ++ks) {
                const s16x4 a0 = tr_rd(ldK + kt[0] + 4096 * ks), a1 = tr_rd(ldK + kt[1] + 4096 * ks);
                const s16x4 b00 = tr_rd(ldV + vt[0][0] + 2048 * ks), b01 = tr_rd(ldV + vt[0][1] + 2048 * ks);
                const s16x4 b10 = tr_rd(ldV + vt[1][0] + 2048 * ks), b11 = tr_rd(ldV + vt[1][1] + 2048 * ks);
                const bf16x8 af = cat8(a0, a1);
                S0 = __builtin_amdgcn_mfma_f32_32x32x16_bf16(af, cat8(b00, b01), S0, 0, 0, 0);
                S1 = __builtin_amdgcn_mfma_f32_32x32x16_bf16(af, cat8(b10, b11), S1, 0, 0, 0);
            }
        }
        __syncthreads();
        if (c + 1 < NCHUNK) {
            RET_STORE_S();
            RET_STORE_KV();
            if (c + 2 < NCHUNK) RET_LOAD_KV(c + 2);
        }
        __syncthreads();
    }
#undef RET_LOAD_KV
#undef RET_STORE_KV
#undef RET_LOAD_Q
#undef RET_STORE_S
}
__device__ __forceinline__ void ret_core_phase(Frame& F, unsigned char* ws, bool do_store = true, int pmask = 31) {
    for (int unit = F.vcu; unit < BATCH * NHEAD * 8; unit += F.G)
        ret_core_unit(F.lds + RING_OFF, (const bf16*)(ws + WS_Q), (const bf16*)(ws + WS_K), (bf16*)(ws + WS_V), (float*)(ws + WS_SSQ), unit >> 5, (unit >> 3) & 3, unit & 7, F.wave * 64 + cur_lane(), cur_lane(), F.wave, do_store, pmask);
}

constexpr int CW_SEAM = 16384, SEAM_BANK = 128 * 64;
static_assert((CW_SEAM + 16 * SEAM_BANK) * 4 <= (int)CTL_ZERO_BYTES, "counter banks inside the memset region");
__global__ void __launch_bounds__(NWAVES * 64, 2) hybrid_fwd(KArgs args) {
    extern __shared__ __attribute__((aligned(16))) unsigned char lds[];
    Frame F;
    F.lds = (LAS unsigned char*)lds;
    F.MISC = (volatile LAS unsigned*)(F.lds + MISC_OFF);
    F.wave = __builtin_amdgcn_readfirstlane((int)threadIdx.x >> 6);
    F.G = gridDim.x; { const int bx = blockIdx.x; F.vcu = (F.G % 8 == 0) ? (bx % 8) * (F.G / 8) + bx / 8 : bx; }
    unsigned char* const ws_k = args.ws; const float* const gains_k = args.in[2];
    F.ctl = (gu32*)(ws_k + WS_CTL);
    for (int u = F.wave * 64 + cur_lane(); u < (LDS_BYTES - LDSCTL_OFF) / 4; u += NWAVES * 64) ((LAS unsigned*)(F.lds + LDSCTL_OFF))[u] = 0u;
    __syncthreads();
#if MK_PER_PHASE
#define GRID_BAR() do { } while (0)
#else
    XcdBarrier bar = xcd_barrier_post((unsigned*)(F.ctl + CW_BAR), F.MISC + 8, F.wave);
#define GRID_BAR() xcd_barrier(bar)
#endif
    const int lo = args.ph_lo, hi = args.ph_hi; int ph = 0;
    constexpr int CW_GRP = 8192;
    GroupBar gb, xb; { const int c = (int)blockIdx.x, gi = (c & 7) * 8 + ((c >> 3) & 7); gb.cnt = F.ctl + CW_GRP + 64 * (gi & ~(GROUP_MERGE - 1)); gb.st = F.MISC + 10; gb.wave = F.wave; gb.n = 4u * GROUP_MERGE;
        xb.cnt = F.ctl + CW_GRP + 64 * (64 + (c & 7)); xb.st = F.MISC + 12; xb.wave = F.wave; xb.n = 32u;
        if (xb_thread0(F.wave)) (void)__hip_atomic_fetch_or(F.ctl + CW_GRP + 64 * gi + 32, 1u << (bar.x & 31u), RLX_AGENT); }
#ifndef B_NT_MASK
#define B_NT_MASK 0
#endif
#ifndef GROUP_SEAMS
#define GROUP_SEAMS 1
#endif
#if GROUP_SEAMS
#define GROUP_BAR() do { if (F.MISC[11] == 1u) group_barrier(gb); else GRID_BAR(); } while (0)
#define XCD_BAR() do { if (F.MISC[11] == 1u) group_barrier(xb); else GRID_BAR(); } while (0)
#else
#define GROUP_BAR() GRID_BAR()
#define XCD_BAR() GRID_BAR()
#endif
#ifndef PROBE_CLK
#define PROBE_CLK 0
#endif
#if PROBE_CLK
#ifndef PROBE_BASE
#define PROBE_BASE 0.f
#endif
#define STAMP(k) if (F.wave == 0 && cur_lane() == 0) { const unsigned t_ = (unsigned)__builtin_amdgcn_s_memrealtime(); (void)__hip_atomic_fetch_max(F.ctl + 128 + 2 * (k), t_, RLX_AGENT); (void)__hip_atomic_fetch_max(F.ctl + 129 + 2 * (k), 0xffffffffu - t_, RLX_AGENT); }
#define TMAX(k) __hip_atomic_load(F.ctl + 128 + 2 * (k), RLX_AGENT)
#define TMIN(k) (0xffffffffu - __hip_atomic_load(F.ctl + 129 + 2 * (k), RLX_AGENT))
#define PROBE_OMUL , 1.0f + PROBE_BASE + floorf((float)(int)(PROBE_EXPR) / (float)(PROBE_Q)) * 0.01f
#else
#define STAMP(k)
#define PROBE_OMUL
#endif
#define PH_BEGIN if (lo <= ph && ph < hi) { unsigned char* ws = ws_k; const float* gains = gains_k; asm volatile("" : "+s"(ws), "+s"(gains));
#define PH_END_XCD if (ph + 1 < hi) XCD_BAR(); STAMP(ph) } ++ph;
#define PH_END_GRID if (ph + 1 < hi) GRID_BAR(); STAMP(ph) } ++ph;
#define PH_END_SEL(grid_) if (ph + 1 < hi) { if (grid_) GRID_BAR(); else GROUP_BAR(); } STAMP(ph) } ++ph;
#ifndef ALIGN_FFN
#define ALIGN_FFN 0
#endif
#if ALIGN_FFN
#define PH_END_ALIGN if (ph + 1 < hi) XCD_BAR(); STAMP(ph) } ++ph;
#else
#define PH_END_ALIGN if (ph + 1 < hi) GROUP_BAR(); STAMP(ph) } ++ph;
#endif
#define PH_END_GROUP if (ph + 1 < hi) GROUP_BAR(); STAMP(ph) } ++ph;
#define GEMM(EPI, I8_, SITE_) pg8::gemm_phase<EPI, pg8::StaticOrder, PG8_ALIGN, PG8_SP2, I8_, ((B_NT_MASK >> (SITE_)) & 1) != 0>(F.lds + RING_OFF, gm, S, E, F.wave)
#define SORDER(N_) pg8::StaticOrder S; S.init(M, (N_), F.G, (int)blockIdx.x)
#define wb ((bf16*)(ws + WS_W))
#define XN ((bf16*)(ws + WS_XN))
#define RS ((float*)(ws + WS_RS))
#define HB ((bf16*)(ws + WS_HBUF))
#define HID ((bf16*)(ws + WS_BIG))
#define XQp ((signed char*)(ws + WS_XQ))
#define RAp ((float*)(ws + WS_RA))
#define XQB ((signed char*)(ws + WS_BIG) + 2 * NHEAD * DV)
#define lw (wb + (size_t)l * W_LAYER)
#define fw (lw + (size_t)f * W_FFN)
#define g (gains + (size_t)l * 8 * D)

    PH_BEGIN
        p0_prologue(F, args);
        if (ph + 1 < hi) GRID_BAR();
        if (xb_thread0(F.wave)) F.MISC[11] = grp_mode_decide(F.ctl + CW_GRP + 32, F.G);
        __syncthreads();
        STAMP(ph) } ++ph;

    _Pragma("nounroll") for (int l = 0; l < 2; ++l) {
        _Pragma("nounroll") for (int f = 0; f < 2; ++f) {
            PH_BEGIN
                { pg8::Gemm gm{(const bf16*)XQp, fw + W_GU, M, 2 * FF, D / 2, XQ_LD / 2}; SORDER(2 * FF); pg8::EpiGLUq E{HID, FF, RAp, (const float*)(ws + WS_CW) + (l * 2 + f) * 2 * FF}; GEMM(pg8::EpiGLUq, true, 0); }
            PH_END_GROUP
            PH_BEGIN
                { pg8::Gemm gm{HID, fw + W_DN, M, D, FF}; SORDER(D); pg8::EpiH<0> E{HB, D, RS}; GEMM(pg8::EpiH<0>, false, 1);
                  GROUP_BAR();
                  norm_rows_g(F, S, HB, XN, RS, g + (f ? FFN2_POST : FFN1_POST) * D, 0.5f, (float*)nullptr, f ? XQp : (l == 1 ? XQB : (signed char*)nullptr), RAp, 1.0f, f ? XQ_LD : 2 * LDV); }
            PH_END_GROUP
            if (f == 0) {
                if (l == 0) {
                    PH_BEGIN
                        { pg8::Gemm gm{XN, wb + W_CCH, M, 2 * D, D}; SORDER(2 * D); pg8::EpiGLU<0> E{(bf16*)(ws + WS_U), LDV, RS}; GEMM(pg8::EpiGLU<0>, false, 2); }
                    PH_END_XCD
                    PH_BEGIN
                        { pg8::Gemm gm{XN, wb + W_CB, M, D, D}; SORDER(D); pg8::EpiConv E{(bf16*)(ws + WS_AB), (const bf16*)(ws + WS_U), args.in[10], D, SEQ, RS, LDV}; GEMM(pg8::EpiConv, false, 3); }
                    PH_END_GROUP
                    PH_BEGIN
                        { pg8::Gemm gm{(const bf16*)(ws + WS_AB), wb + W_CO, M, D, D, LDV}; SORDER(D); pg8::EpiH<0> E{HB, D, RS}; GEMM(pg8::EpiH<0>, false, 4);
                          GROUP_BAR();
                          norm_rows_g(F, S, HB, XN, RS, g + MIX_POST * D, 1.0f, (float*)nullptr, XQp, RAp); }
                    PH_END_XCD
                } else {
                    PH_BEGIN
                        { pg8::Gemm gm{(const bf16*)XQB, wb + W_RIN, M, NRQKV, D / 2, LDV}; SORDER(NRQKV);
                          pg8::EpiDeq<pg8::EpiRetQKV> E{pg8::EpiRetQKV{pg8::EpiRetQK{(bf16*)(ws + WS_Q), (bf16*)(ws + WS_K), (const float*)(ws + WS_COS), (const float*)(ws + WS_SIN), SEQ, RAp, (const float*)(ws + WS_STEP)}, pg8::EpiRetV{(bf16*)(ws + WS_V), RAp}}, (const float*)(ws + WS_CW2) + 2 * D};
                          GEMM(pg8::EpiDeq<pg8::EpiRetQKV>, true, 5); }
                    PH_END_XCD
                    PH_BEGIN
                        ret_core_phase(F, ws);
                    PH_END_XCD
                    PH_BEGIN
                        { pg8::Gemm gm{(const bf16*)XQB, wb + W_RIN + (size_t)NRQKV * D / 2, M, 2048, D / 2, LDV}; SORDER(2048);
                          pg8::EpiRetGateQ E{(bf16*)(ws + WS_V), (const float*)(ws + WS_SSQ), NORM_EPS, RAp, (const float*)(ws + WS_CW2) + 2 * D + NRQKV}; GEMM(pg8::EpiRetGateQ, true, 6); }
                    PH_END_GROUP
                    PH_BEGIN
                        { pg8::Gemm gm{(const bf16*)(ws + WS_V), wb + W_ROUT, M, D, 2048, LDV}; SORDER(D); pg8::EpiH<0> E{HB, D, RS}; GEMM(pg8::EpiH<0>, false, 7);
                          GROUP_BAR();
                          norm_rows_g(F, S, HB, XN, RS, g + MIX_POST * D, 1.0f, (float*)nullptr, XQp, RAp); }
                    PH_END_ALIGN
                }
            } else {
                PH_BEGIN
                    { pg8::Gemm gm{(const bf16*)XQp, lw + W_PG, M, D, D / 2, XQ_LD / 2}; SORDER(D); pg8::EpiDeq<pg8::EpiH<1>> E{pg8::EpiH<1>{HB, D, RAp}, (const float*)(ws + WS_CW2) + l * D}; GEMM(pg8::EpiDeq<pg8::EpiH<1>>, true, 8); }
                    __syncthreads();
                    { pg8::Gemm gm{(const bf16*)(ws + WS_PB) + (size_t)l * M * DPLE, lw + W_PP, M, D, DPLE}; SORDER(D); pg8::EpiH<2> E{HB, D, RS}; GEMM(pg8::EpiH<2>, false, 9);
                      GROUP_BAR();
                      norm_rows_g(F, S, HB, XN, RS, g + PLE_POST * D, 1.0f, (l == 1 ? args.out : (float*)nullptr), (l == 1 ? (signed char*)nullptr : XQp), RAp PROBE_OMUL); }
                PH_END_ALIGN
            }
        }
    }
#undef PH_BEGIN
#undef PH_END_GRID
#undef PH_END_XCD
#undef PH_END_GROUP
#undef PH_END_ALIGN
#undef PH_END_SEL
#undef GEMM
#undef SORDER
#undef wb
#undef XN
#undef RS
#undef HB
#undef HID
#undef XQp
#undef RAp
#undef XQB
#undef lw
#undef fw
#undef g
}
constexpr int N_PHASES = 18;

extern "C" void kernel_launch(void* const* d_in, const int* in_sizes, int n_in, void* d_out, int out_size, void* d_ws, size_t ws_size, hipStream_t stream) {
    static int grid = 0;
    if (grid == 0) {
        if (n_in != 16 || in_sizes[0] != M * D || out_size != M * D || ws_size < WS_END) { fprintf(stderr, "kernel_launch: unexpected shapes / workspace (n_in %d, in0 %d, out %d, ws %zu, need %zu)\n", n_in, n_in > 0 ? in_sizes[0] : -1, out_size, ws_size, (size_t)WS_END); grid = -1; return; }
        int dev = 0, cus = 0;
        if (hipGetDevice(&dev) != hipSuccess || hipDeviceGetAttribute(&cus, hipDeviceAttributeMultiprocessorCount, dev) != hipSuccess) { grid = -1; return; }
        if (hipFuncSetAttribute((const void*)hybrid_fwd, hipFuncAttributeMaxDynamicSharedMemorySize, LDS_BYTES) != hipSuccess) { fprintf(stderr, "kernel_launch: hipFuncSetAttribute failed\n"); grid = -1; return; }
        int per_cu = 0;
        if (hipOccupancyMaxActiveBlocksPerMultiprocessor(&per_cu, (const void*)hybrid_fwd, NWAVES * 64, LDS_BYTES) != hipSuccess || per_cu < 1) fprintf(stderr, "kernel_launch: occupancy query reports %d\n", per_cu);
        (void)hipGetLastError();
        grid = cus;
    }
    if (grid < 0) return;
    if (hipMemsetAsync((char*)d_ws + WS_CTL, 0, CTL_ZERO_BYTES, stream) != hipSuccess) return;
    KArgs a{};
    for (int i = 0; i < 16; ++i) a.in[i] = (const float*)d_in[i];
    a.out = (float*)d_out; a.ws = (unsigned char*)d_ws;
#if MK_PER_PHASE
    for (int ph = 0; ph < N_PHASES; ++ph) { a.ph_lo = ph; a.ph_hi = ph + 1; hipLaunchKernelGGL(hybrid_fwd, dim3(grid), dim3(NWAVES * 64), LDS_BYTES, stream, a); }
#else
    a.ph_lo = 0; a.ph_hi = N_PHASES; hipLaunchKernelGGL(hybrid_fwd, dim3(grid), dim3(NWAVES * 64), LDS_BYTES, stream, a);
#endif
}
```

```cpp
#include <hip/hip_runtime.h>
#include <cstdio>
#include <cstdint>
#define EPI_WS_XB ((size_t)138 << 20)
#define EPI_WS_RS ((size_t)1 << 20)
#define EPI_WS_GATE ((size_t)202 << 20)
#define EPI_WS_XBUF ((size_t)506 << 20)
#define EPI_LDV 2816
#ifndef PG8_PAIR
#define PG8_PAIR 0
#endif
#ifndef PG8_XROT
#define PG8_XROT 1
#endif
#ifndef PG8_LATE_STAGE
#define PG8_LATE_STAGE 0
#endif
#ifndef PG8_ASM_STAGE
#define PG8_ASM_STAGE 1
#endif
namespace pg8 {
#define PG8_LAS __attribute__((address_space(3)))
#define PG8_GAS __attribute__((address_space(1)))
typedef unsigned short bf16_t;
typedef short bf16x8 __attribute__((ext_vector_type(8)));
typedef float f32x4 __attribute__((ext_vector_type(4)));
typedef unsigned u32x4 __attribute__((ext_vector_type(4)));
typedef int i32x4 __attribute__((ext_vector_type(4)));
constexpr int BM = 256, BK = 64, HALF = 128, HTB = HALF * BK * 2  , STAGE_BYTES = 8 * HTB, NXCD = 8, WGM = 8;

__host__ __device__ __forceinline__ int lds_byte(int r, int c) { const int st = (r >> 4) * 2 + (c >> 5), rr = r & 15, cc = c & 31, ob = rr * 64 + cc * 2; return st * 1024 + (ob ^ (((ob >> 9) & 1) << 5)); }
__host__ __device__ __forceinline__ void stage_rc(int b, int& R, int& C) { const int st = b / 1024, sb = b % 1024, swz = sb ^ (((sb >> 9) & 1) << 5); R = (st >> 1) * 16 + swz / 64; C = (st & 1) * 32 + (swz % 64) / 2; }
__host__ __device__ __forceinline__ int perm32(int rho) { const int n = rho >> 4, i = rho & 15; return 8 * (i >> 2) + 4 * n + (i & 3); }

struct Unit { int pm, pn; };
struct Gemm { const bf16_t* A; const bf16_t* Bt; int M, N, K; int lda = 0; };

struct StaticOrder {
    int nM, nN, nwg, G, c;
    __host__ __device__ void init(int M, int N, int G_, int c_) { nM = M / BM; nN = N / BM; nwg = nM * nN; G = G_; c = c_; }
    __host__ __device__ bool next(int i, Unit& u) const {
        if (PG8_PAIR && G == 256 && nM == 128 && (nN & 1) == 0) { const int k = c >> 6, p0 = 16 * (c & 7) + ((c >> 3) & 7), nper = nN >> 2;
            if (i < 2 * nper) { u.pm = p0 + 8 * (i & 1); u.pn = k + 4 * (i >> 1); return true; }
            if ((nN & 3) == 2 && i == 2 * nper) { u.pm = p0 + 8 * (k & 1); u.pn = 4 * nper + (k >> 1); return true; }
            return false; }
        if (PG8_XROT && G == 256 && nM == 128 && nwg % G == 0) { const int rounds = nwg / G; if (i >= rounds) return false; i = (i + (c & 7)) % rounds; }
        const long L = (long)i * G + c; if (L >= nwg) return false;
        int wgid = (int)L; { const int q = nwg / NXCD, r = nwg % NXCD, xcd = wgid % NXCD, off = wgid / NXCD; wgid = (xcd < r ? xcd * (q + 1) : r * (q + 1) + (xcd - r) * q) + off; }
        const int nig = WGM * nN, gid = wgid / nig, fm = gid * WGM, gsz = (nM - fm) < WGM ? (nM - fm) : WGM;
        u.pm = fm + ((wgid % nig) % gsz); u.pn = (wgid % nig) / gsz; return true;
    }
    __device__ __forceinline__ void a_ready(const Unit&) const {}
    __device__ __forceinline__ void done(const Unit&) const {}
};

__device__ __forceinline__ unsigned cvt_pk_bf16(float lo, float hi) { unsigned r; asm volatile("v_cvt_pk_bf16_f32 %0, %1, %2" : "=v"(r) : "v"(lo), "v"(hi)); return r; }
typedef float f32x2 __attribute__((ext_vector_type(2)));
__device__ __forceinline__ float sigmoid_f(float v) { return __builtin_amdgcn_rcpf(1.0f + __builtin_amdgcn_exp2f(v * -1.4426950408889634f)); }
__device__ __forceinline__ u32x4 pack8(const f32x4 a, const f32x4 b) { u32x4 w; w.x = cvt_pk_bf16(a[0], a[1]); w.y = cvt_pk_bf16(a[2], a[3]); w.z = cvt_pk_bf16(b[0], b[1]); w.w = cvt_pk_bf16(b[2], b[3]); return w; }
__device__ __forceinline__ f32x4 bf4_lo(const u32x4 w) { return (f32x4){__uint_as_float(w.x << 16), __uint_as_float(w.x & 0xffff0000u), __uint_as_float(w.y << 16), __uint_as_float(w.y & 0xffff0000u)}; }
__device__ __forceinline__ f32x4 bf4_hi(const u32x4 w) { return (f32x4){__uint_as_float(w.z << 16), __uint_as_float(w.z & 0xffff0000u), __uint_as_float(w.w << 16), __uint_as_float(w.w & 0xffff0000u)}; }

struct EpiNull {
    static constexpr bool PERM = true, AFTER_DRAIN = false;
    float* sink;
    __device__ __forceinline__ void operator()(const f32x4 (&acc)[2][2][4][2], const Unit& u, int wr, int wc, int fr, int fq) const {
        float s = 0.f;
#pragma unroll
        for (int ai = 0; ai < 2; ++ai)
#pragma unroll
            for (int bj = 0; bj < 2; ++bj)
#pragma unroll
                for (int m = 0; m < 4; ++m)
#pragma unroll
                    for (int n = 0; n < 2; ++n) s += acc[ai][bj][m][n][0] + acc[ai][bj][m][n][1] + acc[ai][bj][m][n][2] + acc[ai][bj][m][n][3];
        if (s == 1.2345e30f) ((PG8_GAS float*)sink)[0] = s;
    }
};
struct EpiF32S {
    static constexpr bool PERM = false, AFTER_DRAIN = false;
    float* C; int ldc; const float* rs;
    __device__ __forceinline__ void operator()(const f32x4 (&acc)[2][2][4][2], const Unit& u, int wr, int wc, int fr, int fq) const {
        const int row0 = u.pm * BM + wr * 64 + fr, col0 = u.pn * BM + wc * 32 + 4 * fq;
#pragma unroll
        for (int ai = 0; ai < 2; ++ai)
#pragma unroll
            for (int m = 0; m < 4; ++m) { const int row = row0 + ai * HALF + m * 16; const float r = ((const PG8_GAS float*)rs)[row]; float* rowp = C + (size_t)row * ldc + col0;
#pragma unroll
                for (int bj = 0; bj < 2; ++bj)
#pragma unroll
                    for (int n = 0; n < 2; ++n) *(PG8_GAS f32x4*)(rowp + bj * HALF + n * 16) = acc[ai][bj][m][n] * r; }
    }
};
template <int MODE> struct EpiH {
    static constexpr bool PERM = true, AFTER_DRAIN = false;
    bf16_t* O; int ldc; const float* rs;
    __device__ __forceinline__ void operator()(const f32x4 (&acc)[2][2][4][2], const Unit& u, int wr, int wc, int fr, int fq) const {
        const int row0 = u.pm * BM + wr * 64 + fr, col0 = u.pn * BM + wc * 32 + 8 * fq;
#pragma unroll
        for (int ai = 0; ai < 2; ++ai)
#pragma unroll
            for (int m = 0; m < 4; ++m) { const int row = row0 + ai * HALF + m * 16; bf16_t* rowp = O + (size_t)row * ldc + col0; const float r = (MODE == 1) ? ((const PG8_GAS float*)rs)[row] : 1.0f;
#pragma unroll
                for (int bj = 0; bj < 2; ++bj) { f32x4 v0 = acc[ai][bj][m][0], v1 = acc[ai][bj][m][1];
                    if (MODE == 1) { v0 = v0 * r; v1 = v1 * r; }
                    if (MODE == 2) { const u32x4 gw = *(const PG8_GAS u32x4*)(rowp + bj * HALF); const f32x4 g0 = bf4_lo(gw), g1 = bf4_hi(gw);
#pragma unroll
                        for (int x = 0; x < 4; ++x) { v0[x] *= sigmoid_f(g0[x]); v1[x] *= sigmoid_f(g1[x]); } }
                    *(PG8_GAS u32x4*)(rowp + bj * HALF) = pack8(v0, v1); }
                if (MODE == 2) asm volatile("" ::: "memory"); }
    }
};
template <int ACT  > struct EpiGLU {
    static constexpr bool PERM = true, AFTER_DRAIN = false;
    bf16_t* O; int ldc; const float* rs;
    __device__ __forceinline__ void operator()(const f32x4 (&acc)[2][2][4][2], const Unit& u, int wr, int wc, int fr, int fq) const {
        const int row0 = u.pm * BM + wr * 64 + fr, col0 = u.pn * HALF + wc * 32 + 8 * fq;
#pragma unroll
        for (int ai = 0; ai < 2; ++ai)
#pragma unroll
            for (int m = 0; m < 4; ++m) { const int row = row0 + ai * HALF + m * 16; const float r = ((const PG8_GAS float*)rs)[row]; bf16_t* rowp = O + (size_t)row * ldc + col0; f32x4 v[2];
#pragma unroll
                for (int n = 0; n < 2; ++n) { const f32x4 a = acc[ai][0][m][n] * r, b = acc[ai][1][m][n] * r;
#pragma unroll
                    for (int x = 0; x < 4; ++x) v[n][x] = (ACT ? a[x] * sigmoid_f(a[x]) : a[x]) * b[x]; }
                *(PG8_GAS u32x4*)rowp = pack8(v[0], v[1]); }
    }
};
struct EpiGLUq {
    static constexpr bool PERM = true, AFTER_DRAIN = false;
    bf16_t* O; int ldc; const float* ra; const float* cw;
    static constexpr bool HAS_PRE = true;
    struct Pre { f32x4 cg[2], cu[2]; float rv[2][4]; };
    __device__ __forceinline__ Pre preload(const Unit& u, int wr, int wc, int fr, int fq) const {
        const int row0 = u.pm * BM + wr * 64 + fr, wcol0 = u.pn * BM + wc * 32 + 8 * fq; Pre P;
#pragma unroll
        for (int n = 0; n < 2; ++n) { P.cg[n] = *(const PG8_GAS f32x4*)(cw + wcol0 + 4 * n); P.cu[n] = *(const PG8_GAS f32x4*)(cw + wcol0 + HALF + 4 * n); }
#pragma unroll
        for (int ai = 0; ai < 2; ++ai)
#pragma unroll
            for (int m = 0; m < 4; ++m) P.rv[ai][m] = ((const PG8_GAS float*)ra)[row0 + ai * HALF + m * 16];
        return P;
    }
    __device__ __forceinline__ void operator()(const f32x4 (&acc)[2][2][4][2], const Unit& u, int wr, int wc, int fr, int fq) const { (*this)(acc, u, wr, wc, fr, fq, preload(u, wr, wc, fr, fq)); }
    __device__ __forceinline__ void operator()(const f32x4 (&acc)[2][2][4][2], const Unit& u, int wr, int wc, int fr, int fq, const Pre& P) const {
        const int row0 = u.pm * BM + wr * 64 + fr, col0 = u.pn * HALF + wc * 32 + 8 * fq;
        f32x2 kl[2][2], kk[2][2];
#pragma unroll
        for (int n = 0; n < 2; ++n) { const f32x4 cg = P.cg[n], cu = P.cu[n];
#pragma unroll
            for (int h = 0; h < 2; ++h) { kl[n][h] = (f32x2){cg[2 * h] * -1.4426950408889634f, cg[2 * h + 1] * -1.4426950408889634f}; kk[n][h] = (f32x2){cg[2 * h] * cu[2 * h], cg[2 * h + 1] * cu[2 * h + 1]}; } }
        float rv[2][4];
#pragma unroll
        for (int ai = 0; ai < 2; ++ai)
#pragma unroll
            for (int m = 0; m < 4; ++m) rv[ai][m] = P.rv[ai][m];
#pragma unroll
        for (int ai = 0; ai < 2; ++ai)
#pragma unroll
            for (int m = 0; m < 4; ++m) { const int row = row0 + ai * HALF + m * 16; const float r = rv[ai][m], r2 = r * r; bf16_t* rowp = O + (size_t)row * ldc + col0;
                f32x2 fa[4], fb[4], e[4], q[4];
#pragma unroll
                for (int n = 0; n < 2; ++n) { const i32x4 ia = __builtin_bit_cast(i32x4, acc[ai][0][m][n]), ib = __builtin_bit_cast(i32x4, acc[ai][1][m][n]);
#pragma unroll
                    for (int h = 0; h < 2; ++h) { fa[2 * n + h] = (f32x2){(float)ia[2 * h], (float)ia[2 * h + 1]}; fb[2 * n + h] = (f32x2){(float)ib[2 * h], (float)ib[2 * h + 1]}; } }
#pragma unroll
                for (int j = 0; j < 4; ++j) { const f32x2 t = fa[j] * (kl[j >> 1][j & 1] * r); e[j] = (f32x2){__builtin_amdgcn_exp2f(t.x), __builtin_amdgcn_exp2f(t.y)}; }
#pragma unroll
                for (int j = 0; j < 4; ++j) { q[j] = (fa[j] * fb[j]) * (kk[j >> 1][j & 1] * r2); e[j] = e[j] + 1.0f; }
#pragma unroll
                for (int j = 0; j < 4; ++j) e[j] = (f32x2){__builtin_amdgcn_rcpf(e[j].x), __builtin_amdgcn_rcpf(e[j].y)};
#pragma unroll
                for (int j = 0; j < 4; ++j) q[j] = q[j] * e[j];
                u32x4 w; w.x = cvt_pk_bf16(q[0].x, q[0].y); w.y = cvt_pk_bf16(q[1].x, q[1].y); w.z = cvt_pk_bf16(q[2].x, q[2].y); w.w = cvt_pk_bf16(q[3].x, q[3].y);
                *(PG8_GAS u32x4*)rowp = w; }
    }
};
struct EpiConv {
    static constexpr bool PERM = true, AFTER_DRAIN = false;
    bf16_t* O; const bf16_t* U; const float* cw; int ldc; int seq; const float* rs; int ldr;
    __device__ __forceinline__ void operator()(const f32x4 (&acc)[2][2][4][2], const Unit& u, int wr, int wc, int fr, int fq) const {
        const int row0 = u.pm * BM + wr * 64 + fr;
        float rv[2][4];
#pragma unroll
        for (int ai = 0; ai < 2; ++ai)
#pragma unroll
            for (int m = 0; m < 4; ++m) rv[ai][m] = ((const PG8_GAS float*)rs)[row0 + ai * HALF + m * 16];
#pragma unroll
        for (int bj = 0; bj < 2; ++bj) { const int col0 = u.pn * BM + bj * HALF + wc * 32 + 8 * fq;
            f32x4 w[3][2];
#pragma unroll
            for (int k = 0; k < 3; ++k)
#pragma unroll
                for (int n = 0; n < 2; ++n) w[k][n] = *(const PG8_GAS f32x4*)(cw + (size_t)k * ldc + col0 + 4 * n);
#pragma unroll
            for (int ai = 0; ai < 2; ++ai)
#pragma unroll
                for (int m = 0; m < 4; ++m) { const int row = row0 + ai * HALF + m * 16; const int t = row & (seq - 1); const size_t off = (size_t)row * ldr + col0; const float r = rv[ai][m];
                    const u32x4 u2 = *(const PG8_GAS u32x4*)(U + off); u32x4 u1 = (u32x4){0u, 0u, 0u, 0u}, u0 = (u32x4){0u, 0u, 0u, 0u};
                    if (t >= 1) u1 = *(const PG8_GAS u32x4*)(U + off - ldr);
                    if (t >= 2) u0 = *(const PG8_GAS u32x4*)(U + off - 2 * ldr);
                    const f32x4 c0 = (w[0][0] * bf4_lo(u0) + w[1][0] * bf4_lo(u1) + w[2][0] * bf4_lo(u2)) * r, c1 = (w[0][1] * bf4_hi(u0) + w[1][1] * bf4_hi(u1) + w[2][1] * bf4_hi(u2)) * r;
                    *(PG8_GAS u32x4*)(O + off) = pack8(acc[ai][bj][m][0] * c0, acc[ai][bj][m][1] * c1);
                    if (m & 1) asm volatile("" ::: "memory"); }
        }
    }
};
struct EpiRetQK {
    static constexpr bool PERM = true, AFTER_DRAIN = false;
    bf16_t* Q; bf16_t* Kb; const float* cs; const float* sn; int seq; const float* rs; const float* step;
    __device__ __forceinline__ void operator()(const f32x4 (&acc)[2][2][4][2], const Unit& u, int wr, int wc, int fr, int fq) const {
        const int row0 = u.pm * BM + wr * 64 + fr;
        const float sc = (u.pn < 4) ? 1.0f : 0.0625f;
        bf16_t* op = ((u.pn < 4) ? Q : Kb) + (size_t)row0 * 1024 + (u.pn & 3) * 256 + wc * 32 + 8 * fq;
        const int fcol = wc * 32 + 8 * fq; const size_t toff = (size_t)(row0 & (seq - 1)) * 128 + fcol; const float* rp = rs + row0;
        float rv[2][4]; f32x4 c[2][2], sv[2][2], cst[2], sst[2];
#pragma unroll
        for (int ai = 0; ai < 2; ++ai) {
#pragma unroll
            for (int m = 0; m < 4; ++m) rv[ai][m] = ((const PG8_GAS float*)rp)[ai * HALF + m * 16] * sc;
#pragma unroll
            for (int n = 0; n < 2; ++n) { c[ai][n] = *(const PG8_GAS f32x4*)(cs + toff + (size_t)ai * HALF * 128 + 4 * n); sv[ai][n] = *(const PG8_GAS f32x4*)(sn + toff + (size_t)ai * HALF * 128 + 4 * n); } }
#pragma unroll
        for (int n = 0; n < 2; ++n) { cst[n] = *(const PG8_GAS f32x4*)(step + fcol + 4 * n); sst[n] = *(const PG8_GAS f32x4*)(step + 128 + fcol + 4 * n); }
#pragma unroll
        for (int ai = 0; ai < 2; ++ai)
#pragma unroll
            for (int m = 0; m < 4; ++m) { const int dr = ai * HALF + m * 16; f32x4 o1[2], o2[2]; const float r = rv[ai][m];
#pragma unroll
                for (int n = 0; n < 2; ++n) { const f32x4 cc = c[ai][n] * r, ss = sv[ai][n] * r;
                    const f32x4 x1 = acc[ai][0][m][n], x2 = acc[ai][1][m][n]; o1[n] = x1 * cc - x2 * ss; o2[n] = x2 * cc + x1 * ss;
                    const f32x4 cn = c[ai][n] * cst[n] - sv[ai][n] * sst[n], sn2 = sv[ai][n] * cst[n] + c[ai][n] * sst[n]; c[ai][n] = cn; sv[ai][n] = sn2; }
                *(PG8_GAS u32x4*)(op + dr * 1024) = pack8(o1[0], o1[1]); *(PG8_GAS u32x4*)(op + dr * 1024 + HALF) = pack8(o2[0], o2[1]); }
    }
};
struct EpiRetV {
    static constexpr bool PERM = true, AFTER_DRAIN = false;
    bf16_t* V; const float* rs;
    __device__ __forceinline__ void operator()(const f32x4 (&acc)[2][2][4][2], const Unit& u, int wr, int wc, int fr, int fq) const {
        const int row0 = u.pm * BM + wr * 64 + fr;
        const int head = u.pn >> 1; const float lg = __builtin_amdgcn_logf(1.0f - __builtin_amdgcn_exp2f(-5.0f - (float)head));
        bf16_t* op = V + (size_t)row0 * EPI_LDV + u.pn * 256 + wc * 32 + 8 * fq; const int j0 = 127 - (row0 & 127); const float* rp = rs + row0;
#pragma unroll
        for (int ai = 0; ai < 2; ++ai)
#pragma unroll
            for (int m = 0; m < 4; ++m) { const int dr = ai * HALF + m * 16; const float kd = __builtin_amdgcn_exp2f(lg * (float)(j0 - m * 16)) * ((const PG8_GAS float*)rp)[dr];
#pragma unroll
                for (int bj = 0; bj < 2; ++bj) *(PG8_GAS u32x4*)(op + dr * EPI_LDV + bj * HALF) = pack8(acc[ai][bj][m][0] * kd, acc[ai][bj][m][1] * kd); }
    }
};
struct EpiRetQKV {
    static constexpr bool PERM = true, AFTER_DRAIN = false;
    EpiRetQK qk; EpiRetV v;
    __device__ __forceinline__ void operator()(const f32x4 (&acc)[2][2][4][2], const Unit& u, int wr, int wc, int fr, int fq) const {
        if (u.pn < 8) qk(acc, u, wr, wc, fr, fq); else { Unit uv = u; uv.pn = u.pn - 8; v(acc, uv, wr, wc, fr, fq); }
    }
};
struct EpiRetGate {
    static constexpr bool PERM = true, AFTER_DRAIN = false;
    bf16_t* Y; const float* ssq; float eps; const float* rs;
    __device__ __forceinline__ void operator()(const f32x4 (&acc)[2][2][4][2], const Unit& u, int wr, int wc, int fr, int fq) const {
        const int row0 = u.pm * BM + wr * 64 + fr; const int head = u.pn >> 1, col0 = u.pn * BM + wc * 32 + 8 * fq;
        float rv[2][4], rn[2][4];
#pragma unroll
        for (int ai = 0; ai < 2; ++ai)
#pragma unroll
            for (int m = 0; m < 4; ++m) { const int row = row0 + ai * HALF + m * 16; rv[ai][m] = ((const PG8_GAS float*)rs)[row];
                const f32x4 s0 = *(const PG8_GAS f32x4*)(ssq + ((size_t)row * 4 + head) * 8), s1 = *(const PG8_GAS f32x4*)(ssq + ((size_t)row * 4 + head) * 8 + 4);
                const float tot = ((s0[0] + s0[1]) + (s0[2] + s0[3])) + ((s1[0] + s1[1]) + (s1[2] + s1[3])); rn[ai][m] = __builtin_amdgcn_rsqf(tot * (1.0f / 512.0f) + eps); }
#pragma unroll
        for (int ai = 0; ai < 2; ++ai)
#pragma unroll
            for (int m = 0; m < 4; ++m) { const int row = row0 + ai * HALF + m * 16; const float r = rv[ai][m], rnn = rn[ai][m];
                bf16_t* rowp = Y + (size_t)row * EPI_LDV + col0;
#pragma unroll
                for (int bj = 0; bj < 2; ++bj) { const u32x4 o = *(const PG8_GAS u32x4*)(rowp + bj * HALF); const f32x4 oa = bf4_lo(o), ob = bf4_hi(o); f32x4 va, vb;
#pragma unroll
                    for (int x = 0; x < 4; ++x) { const float a = acc[ai][bj][m][0][x] * r, b = acc[ai][bj][m][1][x] * r; va[x] = a * sigmoid_f(a) * oa[x] * rnn; vb[x] = b * sigmoid_f(b) * ob[x] * rnn; }
                    *(PG8_GAS u32x4*)(rowp + bj * HALF) = pack8(va, vb); }
                if (m & 1) asm volatile("" ::: "memory"); }
    }
};
struct EpiRetGateQ {
    static constexpr bool PERM = true, AFTER_DRAIN = false;
    bf16_t* Y; const float* ssq; float eps; const float* ra; const float* cw;
    __device__ __forceinline__ void operator()(const f32x4 (&acc)[2][2][4][2], const Unit& u, int wr, int wc, int fr, int fq) const {
        const int row0 = u.pm * BM + wr * 64 + fr; const int head = u.pn >> 1, col0 = u.pn * BM + wc * 32 + 8 * fq;
        f32x2 kl[2][4], kk[2][4];
#pragma unroll
        for (int bj = 0; bj < 2; ++bj)
#pragma unroll
            for (int n = 0; n < 2; ++n) { const f32x4 cv = *(const PG8_GAS f32x4*)(cw + col0 + bj * HALF + 4 * n);
#pragma unroll
                for (int h = 0; h < 2; ++h) { kk[bj][2 * n + h] = (f32x2){cv[2 * h], cv[2 * h + 1]}; kl[bj][2 * n + h] = (f32x2){cv[2 * h] * -1.4426950408889634f, cv[2 * h + 1] * -1.4426950408889634f}; } }
        float rv[2][4], rr[2][4];
#pragma unroll
        for (int ai = 0; ai < 2; ++ai)
#pragma unroll
            for (int m = 0; m < 4; ++m) { const int row = row0 + ai * HALF + m * 16; const float r = ((const PG8_GAS float*)ra)[row];
                const f32x4 s0 = *(const PG8_GAS f32x4*)(ssq + ((size_t)row * 4 + head) * 8), s1 = *(const PG8_GAS f32x4*)(ssq + ((size_t)row * 4 + head) * 8 + 4);
                const float tot = ((s0[0] + s0[1]) + (s0[2] + s0[3])) + ((s1[0] + s1[1]) + (s1[2] + s1[3])); rv[ai][m] = r; rr[ai][m] = r * __builtin_amdgcn_rsqf(tot * (1.0f / 512.0f) + eps); }
#pragma unroll
        for (int ai = 0; ai < 2; ++ai)
#pragma unroll
            for (int m = 0; m < 4; ++m) { const int row = row0 + ai * HALF + m * 16; const float r = rv[ai][m], rq = rr[ai][m];
                bf16_t* rowp = Y + (size_t)row * EPI_LDV + col0;
#pragma unroll
                for (int bj = 0; bj < 2; ++bj) { const u32x4 o = *(const PG8_GAS u32x4*)(rowp + bj * HALF); const f32x4 oa = bf4_lo(o), ob = bf4_hi(o);
                    const f32x2 op[4] = {(f32x2){oa[0], oa[1]}, (f32x2){oa[2], oa[3]}, (f32x2){ob[0], ob[1]}, (f32x2){ob[2], ob[3]}};
                    f32x2 fa[4], e[4], q[4];
#pragma unroll
                    for (int j = 0; j < 4; ++j) { const i32x4 ia = __builtin_bit_cast(i32x4, acc[ai][bj][m][j >> 1]); fa[j] = (f32x2){(float)ia[2 * (j & 1)], (float)ia[2 * (j & 1) + 1]}; }
#pragma unroll
                    for (int j = 0; j < 4; ++j) { const f32x2 t = fa[j] * (kl[bj][j] * r); e[j] = (f32x2){__builtin_amdgcn_exp2f(t.x), __builtin_amdgcn_exp2f(t.y)}; }
#pragma unroll
                    for (int j = 0; j < 4; ++j) { q[j] = (fa[j] * op[j]) * (kk[bj][j] * rq); e[j] = e[j] + 1.0f; }
#pragma unroll
                    for (int j = 0; j < 4; ++j) e[j] = (f32x2){__builtin_amdgcn_rcpf(e[j].x), __builtin_amdgcn_rcpf(e[j].y)};
#pragma unroll
                    for (int j = 0; j < 4; ++j) q[j] = q[j] * e[j];
                    u32x4 w; w.x = cvt_pk_bf16(q[0].x, q[0].y); w.y = cvt_pk_bf16(q[1].x, q[1].y); w.z = cvt_pk_bf16(q[2].x, q[2].y); w.w = cvt_pk_bf16(q[3].x, q[3].y);
                    *(PG8_GAS u32x4*)(rowp + bj * HALF) = w; }
                if (m & 1) asm volatile("" ::: "memory"); }
    }
};
template <class Inner> struct EpiDeq {
    static constexpr bool PERM = true, AFTER_DRAIN = false; static_assert(Inner::PERM, "EpiDeq: column map of PERM epilogues");
    Inner in; const float* cw;
    __device__ __forceinline__ void operator()(f32x4 (&acc)[2][2][4][2], const Unit& u, int wr, int wc, int fr, int fq) const {
        const int wcol0 = u.pn * BM + wc * 32 + 8 * fq;
#pragma unroll
        for (int bj = 0; bj < 2; ++bj)
#pragma unroll
            for (int n = 0; n < 2; ++n) { const f32x4 cv = *(const PG8_GAS f32x4*)(cw + wcol0 + bj * HALF + 4 * n);
#pragma unroll
                for (int ai = 0; ai < 2; ++ai)
#pragma unroll
                    for (int m = 0; m < 4; ++m) { const i32x4 iv = __builtin_bit_cast(i32x4, acc[ai][bj][m][n]); acc[ai][bj][m][n] = (f32x4){(float)iv[0], (float)iv[1], (float)iv[2], (float)iv[3]} * cv; } }
        in(acc, u, wr, wc, fr, fq);
    }
};
struct RowSsq {
    unsigned* xbuf;
    unsigned* cnt;
    unsigned* tmo;
    float eps; unsigned code;
    __device__ __forceinline__ bool run(const f32x4 (&v)[2][2][4][2], int panel, int pn, int wr, int wc, int fr, int fq, PG8_LAS unsigned char* lds, int wid, int lane) const {
        PG8_LAS float* P = (PG8_LAS float*)lds;
        PG8_LAS float* S = (PG8_LAS float*)(lds + 8192);
        PG8_LAS unsigned* flag = (PG8_LAS unsigned*)(lds + 8192 + 2048);
#pragma unroll
        for (int ai = 0; ai < 2; ++ai)
#pragma unroll
            for (int m = 0; m < 4; ++m) { float s = 0.f;
#pragma unroll
                for (int bj = 0; bj < 2; ++bj)
#pragma unroll
                    for (int n = 0; n < 2; ++n) { const f32x4 x = v[ai][bj][m][n]; s += (x[0] * x[0] + x[1] * x[1]) + (x[2] * x[2] + x[3] * x[3]); }
                s += __shfl_xor(s, 16); s += __shfl_xor(s, 32);
                if (fq == 0) P[(ai * HALF + wr * 64 + m * 16 + fr) * 4 + wc] = s; }
        asm volatile("s_waitcnt lgkmcnt(0)" ::: "memory"); __builtin_amdgcn_s_barrier(); asm volatile("" ::: "memory");
        const int row = wid * 32 + (lane & 31);
        if (lane < 32) { const float t = (P[row * 4 + 0] + P[row * 4 + 1]) + (P[row * 4 + 2] + P[row * 4 + 3]);
            unsigned long long* slot = (unsigned long long*)xbuf + ((size_t)(panel * BM + row) * 4 + pn);
            __hip_atomic_store(slot, (unsigned long long)__float_as_uint(t), __ATOMIC_RELAXED, __HIP_MEMORY_SCOPE_AGENT); }
        asm volatile("s_waitcnt vmcnt(0)" ::: "memory");
        if (lane == 0) __hip_atomic_fetch_add(cnt + 64 * panel, 1u, __ATOMIC_RELAXED, __HIP_MEMORY_SCOPE_AGENT);
        if (wid == 0) {
            bool dead = false; const unsigned long long t0 = __builtin_amdgcn_s_memrealtime(); const unsigned want = 32u;
            for (;;) {
                if ((unsigned)__builtin_amdgcn_readfirstlane(__hip_atomic_load(cnt + 64 * panel, __ATOMIC_RELAXED, __HIP_MEMORY_SCOPE_AGENT)) >= want) break;
                if (__builtin_amdgcn_s_memrealtime() - t0 > 2000000ull) {
                    if (lane == 0) { unsigned expect = 0u; __hip_atomic_compare_exchange_strong(tmo + 1, &expect, code | (unsigned)(panel & 0xff), __ATOMIC_RELAXED, __ATOMIC_RELAXED, __HIP_MEMORY_SCOPE_AGENT);
                                     __hip_atomic_store(tmo, 1u, __ATOMIC_RELAXED, __HIP_MEMORY_SCOPE_AGENT); }
                    dead = true; break; }
                __builtin_amdgcn_s_sleep(2);
            }
            __builtin_amdgcn_fence(__ATOMIC_ACQUIRE, "agent");
            if (lane == 0) flag[0] = dead ? 1u : 0u;
        }
        asm volatile("s_waitcnt vmcnt(0) lgkmcnt(0)" ::: "memory"); __builtin_amdgcn_s_barrier(); asm volatile("" ::: "memory");
        const bool bad = flag[0] != 0u;
        if (lane < 32) { const unsigned long long* slot = (const unsigned long long*)xbuf + (size_t)(panel * BM + row) * 4; float tot = 0.f;
#pragma unroll
            for (int t = 0; t < 4; ++t) { const unsigned long long w = __hip_atomic_load(slot + t, __ATOMIC_RELAXED, __HIP_MEMORY_SCOPE_AGENT); tot += __uint_as_float((unsigned)w); }
            S[row] = 1.0f / sqrtf(tot * (1.0f / 1024.0f) + eps); }
        asm volatile("s_waitcnt lgkmcnt(0)" ::: "memory"); __builtin_amdgcn_s_barrier(); asm volatile("" ::: "memory");
        return bad;
    }
};
template <bool GATED> struct EpiRmsRes {
    static constexpr bool PERM = true, AFTER_DRAIN = true;
    bf16_t* xb; float* out32; float* rs; const float* gate; const float* g_post; float scale; int row_off;
    RowSsq st1, st2; unsigned poison;
    __device__ __forceinline__ void fused(f32x4 (&acc)[2][2][4][2], const Unit& u, int wr, int wc, int fr, int fq, PG8_LAS unsigned char* lds, int wid, int lane) const {
        const PG8_LAS float* S = (const PG8_LAS float*)(lds + 8192);
        const int col0 = u.pn * BM + wc * 32 + 8 * fq, prow0 = row_off + u.pm * BM, panel = prow0 >> 8;
        if (GATED) {
#pragma unroll
            for (int ai = 0; ai < 2; ++ai)
#pragma unroll
                for (int m = 0; m < 4; ++m) { const size_t off = (size_t)(prow0 + ai * HALF + wr * 64 + m * 16 + fr) * 1024 + col0;
#pragma unroll
                    for (int bj = 0; bj < 2; ++bj)
#pragma unroll
                        for (int n = 0; n < 2; ++n) { const f32x4 gv = *(const PG8_GAS f32x4*)(gate + off + bj * HALF + n * 4);
#pragma unroll
                            for (int x = 0; x < 4; ++x) acc[ai][bj][m][n][x] *= sigmoid_f(gv[x]); }
                    asm volatile("" : "+v"(acc[ai][0][m][0]), "+v"(acc[ai][0][m][1]), "+v"(acc[ai][1][m][0]), "+v"(acc[ai][1][m][1]) :: "memory"); }
        }
        bool bad = st1.run(acc, panel, u.pn, wr, wc, fr, fq, lds, wid, lane) || poison != 0u;
        const float qnan = __builtin_nanf("");
        {
            f32x4 gp[2][2];
#pragma unroll
            for (int bj = 0; bj < 2; ++bj)
#pragma unroll
                for (int n = 0; n < 2; ++n) gp[bj][n] = *(const PG8_GAS f32x4*)(g_post + col0 + bj * HALF + n * 4);
#pragma unroll
            for (int ai = 0; ai < 2; ++ai)
#pragma unroll
                for (int m = 0; m < 4; ++m) { const int r = ai * HALF + wr * 64 + m * 16 + fr; const float sr = S[r] * scale; const size_t off = (size_t)(prow0 + r) * 1024 + col0;
#pragma unroll
                    for (int bj = 0; bj < 2; ++bj) { const u32x4 xw = *(const PG8_GAS u32x4*)(xb + off + bj * HALF);
                        const f32x4 x0 = bf4_lo(xw) + acc[ai][bj][m][0] * gp[bj][0] * sr, x1 = bf4_hi(xw) + acc[ai][bj][m][1] * gp[bj][1] * sr;
                        if (out32) { *(PG8_GAS f32x4*)(out32 + off + bj * HALF) = bad ? (f32x4){qnan, qnan, qnan, qnan} : x0; *(PG8_GAS f32x4*)(out32 + off + bj * HALF + 4) = bad ? (f32x4){qnan, qnan, qnan, qnan} : x1; }
                        const u32x4 w = pack8(x0, x1); *(PG8_GAS u32x4*)(xb + off + bj * HALF) = w;
                        acc[ai][bj][m][0] = bf4_lo(w); acc[ai][bj][m][1] = bf4_hi(w); }
                    asm volatile("" : "+v"(acc[ai][0][m][0]), "+v"(acc[ai][0][m][1]), "+v"(acc[ai][1][m][0]), "+v"(acc[ai][1][m][1]));
                    if (m & 1) asm volatile("" ::: "memory"); }
        }
        bad = st2.run(acc, panel, u.pn, wr, wc, fr, fq, lds, wid, lane) || bad;
        if (u.pn == 0 && wc == 0 && fq == 0) {
#pragma unroll
            for (int ai = 0; ai < 2; ++ai)
#pragma unroll
                for (int m = 0; m < 4; ++m) { const int r = ai * HALF + wr * 64 + m * 16 + fr; rs[prow0 + r] = bad ? qnan : S[r]; }
        }
    }
};

template <bool GATED> struct EpiRmsRes1 {
    static constexpr bool PERM = true, AFTER_DRAIN = true, XKEEP = false;
    unsigned char* wsb; float* out32; const float* g_post; float scale, eps; int cnt_word; PG8_LAS unsigned char* tab; unsigned poison; int row_off;
    static constexpr size_t O_XB = EPI_WS_XB, O_RS = EPI_WS_RS, O_GATE = EPI_WS_GATE, O_XBUF = EPI_WS_XBUF;
    __device__ __forceinline__ void fused(f32x4 (&acc)[2][2][4][2], const Unit& u, int wr, int wc, int fr, int fq, PG8_LAS unsigned char*, int wid, int lane) const {
        typedef float f32x2v __attribute__((ext_vector_type(2)));
        PG8_LAS f32x4* P = (PG8_LAS f32x4*)tab;
        PG8_LAS f32x2v* S = (PG8_LAS f32x2v*)(tab + 16384);
        PG8_LAS unsigned* flag = (PG8_LAS unsigned*)(tab + 16384 + 2048);
        bf16_t* const xb = (bf16_t*)(wsb + O_XB); float* const rs = (float*)(wsb + O_RS); const float* const gate = (const float*)(wsb + O_GATE);
        unsigned* const xbuf = (unsigned*)(wsb + O_XBUF); unsigned* const tmo = (unsigned*)wsb; unsigned* const cnt = (unsigned*)wsb + cnt_word;
        const int col0 = u.pn * BM + wc * 32 + 8 * fq, prow0 = row_off + u.pm * BM, panel = prow0 >> 8;
        u32x4 xk[4][2];
#pragma unroll
        for (int m = 0; m < 4; ++m)
#pragma unroll
            for (int bj = 0; bj < 2; ++bj) xk[m][bj] = XKEEP ? *(const PG8_GAS u32x4*)(xb + (size_t)(prow0 + wr * 64 + m * 16 + fr) * 1024 + col0 + bj * HALF) : (u32x4){0u, 0u, 0u, 0u};
        if (GATED) {
#pragma unroll
            for (int ai = 0; ai < 2; ++ai)
#pragma unroll
                for (int m = 0; m < 4; ++m) { const size_t off = (size_t)(prow0 + ai * HALF + wr * 64 + m * 16 + fr) * 1024 + col0;
#pragma unroll
                    for (int bj = 0; bj < 2; ++bj)
#pragma unroll
                        for (int n = 0; n < 2; ++n) { const f32x4 gv = *(const PG8_GAS f32x4*)(gate + off + bj * HALF + n * 4);
#pragma unroll
                            for (int x = 0; x < 4; ++x) acc[ai][bj][m][n][x] *= sigmoid_f(gv[x]); }
                    asm volatile("" : "+v"(acc[ai][0][m][0]), "+v"(acc[ai][0][m][1]), "+v"(acc[ai][1][m][0]), "+v"(acc[ai][1][m][1])); }
        }
        f32x4 gp[2][2];
#pragma unroll
        for (int bj = 0; bj < 2; ++bj)
#pragma unroll
            for (int n = 0; n < 2; ++n) gp[bj][n] = *(const PG8_GAS f32x4*)(g_post + col0 + bj * HALF + n * 4);
#pragma unroll
        for (int ai = 0; ai < 2; ++ai)
#pragma unroll
            for (int m = 0; m < 4; ++m) { float sa = 0.f, sb = 0.f, sc = 0.f, sd = 0.f;
#pragma unroll
                for (int bj = 0; bj < 2; ++bj) { u32x4 xv; if (ai == 0 && XKEEP) xv = xk[m][bj]; else xv = *(const PG8_GAS u32x4*)(xb + (size_t)(prow0 + ai * HALF + wr * 64 + m * 16 + fr) * 1024 + col0 + bj * HALF);
                    const f32x4 xl = bf4_lo(xv), xh = bf4_hi(xv);
#pragma unroll
                    for (int x = 0; x < 4; ++x) { const float h0 = acc[ai][bj][m][0][x], h1 = acc[ai][bj][m][1][x], g0 = gp[bj][0][x] * h0, g1 = gp[bj][1][x] * h1;
                        sa += h0 * h0 + h1 * h1; sc += g0 * g0 + g1 * g1; sb += xl[x] * g0 + xh[x] * g1; sd += xl[x] * xl[x] + xh[x] * xh[x]; } }
                sa += __shfl_xor(sa, 16); sb += __shfl_xor(sb, 16); sc += __shfl_xor(sc, 16); sd += __shfl_xor(sd, 16);
                sa += __shfl_xor(sa, 32); sb += __shfl_xor(sb, 32); sc += __shfl_xor(sc, 32); sd += __shfl_xor(sd, 32);
                if (fq == 0) P[(ai * HALF + wr * 64 + m * 16 + fr) * 4 + wc] = (f32x4){sa, sb, sc, sd};
                if (ai == 0 && XKEEP) asm volatile("" : "+v"(xk[m][0]), "+v"(xk[m][1]));
                asm volatile("" : "+v"(acc[ai][0][m][0]), "+v"(acc[ai][0][m][1]), "+v"(acc[ai][1][m][0]), "+v"(acc[ai][1][m][1]) :: "memory"); }
        asm volatile("s_waitcnt lgkmcnt(0)" ::: "memory"); __builtin_amdgcn_s_barrier(); asm volatile("" ::: "memory");
        const int row = wid * 32 + (lane & 31);
        if (lane < 32) { const f32x4 t = (P[row * 4 + 0] + P[row * 4 + 1]) + (P[row * 4 + 2] + P[row * 4 + 3]);
            unsigned long long* slot = (unsigned long long*)xbuf + ((size_t)(prow0 + row) * 4 + u.pn) * 2;
            __hip_atomic_store(slot, ((unsigned long long)__float_as_uint(t[1]) << 32) | __float_as_uint(t[0]), __ATOMIC_RELAXED, __HIP_MEMORY_SCOPE_AGENT);
            __hip_atomic_store(slot + 1, ((unsigned long long)__float_as_uint(t[3]) << 32) | __float_as_uint(t[2]), __ATOMIC_RELAXED, __HIP_MEMORY_SCOPE_AGENT); }
        asm volatile("s_waitcnt vmcnt(0)" ::: "memory");
        if (lane == 0) __hip_atomic_fetch_add(cnt + 64 * panel, 1u, __ATOMIC_RELAXED, __HIP_MEMORY_SCOPE_AGENT);
        if (wid == 0) {
            bool dead = false; const unsigned long long t0 = __builtin_amdgcn_s_memrealtime();
            for (;;) {
                if ((unsigned)__builtin_amdgcn_readfirstlane(__hip_atomic_load(cnt + 64 * panel, __ATOMIC_RELAXED, __HIP_MEMORY_SCOPE_AGENT)) >= 32u) break;
                if (__builtin_amdgcn_s_memrealtime() - t0 > 2000000ull) {
                    if (lane == 0) { unsigned expect = 0u; __hip_atomic_compare_exchange_strong(tmo + 1, &expect, 0x700u | (unsigned)(panel & 0xff), __ATOMIC_RELAXED, __ATOMIC_RELAXED, __HIP_MEMORY_SCOPE_AGENT);
                                     __hip_atomic_store(tmo, 1u, __ATOMIC_RELAXED, __HIP_MEMORY_SCOPE_AGENT); }
                    dead = true; break; }
                __builtin_amdgcn_s_sleep(1);
            }
            __builtin_amdgcn_fence(__ATOMIC_ACQUIRE, "agent");
            if (lane == 0) flag[0] = dead ? 1u : 0u;
        }
        asm volatile("s_waitcnt vmcnt(0) lgkmcnt(0)" ::: "memory"); __builtin_amdgcn_s_barrier(); asm volatile("" ::: "memory");
        const bool bad = flag[0] != 0u || poison != 0u;
        if (lane < 32) { const unsigned long long* slot = (const unsigned long long*)xbuf + (size_t)(prow0 + row) * 8; float ta = 0.f, tb = 0.f, tc = 0.f, td = 0.f;
#pragma unroll
            for (int t = 0; t < 4; ++t) { const unsigned long long w0 = __hip_atomic_load(slot + 2 * t, __ATOMIC_RELAXED, __HIP_MEMORY_SCOPE_AGENT), w1 = __hip_atomic_load(slot + 2 * t + 1, __ATOMIC_RELAXED, __HIP_MEMORY_SCOPE_AGENT);
                ta += __uint_as_float((unsigned)w0); tb += __uint_as_float((unsigned)(w0 >> 32)); tc += __uint_as_float((unsigned)w1); td += __uint_as_float((unsigned)(w1 >> 32)); }
            const float r1 = scale / sqrtf(ta * (1.0f / 1024.0f) + eps); const float s1 = td + r1 * ((tb + tb) + r1 * tc);
            S[row] = (f32x2v){r1, 1.0f / sqrtf(fmaxf(s1, 0.f) * (1.0f / 1024.0f) + eps)}; }
        asm volatile("s_waitcnt lgkmcnt(0)" ::: "memory"); __builtin_amdgcn_s_barrier(); asm volatile("" ::: "memory");
        const float qnan = __builtin_nanf("");
#pragma unroll
        for (int bj = 0; bj < 2; ++bj)
#pragma unroll
            for (int n = 0; n < 2; ++n) gp[bj][n] = *(const PG8_GAS f32x4*)(g_post + col0 + bj * HALF + n * 4);
#pragma unroll
        for (int ai = 0; ai < 2; ++ai)
#pragma unroll
            for (int m = 0; m < 4; ++m) { const int r = ai * HALF + wr * 64 + m * 16 + fr; const f32x2v sr = S[r]; const size_t off = (size_t)(prow0 + r) * 1024 + col0;
#pragma unroll
                for (int bj = 0; bj < 2; ++bj) { u32x4 xv; if (ai == 0 && XKEEP) xv = xk[m][bj]; else xv = *(const PG8_GAS u32x4*)(xb + off + bj * HALF);
                    f32x4 x0 = bf4_lo(xv) + acc[ai][bj][m][0] * gp[bj][0] * sr.x, x1 = bf4_hi(xv) + acc[ai][bj][m][1] * gp[bj][1] * sr.x;
                    if (bad) { x0 = (f32x4){qnan, qnan, qnan, qnan}; x1 = x0; }
                    if (out32) { *(PG8_GAS f32x4*)(out32 + off + bj * HALF) = x0; *(PG8_GAS f32x4*)(out32 + off + bj * HALF + 4) = x1; }
                    *(PG8_GAS u32x4*)(xb + off + bj * HALF) = pack8(x0, x1); }
                if (u.pn == 0 && wc == 0 && fq == 0) rs[prow0 + r] = bad ? qnan : sr.y; }
    }
};

template <bool I8> __device__ __forceinline__ f32x4 mma_frag(const bf16x8 b, const bf16x8 a, const f32x4 c) {
    if constexpr (I8) return __builtin_bit_cast(f32x4, __builtin_amdgcn_mfma_i32_16x16x64_i8(__builtin_bit_cast(i32x4, b), __builtin_bit_cast(i32x4, a), __builtin_bit_cast(i32x4, c), 0, 0, 0));
    else return __builtin_amdgcn_mfma_f32_16x16x32_bf16(b, a, c, 0, 0, 0);
}
struct NoPre {};
template <class E, class = void> struct epi_has_pre { static constexpr bool value = false; };
template <class E> struct epi_has_pre<E, decltype((void)E::HAS_PRE)> { static constexpr bool value = E::HAS_PRE; };
template <class E, bool H> struct epi_pre_t { typedef NoPre type; };
template <class E> struct epi_pre_t<E, true> { typedef typename E::Pre type; };
template <class Epi, class Sched, bool ALIGN_EPI = false, bool SP2 = false, bool I8 = false, bool BNT = false  >
__device__ __forceinline__ void gemm_phase(PG8_LAS unsigned char* lds, const Gemm g, const Sched& S, const Epi& E, int wave  ) {
    int tid_; asm volatile("v_mbcnt_lo_u32_b32 %0, -1, 0\n\tv_mbcnt_hi_u32_b32 %0, -1, %0" : "=v"(tid_)); tid_ += wave * 64;
    const int tid = tid_, wid = __builtin_amdgcn_readfirstlane(tid >> 6), lane = tid & 63, wr = wid >> 2, wc = wid & 3, fr = lane & 15, fq = lane >> 4;
    int K_ = g.K; asm volatile("" : "+s"(K_));
    const int K = K_, nt = K / BK;
    int lda_ = g.lda ? g.lda : g.K; asm volatile("" : "+s"(lda_)); const int lda = lda_;
    unsigned voffA[2], voffB[2];
#pragma unroll
    for (int i = 0; i < 2; ++i) { int R, C; stage_rc(tid * 16 + i * 8192, R, C); const int Rb = Epi::PERM ? ((R & ~31) + perm32(R & 31)) : R;
        voffA[i] = (unsigned)(R * lda + C) * 2u; voffB[i] = (unsigned)(Rb * K + C) * 2u; }
    const size_t kstep = (size_t)(BK * 2);
    const size_t hstep = (size_t)HALF * K * 2;
    const size_t hstepA = (size_t)HALF * lda * 2, tstepA = 2 * hstepA;
    const size_t tstep = 2 * hstep;
    const unsigned ldsw = (unsigned)wid * 1024u;
    const int aoff = lds_byte(wr * 64 + fr, fq * 8), boff = lds_byte(wc * 32 + fr, fq * 8);
#define PG8_SA(b, h) (((b) * 2 + (h)) * HTB)
#define PG8_SB(b, h) ((4 + (b) * 2 + (h)) * HTB)
#if PG8_ASM_STAGE
    const unsigned ldsb = (unsigned)__builtin_amdgcn_readfirstlane((int)(unsigned)(size_t)lds) + ldsw;
#define PG8_STAGE(bufoff, gbase, voff) do { _Pragma("unroll") for (int _i = 0; _i < 2; ++_i) { unsigned keep_; \
        asm volatile("s_mov_b32 %0, m0\n\ts_mov_b32 m0, %3\n\ts_nop 0\n\tglobal_load_lds_dwordx4 %1, %2\n\ts_mov_b32 m0, %0" : "=&s"(keep_) : "v"((voff)[_i]), "s"((const char*)(gbase)), "s"(ldsb + (unsigned)((bufoff) + _i * 8192)) : "memory"); } } while (0)
#define PG8_STAGE_B(bufoff, gbase, voff) do { if constexpr (BNT) { _Pragma("unroll") for (int _i = 0; _i < 2; ++_i) { unsigned keep_; \
        asm volatile("s_mov_b32 %0, m0\n\ts_mov_b32 m0, %3\n\ts_nop 0\n\tglobal_load_lds_dwordx4 %1, %2 nt\n\ts_mov_b32 m0, %0" : "=&s"(keep_) : "v"((voff)[_i]), "s"((const char*)(gbase)), "s"(ldsb + (unsigned)((bufoff) + _i * 8192)) : "memory"); } } else PG8_STAGE(bufoff, gbase, voff); } while (0)
#else
#define PG8_STAGE(bufoff, gbase, voff) do { _Pragma("unroll") for (int _i = 0; _i < 2; ++_i) \
        __builtin_amdgcn_global_load_lds((const unsigned*)((const char*)(gbase) + (voff)[_i]), (PG8_LAS unsigned*)(lds + (bufoff) + ldsw + _i * 8192), 16, 0, 0); } while (0)
#define PG8_STAGE_B(bufoff, gbase, voff) PG8_STAGE(bufoff, gbase, voff)
#endif
#define PG8_LDA(dst, b, h) do { _Pragma("unroll") for (int m = 0; m < 4; ++m) _Pragma("unroll") for (int k = 0; k < 2; ++k) dst[m][k] = *(const PG8_LAS bf16x8*)(lds + PG8_SA(b, h) + aoff + m * 2048 + k * 1024); } while (0)
#define PG8_LDB(dst, b, h) do { _Pragma("unroll") for (int n = 0; n < 2; ++n) _Pragma("unroll") for (int k = 0; k < 2; ++k) dst[n][k] = *(const PG8_LAS bf16x8*)(lds + PG8_SB(b, h) + boff + n * 2048 + k * 1024); } while (0)
#define PG8_MMA(ai, bj, At, Bt) do { __builtin_amdgcn_s_setprio(1); _Pragma("unroll") for (int m = 0; m < 4; ++m) _Pragma("unroll") for (int n = 0; n < 2; ++n) _Pragma("unroll") for (int k = 0; k < 2; ++k) \
        acc[ai][bj][m][n] = mma_frag<I8>(Bt[n][k], At[m][k], acc[ai][bj][m][n]); __builtin_amdgcn_s_setprio(0); } while (0)
#define PG8_WAIT_V(n) asm volatile("s_waitcnt vmcnt(" #n ")" ::: "memory")
#define PG8_WAIT_L(n) asm volatile("s_waitcnt lgkmcnt(" #n ")" ::: "memory")
#define PG8_BAR __builtin_amdgcn_s_barrier()
#define PG8_SCHED __builtin_amdgcn_sched_barrier(0)
    Unit cur, nxt; int ui = 0;
    typename epi_pre_t<Epi, epi_has_pre<Epi>::value>::type pre;
    if (!S.next(0, cur)) return;
    f32x4 acc[2][2][4][2];
#pragma unroll
    for (int a = 0; a < 2; ++a)
#pragma unroll
        for (int b = 0; b < 2; ++b)
#pragma unroll
            for (int m = 0; m < 4; ++m)
#pragma unroll
                for (int n = 0; n < 2; ++n) acc[a][b][m][n] = (f32x4){0.f, 0.f, 0.f, 0.f};
    bf16x8 At[4][2], B0[2][2], B1[2][2];
    const char* cA = (const char*)g.A + (size_t)cur.pm * tstepA; const char* cB = (const char*)g.Bt + (size_t)cur.pn * tstep;
    S.a_ready(cur);
    if constexpr (SP2) {
        PG8_STAGE_B(PG8_SB(0, 0), cB, voffB); PG8_STAGE_B(PG8_SB(0, 1), cB + hstep, voffB); PG8_STAGE(PG8_SA(0, 0), cA, voffA); PG8_STAGE(PG8_SA(0, 1), cA + hstepA, voffA);
        if (wr == 1) PG8_BAR;
        PG8_WAIT_V(2); PG8_BAR;
        PG8_STAGE_B(PG8_SB(1, 0), cB + kstep, voffB); PG8_STAGE(PG8_SA(1, 0), cA + kstep, voffA); PG8_STAGE_B(PG8_SB(1, 1), cB + hstep + kstep, voffB);
        PG8_WAIT_V(6); PG8_BAR;
    } else {
        PG8_STAGE_B(PG8_SB(0, 0), cB, voffB); PG8_STAGE(PG8_SA(0, 0), cA, voffA); PG8_STAGE_B(PG8_SB(0, 1), cB + hstep, voffB); PG8_STAGE(PG8_SA(0, 1), cA + hstepA, voffA);
        if (wr == 1) PG8_BAR;
        PG8_WAIT_V(4); PG8_BAR;
        PG8_STAGE_B(PG8_SB(1, 0), cB + kstep, voffB); PG8_STAGE(PG8_SA(1, 0), cA + kstep, voffA); PG8_STAGE_B(PG8_SB(1, 1), cB + hstep + kstep, voffB);
        PG8_WAIT_V(6); PG8_BAR;
    }
    for (;;) {
        const bool has_next = S.next(ui + 1, nxt);
        const char* nA = has_next ? (const char*)g.A + (size_t)nxt.pm * tstepA : cA; const char* nB = has_next ? (const char*)g.Bt + (size_t)nxt.pn * tstep : cB;
        for (int t = 0; t < nt; t += 2) {
            const bool last = (t == nt - 2);
            if constexpr (epi_has_pre<Epi>::value) { if (last) pre = E.preload(cur, wr, wc, fr, fq); }
            const char* a1 = cA + (size_t)(t + 1) * kstep;
            const char* a2 = last ? nA : cA + (size_t)(t + 2) * kstep; const char* b2 = last ? nB : cB + (size_t)(t + 2) * kstep;
            const char* a3 = a2 + kstep; const char* b3 = b2 + kstep;
            if (last && has_next) S.a_ready(nxt);
            if constexpr (SP2) {
#if PG8_LATE_STAGE
            PG8_LDB(B0, 0, 0); PG8_LDB(B1, 0, 1); PG8_SCHED; PG8_LDA(At, 0, 0);
            PG8_WAIT_V(6); PG8_WAIT_L(0); PG8_BAR; PG8_MMA(0, 0, At, B0); PG8_STAGE(PG8_SA(1, 1), a1 + hstepA, voffA); PG8_MMA(0, 1, At, B1); PG8_BAR; PG8_SCHED;
            PG8_LDA(At, 0, 1);
            PG8_WAIT_V(2); PG8_WAIT_L(0); PG8_BAR; PG8_MMA(1, 0, At, B0); PG8_STAGE_B(PG8_SB(0, 0), b2, voffB); PG8_STAGE_B(PG8_SB(0, 1), b2 + hstep, voffB); PG8_STAGE(PG8_SA(0, 0), a2, voffA); PG8_MMA(1, 1, At, B1); PG8_BAR; PG8_SCHED;
            PG8_LDB(B0, 1, 0); PG8_LDB(B1, 1, 1); PG8_SCHED; PG8_LDA(At, 1, 0);
            PG8_WAIT_V(6); PG8_WAIT_L(0); PG8_BAR; PG8_MMA(0, 0, At, B0); PG8_STAGE(PG8_SA(0, 1), a2 + hstepA, voffA); PG8_MMA(0, 1, At, B1); PG8_BAR; PG8_SCHED;
            PG8_LDA(At, 1, 1);
            PG8_WAIT_V(2); PG8_WAIT_L(0); PG8_BAR; PG8_MMA(1, 0, At, B0); PG8_STAGE_B(PG8_SB(1, 0), b3, voffB); PG8_STAGE_B(PG8_SB(1, 1), b3 + hstep, voffB); PG8_STAGE(PG8_SA(1, 0), a3, voffA); PG8_MMA(1, 1, At, B1); PG8_BAR; PG8_SCHED;
#else
            PG8_LDB(B0, 0, 0); PG8_LDB(B1, 0, 1); PG8_SCHED; PG8_LDA(At, 0, 0); PG8_STAGE(PG8_SA(1, 1), a1 + hstepA, voffA);
            PG8_WAIT_V(8); PG8_WAIT_L(0); PG8_BAR; PG8_MMA(0, 0, At, B0); PG8_MMA(0, 1, At, B1); PG8_BAR; PG8_SCHED;
            PG8_LDA(At, 0, 1); PG8_STAGE_B(PG8_SB(0, 0), b2, voffB); PG8_STAGE_B(PG8_SB(0, 1), b2 + hstep, voffB); PG8_STAGE(PG8_SA(0, 0), a2, voffA);
            PG8_WAIT_V(8); PG8_WAIT_L(0); PG8_BAR; PG8_MMA(1, 0, At, B0); PG8_MMA(1, 1, At, B1); PG8_BAR; PG8_SCHED;
            PG8_LDB(B0, 1, 0); PG8_LDB(B1, 1, 1); PG8_SCHED; PG8_LDA(At, 1, 0); PG8_STAGE(PG8_SA(0, 1), a2 + hstepA, voffA);
            PG8_WAIT_V(8); PG8_WAIT_L(0); PG8_BAR; PG8_MMA(0, 0, At, B0); PG8_MMA(0, 1, At, B1); PG8_BAR; PG8_SCHED;
            PG8_LDA(At, 1, 1); PG8_STAGE_B(PG8_SB(1, 0), b3, voffB); PG8_STAGE_B(PG8_SB(1, 1), b3 + hstep, voffB); PG8_STAGE(PG8_SA(1, 0), a3, voffA);
            PG8_WAIT_V(8); PG8_WAIT_L(0); PG8_BAR; PG8_MMA(1, 0, At, B0); PG8_MMA(1, 1, At, B1); PG8_BAR; PG8_SCHED;
#endif
            } else {
            PG8_LDB(B0, 0, 0); PG8_SCHED; PG8_LDA(At, 0, 0); PG8_STAGE(PG8_SA(1, 1), a1 + hstepA, voffA);
            PG8_WAIT_L(8); PG8_BAR; PG8_WAIT_L(0); PG8_MMA(0, 0, At, B0); PG8_BAR; PG8_SCHED;
            PG8_LDB(B1, 0, 1); PG8_STAGE_B(PG8_SB(0, 0), b2, voffB);
            PG8_BAR; PG8_WAIT_L(0); PG8_MMA(0, 1, At, B1); PG8_BAR;
            PG8_LDA(At, 0, 1); PG8_STAGE(PG8_SA(0, 0), a2, voffA);
            PG8_BAR; PG8_WAIT_L(0); PG8_MMA(1, 0, At, B0); PG8_BAR; PG8_SCHED;
            PG8_STAGE_B(PG8_SB(0, 1), b2 + hstep, voffB);
            PG8_WAIT_V(6); PG8_BAR; PG8_MMA(1, 1, At, B1); PG8_BAR;
            PG8_LDB(B0, 1, 0); PG8_SCHED; PG8_LDA(At, 1, 0); PG8_STAGE(PG8_SA(0, 1), a2 + hstepA, voffA);
            PG8_WAIT_L(8); PG8_BAR; PG8_WAIT_L(0); PG8_MMA(0, 0, At, B0); PG8_BAR; PG8_SCHED;
            PG8_LDB(B1, 1, 1); PG8_STAGE_B(PG8_SB(1, 0), b3, voffB);
            PG8_BAR; PG8_WAIT_L(0); PG8_MMA(0, 1, At, B1); PG8_BAR;
            PG8_LDA(At, 1, 1); PG8_STAGE(PG8_SA(1, 0), a3, voffA);
            PG8_BAR; PG8_WAIT_L(0); PG8_MMA(1, 0, At, B0); PG8_BAR; PG8_SCHED;
            PG8_STAGE_B(PG8_SB(1, 1), b3 + hstep, voffB);
            PG8_WAIT_V(6); PG8_BAR; PG8_MMA(1, 1, At, B1); PG8_BAR;
            }
        }
        if constexpr (ALIGN_EPI) { if (wr == 0) PG8_BAR; }
        if constexpr (!Epi::AFTER_DRAIN) { if constexpr (epi_has_pre<Epi>::value) E(acc, cur, wr, wc, fr, fq, pre); else E(acc, cur, wr, wc, fr, fq); S.done(cur); }
        if (!has_next) break;
#pragma unroll
        for (int a = 0; a < 2; ++a)
#pragma unroll
            for (int b = 0; b < 2; ++b)
#pragma unroll
                for (int m = 0; m < 4; ++m)
#pragma unroll
                    for (int n = 0; n < 2; ++n) acc[a][b][m][n] = (f32x4){0.f, 0.f, 0.f, 0.f};
        cur = nxt; cA = nA; cB = nB; ++ui;
        if constexpr (ALIGN_EPI) { if (wr == 1) PG8_BAR; }
    }
    PG8_WAIT_V(0);
    if constexpr (!ALIGN_EPI) { if (wr == 0) PG8_BAR; }
    PG8_BAR;
    if constexpr (Epi::AFTER_DRAIN) { E.fused(acc, cur, wr, wc, fr, fq, lds, wid, lane); S.done(cur); }
#undef PG8_SA
#undef PG8_SB
#undef PG8_STAGE
#undef PG8_STAGE_B
#undef PG8_LDA
#undef PG8_LDB
#undef PG8_MMA
#undef PG8_WAIT_V
#undef PG8_WAIT_L
#undef PG8_BAR
#undef PG8_SCHED
}
}
#define GAS __attribute__((address_space(1)))
#define LAS __attribute__((address_space(3)))
typedef unsigned short bf16;
typedef unsigned v4u __attribute__((ext_vector_type(4)));
typedef float f32x4 __attribute__((ext_vector_type(4)));
typedef short bf16x8 __attribute__((ext_vector_type(8)));
typedef GAS unsigned gu32;
typedef GAS unsigned long long gu64;
#define RLX_AGENT __ATOMIC_RELAXED, __HIP_MEMORY_SCOPE_AGENT
#define LDS_WAIT() asm volatile("s_waitcnt lgkmcnt(0)" ::: "memory")
#define VM_WAIT() asm volatile("s_waitcnt vmcnt(0)" ::: "memory")
__device__ __forceinline__ unsigned long long rt() { return __builtin_amdgcn_s_memrealtime(); }
__device__ __forceinline__ unsigned f2bf(float f) { unsigned u = __builtin_bit_cast(unsigned, f); return (u + 0x7fffu + ((u >> 16) & 1u)) >> 16; }
__device__ __forceinline__ unsigned pk2(float lo, float hi) { return f2bf(lo) | (f2bf(hi) << 16); }

#define XB_TMO      128
#define XB_XCNT(j)  (256  + 64 * (j))
#define XB_XSUB(j)  (1280 + 64 * (j))
#define XB_XGEN(j)  (2304 + 64 * (j))
#define XB_TOP      3328
#define XB_TOPGEN   3392
#define XCD_BAR_WORDS 3456
#define XB_SPIN_CAP (1u << 18)

__device__ __forceinline__ unsigned xb_ld(unsigned* p)              { return __hip_atomic_load(p, __ATOMIC_RELAXED, __HIP_MEMORY_SCOPE_AGENT); }
__device__ __forceinline__ unsigned xb_add(unsigned* p, unsigned v) { return __hip_atomic_fetch_add(p, v, __ATOMIC_RELAXED, __HIP_MEMORY_SCOPE_AGENT); }
__device__ __forceinline__ unsigned xb_xcc_id() { return (unsigned)__builtin_amdgcn_s_getreg((3 << 11) | 20) & 0xFu; }
#define XB_SPIN(cond, bar) do { unsigned _sp = 0; while (cond) { __builtin_amdgcn_s_sleep(1); \
    if ((++_sp & 255u) == 0u) { if (xb_ld(&(bar)[XB_TMO])) break; if (_sp > XB_SPIN_CAP) { atomicAdd(&(bar)[XB_TMO], 1u); break; } } } } while (0)

struct XcdBarrier {
    unsigned* bar; unsigned x; int wave;
    volatile LAS unsigned* st;
};

__device__ __forceinline__ int cur_lane() { int r; asm volatile("v_mbcnt_lo_u32_b32 %0, -1, 0\n\tv_mbcnt_hi_u32_b32 %0, -1, %0" : "=v"(r)); return r; }
__device__ __forceinline__ bool xb_thread0(int wave) { return wave == 0 && cur_lane() == 0; }
__device__ __forceinline__ XcdBarrier xcd_barrier_post(unsigned* bar, volatile LAS unsigned* st, int wave) {
    XcdBarrier b; b.bar = bar; b.x = xb_xcc_id(); b.st = st; b.wave = wave;
    if (xb_thread0(wave)) (void)xb_add(&bar[XB_XCNT(b.x)], 1u);
    return b;
}
__device__ __forceinline__ void xcd_barrier_complete(unsigned* bar, unsigned x, unsigned& nloc, unsigned& nx) {
    const unsigned G = gridDim.x * gridDim.y * gridDim.z;
    unsigned sum, cnt, mine, sp = 0u;
    for (;;) {
        sum = 0u; cnt = 0u; mine = 0u;
#pragma unroll
        for (unsigned j = 0; j < 16; ++j) { const unsigned c = xb_ld(&bar[XB_XCNT(j)]); sum += c; cnt += (c > 0u) ? 1u : 0u; mine = (j == x) ? c : mine; }
        if (sum == G) break;
        __builtin_amdgcn_s_sleep(1);
        if ((++sp & 255u) == 0u) { if (xb_ld(&bar[XB_TMO])) break; if (sp > XB_SPIN_CAP) { atomicAdd(&bar[XB_TMO], 1u); break; } }
    }
    nloc = mine > 0u ? mine : 1u; nx = cnt > 0u ? cnt : 1u;
}

__device__ __forceinline__ void xcd_barrier(const XcdBarrier& b) {
    asm volatile("s_waitcnt vmcnt(0)" ::: "memory");
    __syncthreads();
    if (xb_thread0(b.wave)) {
        unsigned* bar = b.bar;
        __builtin_amdgcn_s_waitcnt(0);
        unsigned nloc = b.st[0], nx = b.st[1];
        if (nloc == 0u) { xcd_barrier_complete(bar, b.x, nloc, nx); b.st[0] = nloc; b.st[1] = nx; }
        const unsigned old = xb_add(&bar[XB_XSUB(b.x)], 1u);
        const unsigned gen = old / nloc;
        if (old + 1u == (gen + 1u) * nloc) {
            __builtin_amdgcn_fence(__ATOMIC_RELEASE, "agent");
            asm volatile("s_waitcnt vmcnt(0)" ::: "memory");
            const unsigned og = xb_add(&bar[XB_TOP], 1u);
            const unsigned tg = og / nx;
            if (og + 1u == (tg + 1u) * nx) xb_add(&bar[XB_TOPGEN], 1u);
            else XB_SPIN(xb_ld(&bar[XB_TOPGEN]) == tg, bar);
            __builtin_amdgcn_fence(__ATOMIC_ACQUIRE, "agent");
            xb_add(&bar[XB_XGEN(b.x)], 1u);
            asm volatile("s_waitcnt vmcnt(0)" ::: "memory");
        } else {
            XB_SPIN(xb_ld(&bar[XB_XGEN(b.x)]) == gen, bar);
            __builtin_amdgcn_fence(__ATOMIC_ACQUIRE, "agent");
            asm volatile("s_waitcnt vmcnt(0)" ::: "memory");
        }
    }
    __syncthreads();
}

#define GRP_SPIN_CAP (1u << 22)
struct GroupBar { gu32* cnt; volatile LAS unsigned* st; int wave; unsigned n; };
__device__ __forceinline__ void group_barrier(const GroupBar& gb) {
    asm volatile("s_waitcnt vmcnt(0)" ::: "memory");
    __syncthreads();
    if (xb_thread0(gb.wave)) {
        const unsigned gen = gb.st[0] + 1u; gb.st[0] = gen;
        (void)__hip_atomic_fetch_add(gb.cnt, 1u, RLX_AGENT);
        unsigned sp = 0u;
        while (__hip_atomic_load(gb.cnt, RLX_AGENT) < gb.n * gen) { __builtin_amdgcn_s_sleep(1); if (++sp > GRP_SPIN_CAP) break; }
        __builtin_amdgcn_fence(__ATOMIC_ACQUIRE, "agent");
        asm volatile("s_waitcnt vmcnt(0)" ::: "memory");
    }
    __syncthreads();
}
__device__ __forceinline__ unsigned grp_mode_decide(gu32* masks, int G) {
    unsigned ok = (G == 256) ? 1u : 0u;
    for (int x = 0; x < 8; ++x) { const unsigned m0 = __hip_atomic_load(masks + 64 * (8 * x), RLX_AGENT); ok &= (m0 != 0u && (m0 & (m0 - 1u)) == 0u) ? 1u : 0u;
        for (int y = 1; y < 8; ++y) ok &= (__hip_atomic_load(masks + 64 * (8 * x + y), RLX_AGENT) == m0) ? 1u : 0u; }
    return ok ? 1u : 2u;
}
#define RET_HD __host__ __device__ __forceinline__
RET_HD unsigned off_b(unsigned row, unsigned ch) { return 256u * row + 16u * (ch ^ (((row & 3u) << 2) | ((row >> 2) & 3u))); }
RET_HD unsigned koff(unsigned j, unsigned d) { return (d >> 7) * 32768u + off_b(j, (d & 127u) >> 3) + (d & 7u) * 2u; }
RET_HD unsigned vswz(unsigned j) { return ((j >> 1) & 1u) | (((j >> 2) & 3u) << 1); }
RET_HD unsigned voff(unsigned j, unsigned e) { return 128u * j + 16u * ((e >> 3) ^ vswz(j)) + (e & 7u) * 2u; }
RET_HD unsigned soff(unsigned e, unsigned d) { return (d >> 7) * 16384u + off_b(e, (d & 127u) >> 3) + (d & 7u) * 2u; }
constexpr unsigned RET_LDS_K = 0u, RET_LDS_V = 65536u, RET_LDS_S = 81920u, RET_LDS_END = 114688u;
#ifndef PG8_SP2
#define PG8_SP2 true
#endif
#ifndef PG8_ALIGN
#define PG8_ALIGN true
#endif
#ifndef GROUP_MERGE
#define GROUP_MERGE 1
#endif
#ifndef NORM_NT
#define NORM_NT 1
#endif
#if NORM_NT
#define NORM_LD(p) __builtin_nontemporal_load(p)
#else
#define NORM_LD(p) (*(p))
#endif
#ifndef XQ_PITCH
#define XQ_PITCH (2 * D)
#endif
#ifndef MK_PER_PHASE
#define MK_PER_PHASE 0
#endif
constexpr int NWAVES = 8;

constexpr int BATCH = 8, SEQ = 4096, D = 1024, FF = 2816, DPLE = 256, NHEAD = 4, DK = 256, DV = 512, CHUNK = 128, NCHUNK = SEQ / CHUNK;
constexpr int M = BATCH * SEQ;
constexpr int NRQKV = 2 * NHEAD * DK + NHEAD * DV;
constexpr float NORM_EPS = 1e-6f;
enum { FFN1_PRE = 0, FFN1_POST, MIX_PRE, MIX_POST, FFN2_PRE, FFN2_POST, PLE_PRE, PLE_POST };

constexpr size_t MiB = 1u << 20;
constexpr size_t WS_CTL = 0, CTL_ZERO_BYTES = 1 * MiB;
constexpr size_t WS_RS = 1 * MiB;
constexpr size_t WS_RA = 1 * MiB + 256 * 1024;
constexpr size_t WS_CW = 1 * MiB + 512 * 1024;
constexpr size_t WS_CW2 = 1 * MiB + 512 * 1024 + 96 * 1024;
constexpr size_t WS_COS = 2 * MiB, WS_SIN = 4 * MiB;
constexpr size_t WS_SSQ = 6 * MiB;
constexpr size_t WS_W = 10 * MiB;
constexpr size_t W_GU = 0, W_DN = (size_t)2 * FF * D, W_FFN = W_DN + (size_t)D * FF;
constexpr size_t W_LAYER = 2 * W_FFN + (size_t)D * DPLE + (size_t)D * D;
constexpr size_t W_PP = 2 * W_FFN, W_PG = W_PP + (size_t)D * DPLE;
constexpr size_t W_CCH = 2 * W_LAYER, W_CB = W_CCH + (size_t)2 * D * D, W_CO = W_CB + (size_t)D * D;
constexpr size_t W_RIN = W_CO + (size_t)D * D, W_ROUT = W_RIN + (size_t)6144 * D, W_END = W_ROUT + (size_t)D * 2048;
static_assert(W_END * 2 <= 96 * MiB, "weights fit 96 MiB");
constexpr size_t WS_STEP = 105 * MiB;
constexpr size_t WS_PB = 106 * MiB;
constexpr size_t WS_XN = 138 * MiB;
constexpr size_t WS_HBUF = 202 * MiB;
constexpr size_t WS_Q = WS_HBUF, WS_K = WS_HBUF + 64 * MiB;
constexpr size_t WS_XQ = WS_HBUF + 64 * MiB;
constexpr size_t WS_BIG = 330 * MiB;
constexpr size_t WS_V = WS_BIG, WS_U = WS_BIG, WS_AB = WS_BIG + (size_t)D * 2;
constexpr int LDV = FF, XQ_LD = XQ_PITCH;
static_assert(LDV == EPI_LDV, "epilogue copy of the row stride");
constexpr size_t WS_XB = 506 * MiB;
constexpr size_t WS_END = 508 * MiB;
static_assert(WS_BIG + (size_t)M * FF * 2 <= WS_XB, "ws map");
static_assert(EPI_WS_XB == WS_XN && EPI_WS_RS == WS_RS && EPI_WS_GATE == WS_HBUF && EPI_WS_XBUF == WS_XB && WS_CTL == 0, "the fused epilogue's copies of the workspace offsets");
constexpr int CW_TMO = 0, CW_CODE = 1, CW_BAR = 4096;

constexpr int RING_OFF = 0, RING_BYTES = 131072;
constexpr int LDSCTL_OFF = RING_BYTES, MISC_OFF = LDSCTL_OFF + 320;
constexpr int TAB_OFF = RING_BYTES + 1024, TAB_BYTES = 16384 + 2048 + 64;
constexpr int LDS_BYTES = 151552;
static_assert(TAB_OFF + TAB_BYTES <= LDS_BYTES && MISC_OFF + 128 <= TAB_OFF, "LDS map");

struct Frame {
    LAS unsigned char* lds;
    volatile LAS unsigned* MISC;
    gu32* ctl;
    int wave;
    int vcu, G;
};


__device__ __forceinline__ float wave_max(float v) {
#pragma unroll
    for (int o = 1; o < 64; o <<= 1) v = fmaxf(v, __shfl_xor(v, o));
    return v;
}
__device__ __forceinline__ unsigned q4(float a, float b, float c, float d) {
    return ((unsigned)(int)__builtin_rintf(a) & 0xffu) | (((unsigned)(int)__builtin_rintf(b) & 0xffu) << 8) | (((unsigned)(int)__builtin_rintf(c) & 0xffu) << 16) | ((unsigned)(int)__builtin_rintf(d) << 24);
}
__device__ __forceinline__ float wave_sum(float v) {
#pragma unroll
    for (int o = 1; o < 64; o <<= 1) v += __shfl_xor(v, o);
    return v;
}
__device__ __forceinline__ void p0_transpose_item(const float* W, int ldw, int K, bf16* WT, int k0, int ncol0, int drow0, LAS float* scr, int lane, const float* gk) {
    const int c = lane & 7;
    f32x4 ga = (f32x4){1.f, 1.f, 1.f, 1.f}, gb = ga;
    if (gk) { ga = *(const GAS f32x4*)(gk + k0 + 8 * c); gb = *(const GAS f32x4*)(gk + k0 + 8 * c + 4); }
#pragma unroll 8
    for (int i = 0; i < 32; ++i) { const int kk = 2 * i + (lane >> 5); scr[kk * 33 + (lane & 31)] = NORM_LD((const GAS float*)W + (size_t)(k0 + kk) * ldw + ncol0 + (lane & 31)); }
    LDS_WAIT(); asm volatile("" ::: "memory");
#pragma unroll
    for (int j = 0; j < 4; ++j) { const int n = (lane >> 3) + 8 * j; const LAS float* s = scr + (8 * c) * 33 + n;
        v4u o; o.x = pk2(s[0 * 33] * ga.x, s[1 * 33] * ga.y); o.y = pk2(s[2 * 33] * ga.z, s[3 * 33] * ga.w); o.z = pk2(s[4 * 33] * gb.x, s[5 * 33] * gb.y); o.w = pk2(s[6 * 33] * gb.z, s[7 * 33] * gb.w);
        *(GAS v4u*)(WT + (size_t)(drow0 + n) * K + k0 + 8 * c) = o; }
    LDS_WAIT(); asm volatile("" ::: "memory");
}
struct WJob { const float* W; int ldw, col0, K, N; bf16* WT; int glu_off; const float* gk; };
struct KArgs { const float* in[16]; float* out; unsigned char* ws; int ph_lo, ph_hi; };
__device__ __forceinline__ WJob wjob(const KArgs& a, bf16* wb, int j) {
    WJob r; const float* gains = a.in[2];
    if (j < 16) { const int l = j >> 3, k = j & 7; bf16* lw = wb + (size_t)l * W_LAYER; const float* g = gains + (size_t)l * 8 * D;
        switch (k) {
        case 0: r = WJob{a.in[3] + (size_t)l * D * FF, FF, 0, D, FF, lw + W_GU, 0, g + FFN1_PRE * D}; break;
        case 1: r = WJob{a.in[4] + (size_t)l * D * FF, FF, 0, D, FF, lw + W_GU, 128, g + FFN1_PRE * D}; break;
        case 2: r = WJob{a.in[5] + (size_t)l * D * FF, D, 0, FF, D, lw + W_DN, -1, nullptr}; break;
        case 3: r = WJob{a.in[6] + (size_t)l * D * FF, FF, 0, D, FF, lw + W_FFN + W_GU, 0, g + FFN2_PRE * D}; break;
        case 4: r = WJob{a.in[7] + (size_t)l * D * FF, FF, 0, D, FF, lw + W_FFN + W_GU, 128, g + FFN2_PRE * D}; break;
        case 5: r = WJob{a.in[8] + (size_t)l * D * FF, D, 0, FF, D, lw + W_FFN + W_DN, -1, nullptr}; break;
        case 6: r = WJob{a.in[14] + (size_t)l * DPLE * D, D, 0, DPLE, D, lw + W_PP, -1, nullptr}; break;
        default: r = WJob{a.in[15] + (size_t)l * D * D, D, 0, D, D, lw + W_PG, -1, g + PLE_PRE * D}; break;
        }
        return r; }
    switch (j) {
    case 16: r = WJob{a.in[9], 3 * D, 0, D, D, wb + W_CB, -1, gains + MIX_PRE * D}; break;
    case 17: r = WJob{a.in[9], 3 * D, D, D, D, wb + W_CCH, 0, gains + MIX_PRE * D}; break;
    case 18: r = WJob{a.in[9], 3 * D, 2 * D, D, D, wb + W_CCH, 128, gains + MIX_PRE * D}; break;
    case 19: r = WJob{a.in[11], D, 0, D, D, wb + W_CO, -1, nullptr}; break;
    case 20: r = WJob{a.in[12], 6144, 0, D, NRQKV, wb + W_RIN, -1, gains + (size_t)8 * D + MIX_PRE * D}; break;
    default: r = WJob{a.in[13], D, 0, 2048, D, wb + W_ROUT, -1, nullptr}; break;
    }
    return r;
}
constexpr int N_WJOBS = 22;

__device__ __forceinline__ void xb_rows(Frame& F, const float* xsrc, bf16* xb, float* rs, signed char* xq, float* ra) {
    const int gw = F.vcu * NWAVES + F.wave, NGW = F.G * NWAVES;
    int lane = cur_lane(); asm volatile("" : "+v"(lane));
    for (int m = gw; m < M; m += NGW) {
        const GAS f32x4* xr = (const GAS f32x4*)(xsrc + (size_t)m * D) + lane;
        float s2 = 0.f, am = 0.f; f32x4 z[4];
#pragma unroll
        for (int j = 0; j < 4; ++j) { const f32x4 v = NORM_LD(xr + 64 * j); const unsigned w0 = pk2(v.x, v.y), w1 = pk2(v.z, v.w);
            z[j] = (f32x4){__uint_as_float(w0 << 16), __uint_as_float(w0 & 0xffff0000u), __uint_as_float(w1 << 16), __uint_as_float(w1 & 0xffff0000u)};
            s2 += (z[j].x * z[j].x + z[j].y * z[j].y) + (z[j].z * z[j].z + z[j].w * z[j].w); am = fmaxf(fmaxf(am, fmaxf(fabsf(z[j].x), fabsf(z[j].y))), fmaxf(fabsf(z[j].z), fabsf(z[j].w)));
            }
        const float r2 = 1.f / sqrtf(wave_sum(s2) * (1.f / D) + NORM_EPS); am = wave_max(am); const float qs = am > 0.f ? 127.f / am : 0.f;
        GAS unsigned* oq = (GAS unsigned*)(xq + (size_t)m * XQ_LD) + lane;
#pragma unroll
        for (int j = 0; j < 4; ++j) oq[64 * j] = q4(z[j].x * qs, z[j].y * qs, z[j].z * qs, z[j].w * qs);
        if (lane == 0) { ((GAS float*)rs)[m] = r2; ((GAS float*)ra)[m] = r2 * am * (1.f / 127.f); }
    }
}

template <bool XF32  >
__device__ __forceinline__ void norm_pair(const bf16* hsrc, bf16* xb, float* rs, float scale, float* out32, signed char* xq, float* ra, const int m0, const int lane, const f32x4 (&gp)[2][2], const float omul, const int xq_ld, const float* x32) {
    v4u hw[2][2], xw[2][2]; f32x4 xf[2][2][2];
#pragma unroll
    for (int q = 0; q < 2; ++q)
#pragma unroll
        for (int j = 0; j < 2; ++j) { hw[q][j] = NORM_LD((const GAS v4u*)(hsrc + (size_t)(m0 + q) * D + 512 * j + 8 * lane));
            if constexpr (XF32) { xf[q][j][0] = NORM_LD((const GAS f32x4*)(x32 + (size_t)(m0 + q) * D + 512 * j + 8 * lane)); xf[q][j][1] = NORM_LD((const GAS f32x4*)(x32 + (size_t)(m0 + q) * D + 512 * j + 8 * lane + 4)); }
            else xw[q][j] = NORM_LD((const GAS v4u*)(xb + (size_t)(m0 + q) * D + 512 * j + 8 * lane)); }
#pragma unroll
    for (int q = 0; q < 2; ++q) {
        f32x4 h[2][2], x[2][2]; float s = 0.f;
#pragma unroll
        for (int j = 0; j < 2; ++j) { h[j][0] = pg8::bf4_lo(hw[q][j]); h[j][1] = pg8::bf4_hi(hw[q][j]); if constexpr (XF32) { x[j][0] = xf[q][j][0]; x[j][1] = xf[q][j][1]; } else { x[j][0] = pg8::bf4_lo(xw[q][j]); x[j][1] = pg8::bf4_hi(xw[q][j]); }
#pragma unroll
            for (int n = 0; n < 2; ++n) s += (h[j][n].x * h[j][n].x + h[j][n].y * h[j][n].y) + (h[j][n].z * h[j][n].z + h[j][n].w * h[j][n].w); }
        const float r1 = scale / sqrtf(wave_sum(s) * (1.f / D) + NORM_EPS); float s2 = 0.f;
#pragma unroll
        for (int j = 0; j < 2; ++j) { const f32x4 y0 = x[j][0] + h[j][0] * gp[j][0] * r1, y1 = x[j][1] + h[j][1] * gp[j][1] * r1;
            if (out32) { __builtin_nontemporal_store(y0 * omul, (GAS f32x4*)(out32 + (size_t)(m0 + q) * D + 512 * j + 8 * lane)); __builtin_nontemporal_store(y1 * omul, (GAS f32x4*)(out32 + (size_t)(m0 + q) * D + 512 * j + 8 * lane + 4)); }
            const v4u w = pg8::pack8(y0, y1); if (!out32) *(GAS v4u*)(xb + (size_t)(m0 + q) * D + 512 * j + 8 * lane) = w;
            const f32x4 z0 = pg8::bf4_lo(w), z1 = pg8::bf4_hi(w); s2 += ((z0.x * z0.x + z0.y * z0.y) + (z0.z * z0.z + z0.w * z0.w)) + ((z1.x * z1.x + z1.y * z1.y) + (z1.z * z1.z + z1.w * z1.w));
            x[j][0] = z0; x[j][1] = z1; }
        const float r2 = 1.f / sqrtf(wave_sum(s2) * (1.f / D) + NORM_EPS);
        if (lane == 0) ((GAS float*)rs)[m0 + q] = r2;
        if (xq) { float am = 0.f;
#pragma unroll
            for (int j = 0; j < 2; ++j)
#pragma unroll
                for (int n = 0; n < 2; ++n) am = fmaxf(fmaxf(am, fmaxf(fabsf(x[j][n].x), fabsf(x[j][n].y))), fmaxf(fabsf(x[j][n].z), fabsf(x[j][n].w)));
            am = wave_max(am); const float qs = am > 0.f ? 127.f / am : 0.f;
#pragma unroll
            for (int j = 0; j < 2; ++j) { const unsigned long long pk = (unsigned long long)q4(x[j][0].x * qs, x[j][0].y * qs, x[j][0].z * qs, x[j][0].w * qs) | ((unsigned long long)q4(x[j][1].x * qs, x[j][1].y * qs, x[j][1].z * qs, x[j][1].w * qs) << 32);
                *(GAS unsigned long long*)(xq + (size_t)(m0 + q) * xq_ld + 512 * j + 8 * lane) = pk; }
            if (lane == 0) ((GAS float*)ra)[m0 + q] = r2 * am * (1.f / 127.f); }
    }
}
__device__ __forceinline__ void norm_gains(const float* g_post, int lane, f32x4 (&gp)[2][2]) {
#pragma unroll
    for (int j = 0; j < 2; ++j) { gp[j][0] = *(const GAS f32x4*)(g_post + 512 * j + 8 * lane); gp[j][1] = *(const GAS f32x4*)(g_post + 512 * j + 8 * lane + 4); }
}
template <bool XF32 = false, class Sched>
__device__ __forceinline__ void norm_rows_g(Frame& F, const Sched& S, const bf16* hsrc, bf16* xb, float* rs, const float* g_post, float scale, float* out32, signed char* xq, float* ra, const float omul = 1.0f, const int xq_ld = XQ_LD, const float* x32 = nullptr) {
    int lane = cur_lane();
    f32x4 gp[2][2]; norm_gains(g_post, lane, gp);
    pg8::Unit u;
    for (int i = 0; S.next(i, u); ++i) { const int base = u.pm * pg8::BM + u.pn * (pg8::BM / 4) + 2 * F.wave;
        for (int k = 0; k < 4; ++k) norm_pair<XF32>(hsrc, xb, rs, scale, out32, xq, ra, base + 16 * k, lane, gp, omul, xq_ld, x32); }
}

struct QJob { const float* W; const float* gk; signed char* WQ; float* cwf; int glu_off; int ldw; };
struct QSrc { const float* g1; const float* u1; const float* g2; const float* u2; const float* gains; const float* pg; const float* rin; };
constexpr int Q_STRIPS_GU = 8 * (FF / 32), Q_STRIPS_PG = 2 * (D / 32), Q_STRIPS_RG = 6144 / 32, Q_STRIPS = Q_STRIPS_GU + Q_STRIPS_PG + Q_STRIPS_RG;
__device__ __forceinline__ QJob qjob(const QSrc a, unsigned char* ws, int st, int& n0) {
    const float* gains = a.gains; QJob r; bf16* wb = (bf16*)(ws + WS_W);
    if (st >= Q_STRIPS_GU + Q_STRIPS_PG) {
        n0 = 32 * (st - Q_STRIPS_GU - Q_STRIPS_PG); r.W = a.rin; r.ldw = 6144; r.gk = gains + (size_t)8 * D + MIX_PRE * D; r.WQ = (signed char*)(wb + W_RIN); r.cwf = (float*)(ws + WS_CW2) + 2 * D; r.glu_off = -1; return r; }
    if (st >= Q_STRIPS_GU) { const int q = st - Q_STRIPS_GU, l = q / (D / 32);
        n0 = 32 * (q % (D / 32)); r.W = a.pg + (size_t)l * D * D; r.ldw = D; r.gk = gains + (size_t)l * 8 * D + PLE_PRE * D; r.WQ = (signed char*)(wb + (size_t)l * W_LAYER + W_PG); r.cwf = (float*)(ws + WS_CW2) + l * D; r.glu_off = -1; return r; }
    const int j = st / (FF / 32), l = j >> 2, f = (j >> 1) & 1, which = j & 1; n0 = 32 * (st % (FF / 32));
    { const float* w0 = f ? (which ? a.u2 : a.g2) : (which ? a.u1 : a.g1); r.W = w0 + (size_t)l * D * FF; } r.gk = gains + (size_t)l * 8 * D + (f ? FFN2_PRE : FFN1_PRE) * D; r.ldw = FF;
    r.WQ = (signed char*)(wb + (size_t)l * W_LAYER + (size_t)f * W_FFN + W_GU); r.cwf = (float*)(ws + WS_CW) + (l * 2 + f) * 2 * FF; r.glu_off = which * 128;
    return r;
}
__device__ __forceinline__ void q_strip(const QJob& jb, int n0, LAS float* scr  , LAS float* red  , int wave, int lane) {
    { const int n = lane & 31, hf = lane >> 5; float mx = 0.f;
#pragma unroll
      for (int t = 0; t < 2; ++t) { const int k0 = 128 * wave + 64 * t;
#pragma unroll
          for (int i4 = 0; i4 < 8; ++i4) { const f32x4 gv = *(const GAS f32x4*)(jb.gk + k0 + 32 * hf + 4 * i4);
#pragma unroll
              for (int x = 0; x < 4; ++x) { const float v = NORM_LD((const GAS float*)jb.W + (size_t)(k0 + 32 * hf + 4 * i4 + x) * jb.ldw + n0 + n) * gv[x]; scr[t * 2048 + (32 * hf + 4 * i4 + x) * 32 + n] = v; mx = fmaxf(mx, fabsf(v)); } } }
      mx = fmaxf(mx, __shfl_xor(mx, 32));
      if (hf == 0) red[wave * 32 + n] = mx; }
    __syncthreads();
    const int n = lane >> 1, hf = lane & 1;
    float cm = 0.f;
#pragma unroll
    for (int w8 = 0; w8 < 8; ++w8) cm = fmaxf(cm, red[w8 * 32 + n]);
    const float qs = cm > 0.f ? 127.f / cm : 0.f;
    const int drow = jb.glu_off < 0 ? (n0 + n) : (((n0 + n) >> 7) * 256 + jb.glu_off + ((n0 + n) & 127));
#pragma unroll
    for (int t = 0; t < 2; ++t) { const LAS float* s = scr + t * 2048 + (32 * hf) * 32 + n; unsigned w[8];
#pragma unroll
        for (int i4 = 0; i4 < 8; ++i4) w[i4] = q4(s[(4 * i4 + 0) * 32] * qs, s[(4 * i4 + 1) * 32] * qs, s[(4 * i4 + 2) * 32] * qs, s[(4 * i4 + 3) * 32] * qs);
        GAS v4u* dst = (GAS v4u*)(jb.WQ + (size_t)drow * D + 128 * wave + 64 * t + 32 * hf);
        dst[0] = (v4u){w[0], w[1], w[2], w[3]}; dst[1] = (v4u){w[4], w[5], w[6], w[7]}; }
    if (wave == 0 && hf == 0) ((GAS float*)jb.cwf)[drow] = cm * (1.f / 127.f);
    __syncthreads();
}

#ifndef PRO_REP
#define PRO_REP 0
#endif
__device__ __forceinline__ void p0_prologue(Frame& F, const KArgs& a) {
    unsigned char* ws = a.ws;
    LAS float* scr = (LAS float*)(F.lds + RING_OFF + F.wave * 16384);
    const int gw = F.vcu * NWAVES + F.wave, NGW = F.G * NWAVES; const int lane0 = cur_lane();
    bf16* wb = (bf16*)(ws + WS_W);
    for (int rp_ = 0; rp_ <= ((PRO_REP >> 0) & 1); ++rp_)
    { const QSrc qs{a.in[3], a.in[4], a.in[6], a.in[7], a.in[2], a.in[15], a.in[12]};
      for (int st = F.vcu; st < Q_STRIPS; st += F.G) { int n0; const QJob jb = qjob(qs, ws, st, n0);
          q_strip(jb, n0, scr, (LAS float*)(F.lds + TAB_OFF), F.wave, lane0); } }
    for (int rp_ = 0; rp_ <= ((PRO_REP >> 1) & 1); ++rp_)
    for (int j = 0; j < N_WJOBS; ++j) {
        if ((j < 16 && ((j & 7) == 0 || (j & 7) == 1 || (j & 7) == 3 || (j & 7) == 4 || (j & 7) == 7)) || j == 20) continue;
        const WJob jb = wjob(a, wb, j); const int nblk = jb.N / 32, nitems = (jb.K / 64) * nblk;
        for (int it = gw; it < nitems; it += NGW) { const int kb = it / nblk, nb = it % nblk, n0 = 32 * nb;
            const int drow0 = jb.glu_off < 0 ? n0 : ((n0 >> 7) * 256 + jb.glu_off + (n0 & 127));
            p0_transpose_item(jb.W, jb.ldw, jb.K, jb.WT, 64 * kb, jb.col0 + n0, drow0, scr, lane0, jb.gk); }
    }
    { const int gt = (F.vcu * NWAVES + F.wave) * 64 + lane0, NGT = NGW * 64; const f32x4* src = (const f32x4*)a.in[1]; v4u* dst = (v4u*)(ws + WS_PB);
      for (int rp_ = 0; rp_ <= ((PRO_REP >> 2) & 1); ++rp_)
      for (int i = gt; i < 2 * M * DPLE / 8; i += NGT) { const f32x4 v0 = NORM_LD((const GAS f32x4*)src + 2 * i), v1 = NORM_LD((const GAS f32x4*)src + 2 * i + 1); v4u o; o.x = pk2(v0.x, v0.y); o.y = pk2(v0.z, v0.w); o.z = pk2(v1.x, v1.y); o.w = pk2(v1.z, v1.w); ((GAS v4u*)dst)[i] = o; }
      float* cs = (float*)(ws + WS_COS); float* sn = (float*)(ws + WS_SIN);
      float* stp = (float*)(ws + WS_STEP);
      for (int i = gt; i < (SEQ + 1) * 128; i += NGT) { const bool is_step = (i >> 7) == SEQ; const int pos = is_step ? 16 : (i >> 7), fi = i & 127;
          const float inv = 1.0f / exp2f((float)fi * (13.287712379549449f / 127.0f)); const float ang = (float)pos * inv;
          double tr = (double)ang * 0.15915494309189535; tr -= __builtin_rint(tr); const float tf = (float)tr;
          const float cv = __builtin_amdgcn_cosf(tf), sv = __builtin_amdgcn_sinf(tf);
          if (is_step) { ((GAS float*)stp)[fi] = cv; ((GAS float*)stp)[128 + fi] = sv; } else { ((GAS float*)cs)[i] = cv; ((GAS float*)sn)[i] = sv; } }
    }
    for (int rp_ = 0; rp_ <= ((PRO_REP >> 3) & 1); ++rp_)
    xb_rows(F, a.in[0], (bf16*)(ws + WS_XN), (float*)(ws + WS_RS), (signed char*)(ws + WS_XQ), (float*)(ws + WS_RA));
}
typedef short s16x4 __attribute__((ext_vector_type(4)));
typedef short v4i16_t __attribute__((ext_vector_type(4)));
typedef float f32x16 __attribute__((ext_vector_type(16)));
__device__ __forceinline__ s16x4 tr_rd(LAS unsigned char* p) { return __builtin_bit_cast(s16x4, __builtin_amdgcn_ds_read_tr16_b64_v4i16((LAS v4i16_t*)p)); }
__device__ __forceinline__ bf16x8 cat8(const s16x4 a, const s16x4 b) { return (bf16x8){a[0], a[1], a[2], a[3], b[0], b[1], b[2], b[3]}; }
__device__ __forceinline__ unsigned cvtpk(float lo, float hi) { unsigned r; asm volatile("v_cvt_pk_bf16_f32 %0, %1, %2" : "=v"(r) : "v"(lo), "v"(hi)); return r; }

__device__ __forceinline__ void ret_core_unit(LAS unsigned char* lds, const bf16* Qg, const bf16* Kg, bf16* Vg, float* ssq, int b, int h, int es, int tid_in, int lane_in, int w, bool do_store, int pmask = 31) {
    int tid = tid_in, lane = lane_in; asm volatile("" : "+v"(tid), "+v"(lane));
    const int c16 = lane & 15, q = lane >> 4, r32 = lane & 31, hh = lane >> 5, blk = (lane >> 4) & 1, qq = c16 >> 2, pp = c16 & 3;
    const int ib = (w < 4) ? w : 11 - w;
    const float lg = __builtin_amdgcn_logf(1.0f - __builtin_amdgcn_exp2f(-5.0f - (float)h));
    const float cd = __builtin_amdgcn_exp2f(lg * 128.0f);
    const float fi = __builtin_amdgcn_exp2f(lg * (float)(16 * ib + c16 - 127));
    float qd[4];
#pragma unroll
    for (int r = 0; r < 4; ++r) qd[r] = __builtin_amdgcn_exp2f(lg * (float)(16 * ib + 4 * q + r + 1));
    const size_t rowbase = (size_t)b * SEQ;
    const bf16* Qh = Qg + rowbase * 1024 + h * 256;
    const bf16* Kh = Kg + rowbase * 1024 + h * 256;
    bf16* Vh = Vg + rowbase * LDV + h * 512 + es * 64;
    LAS unsigned char* ldK = lds + RET_LDS_K; LAS unsigned char* ldV = lds + RET_LDS_V; LAS unsigned char* ldS = lds + RET_LDS_S;
    unsigned rx[4], kt[2], vt[2][2], vdx[4], st[4], kst_a, vst_a;
    { const unsigned rbase = 256u * c16 + 16u * (q ^ ((c16 >> 2) & 3)), sig64 = 64u * (c16 & 3);
#pragma unroll
      for (int k = 0; k < 4; ++k) { rx[k] = rbase + ((64u * k) ^ sig64); asm volatile("" : "+v"(rx[k])); }
      const unsigned L = (2 * blk + (pp >> 1)) ^ (2 * hh);
#pragma unroll
      for (int t = 0; t < 2; ++t) { kt[t] = 256u * (8 * hh + qq) + 8u * (pp & 1) + 32768u * (w >> 2) + 64u * ((w & 3) ^ qq) + 1024u * t + 16u * (L ^ t); asm volatile("" : "+v"(kt[t])); }
      const unsigned vb = 128u * (8 * hh + qq) + 16u * ((pp >> 1) ^ (qq >> 1)) + 8u * (pp & 1);
#pragma unroll
      for (int eb = 0; eb < 2; ++eb)
#pragma unroll
          for (int t = 0; t < 2; ++t) { vt[eb][t] = vb + 512u * t + 64u * (eb ^ hh) + 32u * (blk ^ t); asm volatile("" : "+v"(vt[eb][t])); }
      const unsigned vd = 128u * (4 * q + qq) + 16u * ((pp >> 1) ^ (qq >> 1)) + 8u * (pp & 1);
#pragma unroll
      for (int cc = 0; cc < 4; ++cc) { vdx[cc] = vd + 32u * (cc ^ q); asm volatile("" : "+v"(vdx[cc])); }
      const unsigned ssb = 256u * r32 + 8u * hh + 64u * ((w & 3) ^ (r32 & 3)) + 16384u * (w >> 2);
#pragma unroll
      for (int g = 0; g < 4; ++g) { st[g] = ssb + 16u * (g ^ ((r32 >> 2) & 3)); asm volatile("" : "+v"(st[g])); }
      kst_a = koff(tid >> 5, (tid & 31) * 8); vst_a = voff(tid >> 3, (tid & 7) * 8); asm volatile("" : "+v"(kst_a), "+v"(vst_a));
    }
    f32x16 S0, S1;
#pragma unroll
    for (int r = 0; r < 16; ++r) { S0[r] = 0.f; S1[r] = 0.f; }
    v4u kst[8], vst[2]; bf16x8 qf[8];
    const bf16* kgp = Kh + (size_t)(tid >> 5) * 1024 + (tid & 31) * 8;
    const bf16* vgp = Vh + (size_t)(tid >> 3) * LDV + (tid & 7) * 8;
    const bf16* qgp = Qh + (size_t)(16 * ib + c16) * 1024 + 8 * q;
#define RET_LOAD_KV(c) do { const size_t t0_ = (size_t)(c) * CHUNK; \
        _Pragma("unroll") for (int n = 0; n < 8; ++n) kst[n] = *(const GAS v4u*)(kgp + (t0_ + 16 * n) * 1024); \
        _Pragma("unroll") for (int n = 0; n < 2; ++n) vst[n] = *(const GAS v4u*)(vgp + (t0_ + 64 * n) * LDV); } while (0)
#define RET_STORE_KV() do { \
        _Pragma("unroll") for (int n = 0; n < 8; ++n) *(LAS v4u*)(ldK + kst_a + 4096 * n) = kst[n]; \
        _Pragma("unroll") for (int n = 0; n < 2; ++n) *(LAS v4u*)(ldV + vst_a + 8192 * n) = vst[n]; } while (0)
#define RET_LOAD_Q(c) do { const size_t t0_ = (size_t)(c) * CHUNK; \
        _Pragma("unroll") for (int ks = 0; ks < 8; ++ks) qf[ks] = *(const GAS bf16x8*)(qgp + t0_ * 1024 + 32 * ks); } while (0)
#define RET_STORE_S() do { \
        _Pragma("unroll") for (int g = 0; g < 4; ++g) { \
            unsigned long long v0 = (unsigned long long)cvtpk(S0[4 * g], S0[4 * g + 1]) | ((unsigned long long)cvtpk(S0[4 * g + 2], S0[4 * g + 3]) << 32); \
            unsigned long long v1 = (unsigned long long)cvtpk(S1[4 * g], S1[4 * g + 1]) | ((unsigned long long)cvtpk(S1[4 * g + 2], S1[4 * g + 3]) << 32); \
            *(LAS unsigned long long*)(ldS + st[g]) = v0; *(LAS unsigned long long*)(ldS + st[g] + 8192) = v1; } } while (0)
    RET_LOAD_KV(0); RET_LOAD_Q(0);
    RET_STORE_S();
    RET_STORE_KV();
    RET_LOAD_KV(1);
    __syncthreads();
    for (int c = 0; c < NCHUNK; ++c) {
        const int t0 = c * CHUNK;
        f32x4 O[4];
#pragma unroll
        for (int cc = 0; cc < 4; ++cc) O[cc] = (f32x4){0.f, 0.f, 0.f, 0.f};
        if (pmask & 1)
#pragma unroll
        for (int ks = 0; ks < 8; ++ks)
#pragma unroll
            for (int cc = 0; cc < 4; ++cc) { const bf16x8 sb = *(const LAS bf16x8*)(ldS + rx[ks & 3] + (4096 * cc + 16384 * (ks >> 2))); O[cc] = __builtin_amdgcn_mfma_f32_16x16x32_bf16(qf[ks], sb, O[cc], 0, 0, 0); }
#pragma unroll
        for (int cc = 0; cc < 4; ++cc)
#pragma unroll
            for (int r = 0; r < 4; ++r) O[cc][r] *= qd[r];
        f32x4 X[8];
        {
            bf16x8 kf[8];
            if (pmask & 2) {
#pragma unroll
                for (int ks = 0; ks < 8; ++ks) kf[ks] = *(const LAS bf16x8*)(ldK + rx[ks & 3] + (32768 * (ks >> 2)));
            }
#pragma unroll
            for (int jb = 0; jb < 8; ++jb) { X[jb] = (f32x4){0.f, 0.f, 0.f, 0.f};
                if (jb <= ib && (pmask & 2)) {
#pragma unroll
                    for (int ks = 0; ks < 8; ++ks) { X[jb] = __builtin_amdgcn_mfma_f32_16x16x32_bf16(kf[ks], qf[ks], X[jb], 0, 0, 0);
                        if (jb < 7) kf[ks] = *(const LAS bf16x8*)(ldK + rx[ks & 3] + (4096 * (jb + 1) + 32768 * (ks >> 2))); }
#pragma unroll
                    for (int r = 0; r < 4; ++r) { float v = X[jb][r] * fi; if (jb == ib && 4 * q + r > c16) v = 0.f; X[jb][r] = v; }
                } }
        }
        if (c + 1 < NCHUNK) RET_LOAD_Q(c + 1);
#pragma unroll
        for (int s = 0; s < 4; ++s) {
            if (2 * s <= ib && (pmask & 16)) {
                v4u aw; aw.x = cvtpk(X[2 * s][0], X[2 * s][1]); aw.y = cvtpk(X[2 * s][2], X[2 * s][3]); aw.z = cvtpk(X[2 * s + 1][0], X[2 * s + 1][1]); aw.w = cvtpk(X[2 * s + 1][2], X[2 * s + 1][3]);
                const bf16x8 af = __builtin_bit_cast(bf16x8, aw);
#pragma unroll
                for (int cc = 0; cc < 4; ++cc) { const s16x4 b0 = tr_rd(ldV + vdx[cc] + 4096 * s), b1 = tr_rd(ldV + vdx[cc] + (4096 * s + 2048));
                    O[cc] = __builtin_amdgcn_mfma_f32_16x16x32_bf16(af, cat8(b0, b1), O[cc], 0, 0, 0); }
            } }
        if (do_store) {
            bf16* orow = Vh + (size_t)(t0 + 16 * ib + 4 * q) * LDV + c16; float* srow = ssq + ((rowbase + t0 + 16 * ib + 4 * q) * 4 + h) * 8 + es;
#pragma unroll
            for (int r = 0; r < 4; ++r) { float sq = 0.f;
#pragma unroll
                for (int cc = 0; cc < 4; ++cc) { sq += O[cc][r] * O[cc][r]; ((GAS bf16*)orow)[(size_t)r * LDV + 16 * cc] = (bf16)f2bf(O[cc][r]); }
                sq += __shfl_xor(sq, 1); sq += __shfl_xor(sq, 2); sq += __shfl_xor(sq, 4); sq += __shfl_xor(sq, 8);
                if (c16 == 0) ((GAS float*)srow)[r * 32] = sq; }
        }
        if (c + 1 < NCHUNK && (pmask & 4)) {
#pragma unroll
            for (int r = 0; r < 16; ++r) { S0[r] *= cd; S1[r] *= cd; }
#pragma unroll
            for (int ks = 0; ks < 8; ++ks) {
                const s16x4 a0 = tr_rd(ldK + kt[0] + 4096 * ks), a1 = tr_rd(ldK + kt[1] + 4096 * ks);
                const s16x4 b00 = tr_rd(ldV + vt[0][0] + 2048 * ks), b01 = tr_rd(ldV + vt[0][1] + 2048 * ks);
                const s16x4 b10 = tr_rd(ldV + vt[1][0] + 2048 * ks), b11 = tr_rd(ldV + vt[1][1] + 2048 * ks);
                const bf16x8 af = cat8(a0, a1);
                S0 = __builtin_amdgcn_mfma_f32_32x32x16_bf16(af, cat8(b00, b01), S0, 0, 0, 0);
                S1 = __builtin_amdgcn_mfma_f32_32x32x16_bf16(af, cat8(b10, b11), S1, 0, 0, 0);
            }
        }
        __syncthreads();
        if (c + 1 < NCHUNK) {
            RET_STORE_S();
            RET_STORE_KV();
            if (c + 2 < NCHUNK) RET_LOAD_KV(c + 2);
        }
        __syncthreads();
    }
#undef RET_LOAD_KV
#undef RET_STORE_KV
#undef RET_LOAD_Q
#undef RET_STORE_S
}
__device__ __forceinline__ void ret_core_phase(Frame& F, unsigned char* ws, bool do_store = true, int pmask = 31) {
    for (int unit = F.vcu; unit < BATCH * NHEAD * 8; unit += F.G)
        ret_core_unit(F.lds + RING_OFF, (const bf16*)(ws + WS_Q), (const bf16*)(ws + WS_K), (bf16*)(ws + WS_V), (float*)(ws + WS_SSQ), unit >> 5, (unit >> 3) & 3, unit & 7, F.wave * 64 + cur_lane(), cur_lane(), F.wave, do_store, pmask);
}

constexpr int CW_SEAM = 16384, SEAM_BANK = 128 * 64;
static_assert((CW_SEAM + 16 * SEAM_BANK) * 4 <= (int)CTL_ZERO_BYTES, "counter banks inside the memset region");
__global__ void __launch_bounds__(NWAVES * 64, 2) hybrid_fwd(KArgs args) {
    extern __shared__ __attribute__((aligned(16))) unsigned char lds[];
    Frame F;
    F.lds = (LAS unsigned char*)lds;
    F.MISC = (volatile LAS unsigned*)(F.lds + MISC_OFF);
    F.wave = __builtin_amdgcn_readfirstlane((int)threadIdx.x >> 6);
    F.G = gridDim.x; { const int bx = blockIdx.x; F.vcu = (F.G % 8 == 0) ? (bx % 8) * (F.G / 8) + bx / 8 : bx; }
    unsigned char* const ws_k = args.ws; const float* const gains_k = args.in[2];
    F.ctl = (gu32*)(ws_k + WS_CTL);
    for (int u = F.wave * 64 + cur_lane(); u < (LDS_BYTES - LDSCTL_OFF) / 4; u += NWAVES * 64) ((LAS unsigned*)(F.lds + LDSCTL_OFF))[u] = 0u;
    __syncthreads();
#if MK_PER_PHASE
#define GRID_BAR() do { } while (0)
#else
    XcdBarrier bar = xcd_barrier_post((unsigned*)(F.ctl + CW_BAR), F.MISC + 8, F.wave);
#define GRID_BAR() xcd_barrier(bar)
#endif
    const int lo = args.ph_lo, hi = args.ph_hi; int ph = 0;
    constexpr int CW_GRP = 8192;
    GroupBar gb, xb; { const int c = (int)blockIdx.x, gi = (c & 7) * 8 + ((c >> 3) & 7); gb.cnt = F.ctl + CW_GRP + 64 * (gi & ~(GROUP_MERGE - 1)); gb.st = F.MISC + 10; gb.wave = F.wave; gb.n = 4u * GROUP_MERGE;
        xb.cnt = F.ctl + CW_GRP + 64 * (64 + (c & 7)); xb.st = F.MISC + 12; xb.wave = F.wave; xb.n = 32u;
        if (xb_thread0(F.wave)) (void)__hip_atomic_fetch_or(F.ctl + CW_GRP + 64 * gi + 32, 1u << (bar.x & 31u), RLX_AGENT); }
#ifndef B_NT_MASK
#define B_NT_MASK 0
#endif
#ifndef GROUP_SEAMS
#define GROUP_SEAMS 1
#endif
#if GROUP_SEAMS
#define GROUP_BAR() do { if (F.MISC[11] == 1u) group_barrier(gb); else GRID_BAR(); } while (0)
#define XCD_BAR() do { if (F.MISC[11] == 1u) group_barrier(xb); else GRID_BAR(); } while (0)
#else
#define GROUP_BAR() GRID_BAR()
#define XCD_BAR() GRID_BAR()
#endif
#ifndef PROBE_CLK
#define PROBE_CLK 0
#endif
#if PROBE_CLK
#ifndef PROBE_BASE
#define PROBE_BASE 0.f
#endif
#define STAMP(k) if (F.wave == 0 && cur_lane() == 0) { const unsigned t_ = (unsigned)__builtin_amdgcn_s_memrealtime(); (void)__hip_atomic_fetch_max(F.ctl + 128 + 2 * (k), t_, RLX_AGENT); (void)__hip_atomic_fetch_max(F.ctl + 129 + 2 * (k), 0xffffffffu - t_, RLX_AGENT); }
#define TMAX(k) __hip_atomic_load(F.ctl + 128 + 2 * (k), RLX_AGENT)
#define TMIN(k) (0xffffffffu - __hip_atomic_load(F.ctl + 129 + 2 * (k), RLX_AGENT))
#define PROBE_OMUL , 1.0f + PROBE_BASE + floorf((float)(int)(PROBE_EXPR) / (float)(PROBE_Q)) * 0.01f
#else
#define STAMP(k)
#define PROBE_OMUL
#endif
#define PH_BEGIN if (lo <= ph && ph < hi) { unsigned char* ws = ws_k; const float* gains = gains_k; asm volatile("" : "+s"(ws), "+s"(gains));
#define PH_END_XCD if (ph + 1 < hi) XCD_BAR(); STAMP(ph) } ++ph;
#define PH_END_GRID if (ph + 1 < hi) GRID_BAR(); STAMP(ph) } ++ph;
#define PH_END_SEL(grid_) if (ph + 1 < hi) { if (grid_) GRID_BAR(); else GROUP_BAR(); } STAMP(ph) } ++ph;
#ifndef ALIGN_FFN
#define ALIGN_FFN 0
#endif
#if ALIGN_FFN
#define PH_END_ALIGN if (ph + 1 < hi) XCD_BAR(); STAMP(ph) } ++ph;
#else
#define PH_END_ALIGN if (ph + 1 < hi) GROUP_BAR(); STAMP(ph) } ++ph;
#endif
#define PH_END_GROUP if (ph + 1 < hi) GROUP_BAR(); STAMP(ph) } ++ph;
#define GEMM(EPI, I8_, SITE_) pg8::gemm_phase<EPI, pg8::StaticOrder, PG8_ALIGN, PG8_SP2, I8_, ((B_NT_MASK >> (SITE_)) & 1) != 0>(F.lds + RING_OFF, gm, S, E, F.wave)
#define SORDER(N_) pg8::StaticOrder S; S.init(M, (N_), F.G, (int)blockIdx.x)
#define wb ((bf16*)(ws + WS_W))
#define XN ((bf16*)(ws + WS_XN))
#define RS ((float*)(ws + WS_RS))
#define HB ((bf16*)(ws + WS_HBUF))
#define HID ((bf16*)(ws + WS_BIG))
#define XQp ((signed char*)(ws + WS_XQ))
#define RAp ((float*)(ws + WS_RA))
#define XQB ((signed char*)(ws + WS_BIG) + 2 * NHEAD * DV)
#define lw (wb + (size_t)l * W_LAYER)
#define fw (lw + (size_t)f * W_FFN)
#define g (gains + (size_t)l * 8 * D)

    PH_BEGIN
        p0_prologue(F, args);
        if (ph + 1 < hi) GRID_BAR();
        if (xb_thread0(F.wave)) F.MISC[11] = grp_mode_decide(F.ctl + CW_GRP + 32, F.G);
        __syncthreads();
        STAMP(ph) } ++ph;

    _Pragma("nounroll") for (int l = 0; l < 2; ++l) {
        _Pragma("nounroll") for (int f = 0; f < 2; ++f) {
            PH_BEGIN
                { pg8::Gemm gm{(const bf16*)XQp, fw + W_GU, M, 2 * FF, D / 2, XQ_LD / 2}; SORDER(2 * FF); pg8::EpiGLUq E{HID, FF, RAp, (const float*)(ws + WS_CW) + (l * 2 + f) * 2 * FF}; GEMM(pg8::EpiGLUq, true, 0); }
            PH_END_GROUP
            PH_BEGIN
                { pg8::Gemm gm{HID, fw + W_DN, M, D, FF}; SORDER(D); pg8::EpiH<0> E{HB, D, RS}; GEMM(pg8::EpiH<0>, false, 1);
                  GROUP_BAR();
                  if (l == 0 && f == 0) norm_rows_g<true>(F, S, HB, XN, RS, g + (f ? FFN2_POST : FFN1_POST) * D, 0.5f, (float*)nullptr, f ? XQp : (l == 1 ? XQB : (signed char*)nullptr), RAp, 1.0f, f ? XQ_LD : 2 * LDV, args.in[0]);
                  else norm_rows_g<false>(F, S, HB, XN, RS, g + (f ? FFN2_POST : FFN1_POST) * D, 0.5f, (float*)nullptr, f ? XQp : (l == 1 ? XQB : (signed char*)nullptr), RAp, 1.0f, f ? XQ_LD : 2 * LDV); }
            PH_END_GROUP
            if (f == 0) {
                if (l == 0) {
                    PH_BEGIN
                        { pg8::Gemm gm{XN, wb + W_CCH, M, 2 * D, D}; SORDER(2 * D); pg8::EpiGLU<0> E{(bf16*)(ws + WS_U), LDV, RS}; GEMM(pg8::EpiGLU<0>, false, 2); }
                    PH_END_XCD
                    PH_BEGIN
                        { pg8::Gemm gm{XN, wb + W_CB, M, D, D}; SORDER(D); pg8::EpiConv E{(bf16*)(ws + WS_AB), (const bf16*)(ws + WS_U), args.in[10], D, SEQ, RS, LDV}; GEMM(pg8::EpiConv, false, 3); }
                    PH_END_GROUP
                    PH_BEGIN
                        { pg8::Gemm gm{(const bf16*)(ws + WS_AB), wb + W_CO, M, D, D, LDV}; SORDER(D); pg8::EpiH<0> E{HB, D, RS}; GEMM(pg8::EpiH<0>, false, 4);
                          GROUP_BAR();
                          norm_rows_g(F, S, HB, XN, RS, g + MIX_POST * D, 1.0f, (float*)nullptr, XQp, RAp); }
                    PH_END_XCD
                } else {
                    PH_BEGIN
                        { pg8::Gemm gm{(const bf16*)XQB, wb + W_RIN, M, NRQKV, D / 2, LDV}; SORDER(NRQKV);
                          pg8::EpiDeq<pg8::EpiRetQKV> E{pg8::EpiRetQKV{pg8::EpiRetQK{(bf16*)(ws + WS_Q), (bf16*)(ws + WS_K), (const float*)(ws + WS_COS), (const float*)(ws + WS_SIN), SEQ, RAp, (const float*)(ws + WS_STEP)}, pg8::EpiRetV{(bf16*)(ws + WS_V), RAp}}, (const float*)(ws + WS_CW2) + 2 * D};
                          GEMM(pg8::EpiDeq<pg8::EpiRetQKV>, true, 5); }
                    PH_END_XCD
                    PH_BEGIN
                        ret_core_phase(F, ws);
                    PH_END_XCD
                    PH_BEGIN
                        { pg8::Gemm gm{(const bf16*)XQB, wb + W_RIN + (size_t)NRQKV * D / 2, M, 2048, D / 2, LDV}; SORDER(2048);
                          pg8::EpiRetGateQ E{(bf16*)(ws + WS_V), (const float*)(ws + WS_SSQ), NORM_EPS, RAp, (const float*)(ws + WS_CW2) + 2 * D + NRQKV}; GEMM(pg8::EpiRetGateQ, true, 6); }
                    PH_END_GROUP
                    PH_BEGIN
                        { pg8::Gemm gm{(const bf16*)(ws + WS_V), wb + W_ROUT, M, D, 2048, LDV}; SORDER(D); pg8::EpiH<0> E{HB, D, RS}; GEMM(pg8::EpiH<0>, false, 7);
                          GROUP_BAR();
                          norm_rows_g(F, S, HB, XN, RS, g + MIX_POST * D, 1.0f, (float*)nullptr, XQp, RAp); }
                    PH_END_ALIGN
                }
            } else {
                PH_BEGIN
                    { pg8::Gemm gm{(const bf16*)XQp, lw + W_PG, M, D, D / 2, XQ_LD / 2}; SORDER(D); pg8::EpiDeq<pg8::EpiH<1>> E{pg8::EpiH<1>{HB, D, RAp}, (const float*)(ws + WS_CW2) + l * D}; GEMM(pg8::EpiDeq<pg8::EpiH<1>>, true, 8); }
                    __syncthreads();
                    { pg8::Gemm gm{(const bf16*)(ws + WS_PB) + (size_t)l * M * DPLE, lw + W_PP, M, D, DPLE}; SORDER(D); pg8::EpiH<2> E{HB, D, RS}; GEMM(pg8::EpiH<2>, false, 9);
                      GROUP_BAR();
                      norm_rows_g(F, S, HB, XN, RS, g + PLE_POST * D, 1.0f, (l == 1 ? args.out : (float*)nullptr), (l == 1 ? (signed char*)nullptr : XQp), RAp PROBE_OMUL); }
                PH_END_ALIGN
            }
        }
    }
#undef PH_BEGIN
#undef PH_END_GRID
#undef PH_END_XCD
#undef PH_END_GROUP
#undef PH_END_ALIGN
#undef PH_END_SEL
#undef GEMM
#undef SORDER
#undef wb
#undef XN
#undef RS
#undef HB
#undef HID
#undef XQp
#undef RAp
#undef XQB
#undef lw
#undef fw
#undef g
}
constexpr int N_PHASES = 18;

extern "C" void kernel_launch(void* const* d_in, const int* in_sizes, int n_in, void* d_out, int out_size, void* d_ws, size_t ws_size, hipStream_t stream) {
    static int grid = 0;
    if (grid == 0) {
        if (n_in != 16 || in_sizes[0] != M * D || out_size != M * D || ws_size < WS_END) { fprintf(stderr, "kernel_launch: unexpected shapes / workspace (n_in %d, in0 %d, out %d, ws %zu, need %zu)\n", n_in, n_in > 0 ? in_sizes[0] : -1, out_size, ws_size, (size_t)WS_END); grid = -1; return; }
        int dev = 0, cus = 0;
        if (hipGetDevice(&dev) != hipSuccess || hipDeviceGetAttribute(&cus, hipDeviceAttributeMultiprocessorCount, dev) != hipSuccess) { grid = -1; return; }
        if (hipFuncSetAttribute((const void*)hybrid_fwd, hipFuncAttributeMaxDynamicSharedMemorySize, LDS_BYTES) != hipSuccess) { fprintf(stderr, "kernel_launch: hipFuncSetAttribute failed\n"); grid = -1; return; }
        int per_cu = 0;
        if (hipOccupancyMaxActiveBlocksPerMultiprocessor(&per_cu, (const void*)hybrid_fwd, NWAVES * 64, LDS_BYTES) != hipSuccess || per_cu < 1) fprintf(stderr, "kernel_launch: occupancy query reports %d\n", per_cu);
        (void)hipGetLastError();
        grid = cus;
    }
    if (grid < 0) return;
    if (hipMemsetAsync((char*)d_ws + WS_CTL, 0, CTL_ZERO_BYTES, stream) != hipSuccess) return;
    KArgs a{};
    for (int i = 0; i < 16; ++i) a.in[i] = (const float*)d_in[i];
    a.out = (float*)d_out; a.ws = (unsigned char*)d_ws;
#if MK_PER_PHASE
    for (int ph = 0; ph < N_PHASES; ++ph) { a.ph_lo = ph; a.ph_hi = ph + 1; hipLaunchKernelGGL(hybrid_fwd, dim3(grid), dim3(NWAVES * 64), LDS_BYTES, stream, a); }
#else
    a.ph_lo = 0; a.ph_hi = N_PHASES; hipLaunchKernelGGL(hybrid_fwd, dim3(grid), dim3(NWAVES * 64), LDS_BYTES, stream, a);
#endif
}
```

```cpp
#include <hip/hip_runtime.h>
#include <cstdio>
#include <cstdint>
#define EPI_WS_XB ((size_t)138 << 20)
#define EPI_WS_RS ((size_t)1 << 20)
#define EPI_WS_GATE ((size_t)202 << 20)
#define EPI_WS_XBUF ((size_t)506 << 20)
#define EPI_LDV 2816
#ifndef PG8_PAIR
#define PG8_PAIR 0
#endif
#ifndef PG8_XROT
#define PG8_XROT 1
#endif
#ifndef PG8_LATE_STAGE
#define PG8_LATE_STAGE 0
#endif
#ifndef PG8_ASM_STAGE
#define PG8_ASM_STAGE 1
#endif
namespace pg8 {
#define PG8_LAS __attribute__((address_space(3)))
#define PG8_GAS __attribute__((address_space(1)))
typedef unsigned short bf16_t;
typedef short bf16x8 __attribute__((ext_vector_type(8)));
typedef float f32x4 __attribute__((ext_vector_type(4)));
typedef unsigned u32x4 __attribute__((ext_vector_type(4)));
typedef int i32x4 __attribute__((ext_vector_type(4)));
constexpr int BM = 256, BK = 64, HALF = 128, HTB = HALF * BK * 2  , STAGE_BYTES = 8 * HTB, NXCD = 8, WGM = 8;

__host__ __device__ __forceinline__ int lds_byte(int r, int c) { const int st = (r >> 4) * 2 + (c >> 5), rr = r & 15, cc = c & 31, ob = rr * 64 + cc * 2; return st * 1024 + (ob ^ (((ob >> 9) & 1) << 5)); }
__host__ __device__ __forceinline__ void stage_rc(int b, int& R, int& C) { const int st = b / 1024, sb = b % 1024, swz = sb ^ (((sb >> 9) & 1) << 5); R = (st >> 1) * 16 + swz / 64; C = (st & 1) * 32 + (swz % 64) / 2; }
__host__ __device__ __forceinline__ int perm32(int rho) { const int n = rho >> 4, i = rho & 15; return 8 * (i >> 2) + 4 * n + (i & 3); }

struct Unit { int pm, pn; };
struct Gemm { const bf16_t* A; const bf16_t* Bt; int M, N, K; int lda = 0; };

struct StaticOrder {
    int nM, nN, nwg, G, c;
    __host__ __device__ void init(int M, int N, int G_, int c_) { nM = M / BM; nN = N / BM; nwg = nM * nN; G = G_; c = c_; }
    __host__ __device__ bool next(int i, Unit& u) const {
        if (PG8_PAIR && G == 256 && nM == 128 && (nN & 1) == 0) { const int k = c >> 6, p0 = 16 * (c & 7) + ((c >> 3) & 7), nper = nN >> 2;
            if (i < 2 * nper) { u.pm = p0 + 8 * (i & 1); u.pn = k + 4 * (i >> 1); return true; }
            if ((nN & 3) == 2 && i == 2 * nper) { u.pm = p0 + 8 * (k & 1); u.pn = 4 * nper + (k >> 1); return true; }
            return false; }
        if (PG8_XROT && G == 256 && nM == 128 && nwg % G == 0) { const int rounds = nwg / G; if (i >= rounds) return false; i = (i + (c & 7)) % rounds; }
        const long L = (long)i * G + c; if (L >= nwg) return false;
        int wgid = (int)L; { const int q = nwg / NXCD, r = nwg % NXCD, xcd = wgid % NXCD, off = wgid / NXCD; wgid = (xcd < r ? xcd * (q + 1) : r * (q + 1) + (xcd - r) * q) + off; }
        const int nig = WGM * nN, gid = wgid / nig, fm = gid * WGM, gsz = (nM - fm) < WGM ? (nM - fm) : WGM;
        u.pm = fm + ((wgid % nig) % gsz); u.pn = (wgid % nig) / gsz; return true;
    }
    __device__ __forceinline__ void a_ready(const Unit&) const {}
    __device__ __forceinline__ void done(const Unit&) const {}
};

__device__ __forceinline__ unsigned cvt_pk_bf16(float lo, float hi) { unsigned r; asm volatile("v_cvt_pk_bf16_f32 %0, %1, %2" : "=v"(r) : "v"(lo), "v"(hi)); return r; }
typedef float f32x2 __attribute__((ext_vector_type(2)));
__device__ __forceinline__ float sigmoid_f(float v) { return __builtin_amdgcn_rcpf(1.0f + __builtin_amdgcn_exp2f(v * -1.4426950408889634f)); }
__device__ __forceinline__ u32x4 pack8(const f32x4 a, const f32x4 b) { u32x4 w; w.x = cvt_pk_bf16(a[0], a[1]); w.y = cvt_pk_bf16(a[2], a[3]); w.z = cvt_pk_bf16(b[0], b[1]); w.w = cvt_pk_bf16(b[2], b[3]); return w; }
__device__ __forceinline__ f32x4 bf4_lo(const u32x4 w) { return (f32x4){__uint_as_float(w.x << 16), __uint_as_float(w.x & 0xffff0000u), __uint_as_float(w.y << 16), __uint_as_float(w.y & 0xffff0000u)}; }
__device__ __forceinline__ f32x4 bf4_hi(const u32x4 w) { return (f32x4){__uint_as_float(w.z << 16), __uint_as_float(w.z & 0xffff0000u), __uint_as_float(w.w << 16), __uint_as_float(w.w & 0xffff0000u)}; }

struct EpiNull {
    static constexpr bool PERM = true, AFTER_DRAIN = false;
    float* sink;
    __device__ __forceinline__ void operator()(const f32x4 (&acc)[2][2][4][2], const Unit& u, int wr, int wc, int fr, int fq) const {
        float s = 0.f;
#pragma unroll
        for (int ai = 0; ai < 2; ++ai)
#pragma unroll
            for (int bj = 0; bj < 2; ++bj)
#pragma unroll
                for (int m = 0; m < 4; ++m)
#pragma unroll
                    for (int n = 0; n < 2; ++n) s += acc[ai][bj][m][n][0] + acc[ai][bj][m][n][1] + acc[ai][bj][m][n][2] + acc[ai][bj][m][n][3];
        if (s == 1.2345e30f) ((PG8_GAS float*)sink)[0] = s;
    }
};
struct EpiF32S {
    static constexpr bool PERM = false, AFTER_DRAIN = false;
    float* C; int ldc; const float* rs;
    __device__ __forceinline__ void operator()(const f32x4 (&acc)[2][2][4][2], const Unit& u, int wr, int wc, int fr, int fq) const {
        const int row0 = u.pm * BM + wr * 64 + fr, col0 = u.pn * BM + wc * 32 + 4 * fq;
#pragma unroll
        for (int ai = 0; ai < 2; ++ai)
#pragma unroll
            for (int m = 0; m < 4; ++m) { const int row = row0 + ai * HALF + m * 16; const float r = ((const PG8_GAS float*)rs)[row]; float* rowp = C + (size_t)row * ldc + col0;
#pragma unroll
                for (int bj = 0; bj < 2; ++bj)
#pragma unroll
                    for (int n = 0; n < 2; ++n) *(PG8_GAS f32x4*)(rowp + bj * HALF + n * 16) = acc[ai][bj][m][n] * r; }
    }
};
template <int MODE> struct EpiH {
    static constexpr bool PERM = true, AFTER_DRAIN = false;
    bf16_t* O; int ldc; const float* rs;
    __device__ __forceinline__ void operator()(const f32x4 (&acc)[2][2][4][2], const Unit& u, int wr, int wc, int fr, int fq) const {
        const int row0 = u.pm * BM + wr * 64 + fr, col0 = u.pn * BM + wc * 32 + 8 * fq;
#pragma unroll
        for (int ai = 0; ai < 2; ++ai)
#pragma unroll
            for (int m = 0; m < 4; ++m) { const int row = row0 + ai * HALF + m * 16; bf16_t* rowp = O + (size_t)row * ldc + col0; const float r = (MODE == 1) ? ((const PG8_GAS float*)rs)[row] : 1.0f;
#pragma unroll
                for (int bj = 0; bj < 2; ++bj) { f32x4 v0 = acc[ai][bj][m][0], v1 = acc[ai][bj][m][1];
                    if (MODE == 1) { v0 = v0 * r; v1 = v1 * r; }
                    if (MODE == 2) { const u32x4 gw = *(const PG8_GAS u32x4*)(rowp + bj * HALF); const f32x4 g0 = bf4_lo(gw), g1 = bf4_hi(gw);
#pragma unroll
                        for (int x = 0; x < 4; ++x) { v0[x] *= sigmoid_f(g0[x]); v1[x] *= sigmoid_f(g1[x]); } }
                    *(PG8_GAS u32x4*)(rowp + bj * HALF) = pack8(v0, v1); }
                if (MODE == 2) asm volatile("" ::: "memory"); }
    }
};
template <int ACT  > struct EpiGLU {
    static constexpr bool PERM = true, AFTER_DRAIN = false;
    bf16_t* O; int ldc; const float* rs;
    __device__ __forceinline__ void operator()(const f32x4 (&acc)[2][2][4][2], const Unit& u, int wr, int wc, int fr, int fq) const {
        const int row0 = u.pm * BM + wr * 64 + fr, col0 = u.pn * HALF + wc * 32 + 8 * fq;
#pragma unroll
        for (int ai = 0; ai < 2; ++ai)
#pragma unroll
            for (int m = 0; m < 4; ++m) { const int row = row0 + ai * HALF + m * 16; const float r = ((const PG8_GAS float*)rs)[row]; bf16_t* rowp = O + (size_t)row * ldc + col0; f32x4 v[2];
#pragma unroll
                for (int n = 0; n < 2; ++n) { const f32x4 a = acc[ai][0][m][n] * r, b = acc[ai][1][m][n] * r;
#pragma unroll
                    for (int x = 0; x < 4; ++x) v[n][x] = (ACT ? a[x] * sigmoid_f(a[x]) : a[x]) * b[x]; }
                *(PG8_GAS u32x4*)rowp = pack8(v[0], v[1]); }
    }
};
struct EpiGLUq {
    static constexpr bool PERM = true, AFTER_DRAIN = false;
    bf16_t* O; int ldc; const float* ra; const float* cw;
    static constexpr bool HAS_PRE = true;
    struct Pre { f32x4 cg[2], cu[2]; float rv[2][4]; };
    __device__ __forceinline__ Pre preload(const Unit& u, int wr, int wc, int fr, int fq) const {
        const int row0 = u.pm * BM + wr * 64 + fr, wcol0 = u.pn * BM + wc * 32 + 8 * fq; Pre P;
#pragma unroll
        for (int n = 0; n < 2; ++n) { P.cg[n] = *(const PG8_GAS f32x4*)(cw + wcol0 + 4 * n); P.cu[n] = *(const PG8_GAS f32x4*)(cw + wcol0 + HALF + 4 * n); }
#pragma unroll
        for (int ai = 0; ai < 2; ++ai)
#pragma unroll
            for (int m = 0; m < 4; ++m) P.rv[ai][m] = ((const PG8_GAS float*)ra)[row0 + ai * HALF + m * 16];
        return P;
    }
    __device__ __forceinline__ void operator()(const f32x4 (&acc)[2][2][4][2], const Unit& u, int wr, int wc, int fr, int fq) const { (*this)(acc, u, wr, wc, fr, fq, preload(u, wr, wc, fr, fq)); }
    __device__ __forceinline__ void operator()(const f32x4 (&acc)[2][2][4][2], const Unit& u, int wr, int wc, int fr, int fq, const Pre& P) const {
        const int row0 = u.pm * BM + wr * 64 + fr, col0 = u.pn * HALF + wc * 32 + 8 * fq;
        f32x2 kl[2][2], kk[2][2];
#pragma unroll
        for (int n = 0; n < 2; ++n) { const f32x4 cg = P.cg[n], cu = P.cu[n];
#pragma unroll
            for (int h = 0; h < 2; ++h) { kl[n][h] = (f32x2){cg[2 * h] * -1.4426950408889634f, cg[2 * h + 1] * -1.4426950408889634f}; kk[n][h] = (f32x2){cg[2 * h] * cu[2 * h], cg[2 * h + 1] * cu[2 * h + 1]}; } }
        float rv[2][4];
#pragma unroll
        for (int ai = 0; ai < 2; ++ai)
#pragma unroll
            for (int m = 0; m < 4; ++m) rv[ai][m] = P.rv[ai][m];
#pragma unroll
        for (int ai = 0; ai < 2; ++ai)
#pragma unroll
            for (int m = 0; m < 4; ++m) { const int row = row0 + ai * HALF + m * 16; const float r = rv[ai][m], r2 = r * r; bf16_t* rowp = O + (size_t)row * ldc + col0;
                f32x2 fa[4], fb[4], e[4], q[4];
#pragma unroll
                for (int n = 0; n < 2; ++n) { const i32x4 ia = __builtin_bit_cast(i32x4, acc[ai][0][m][n]), ib = __builtin_bit_cast(i32x4, acc[ai][1][m][n]);
#pragma unroll
                    for (int h = 0; h < 2; ++h) { fa[2 * n + h] = (f32x2){(float)ia[2 * h], (float)ia[2 * h + 1]}; fb[2 * n + h] = (f32x2){(float)ib[2 * h], (float)ib[2 * h + 1]}; } }
#pragma unroll
                for (int j = 0; j < 4; ++j) { const f32x2 t = fa[j] * (kl[j >> 1][j & 1] * r); e[j] = (f32x2){__builtin_amdgcn_exp2f(t.x), __builtin_amdgcn_exp2f(t.y)}; }
#pragma unroll
                for (int j = 0; j < 4; ++j) { q[j] = (fa[j] * fb[j]) * (kk[j >> 1][j & 1] * r2); e[j] = e[j] + 1.0f; }
#pragma unroll
                for (int j = 0; j < 4; ++j) e[j] = (f32x2){__builtin_amdgcn_rcpf(e[j].x), __builtin_amdgcn_rcpf(e[j].y)};
#pragma unroll
                for (int j = 0; j < 4; ++j) q[j] = q[j] * e[j];
                u32x4 w; w.x = cvt_pk_bf16(q[0].x, q[0].y); w.y = cvt_pk_bf16(q[1].x, q[1].y); w.z = cvt_pk_bf16(q[2].x, q[2].y); w.w = cvt_pk_bf16(q[3].x, q[3].y);
                *(PG8_GAS u32x4*)rowp = w; }
    }
};
struct EpiConv {
    static constexpr bool PERM = true, AFTER_DRAIN = false;
    bf16_t* O; const bf16_t* U; const float* cw; int ldc; int seq; const float* rs; int ldr;
    __device__ __forceinline__ void operator()(const f32x4 (&acc)[2][2][4][2], const Unit& u, int wr, int wc, int fr, int fq) const {
        const int row0 = u.pm * BM + wr * 64 + fr;
        float rv[2][4];
#pragma unroll
        for (int ai = 0; ai < 2; ++ai)
#pragma unroll
            for (int m = 0; m < 4; ++m) rv[ai][m] = ((const PG8_GAS float*)rs)[row0 + ai * HALF + m * 16];
#pragma unroll
        for (int bj = 0; bj < 2; ++bj) { const int col0 = u.pn * BM + bj * HALF + wc * 32 + 8 * fq;
            f32x4 w[3][2];
#pragma unroll
            for (int k = 0; k < 3; ++k)
#pragma unroll
                for (int n = 0; n < 2; ++n) w[k][n] = *(const PG8_GAS f32x4*)(cw + (size_t)k * ldc + col0 + 4 * n);
#pragma unroll
            for (int ai = 0; ai < 2; ++ai)
#pragma unroll
                for (int m = 0; m < 4; ++m) { const int row = row0 + ai * HALF + m * 16; const int t = row & (seq - 1); const size_t off = (size_t)row * ldr + col0; const float r = rv[ai][m];
                    const u32x4 u2 = *(const PG8_GAS u32x4*)(U + off); u32x4 u1 = (u32x4){0u, 0u, 0u, 0u}, u0 = (u32x4){0u, 0u, 0u, 0u};
                    if (t >= 1) u1 = *(const PG8_GAS u32x4*)(U + off - ldr);
                    if (t >= 2) u0 = *(const PG8_GAS u32x4*)(U + off - 2 * ldr);
                    const f32x4 c0 = (w[0][0] * bf4_lo(u0) + w[1][0] * bf4_lo(u1) + w[2][0] * bf4_lo(u2)) * r, c1 = (w[0][1] * bf4_hi(u0) + w[1][1] * bf4_hi(u1) + w[2][1] * bf4_hi(u2)) * r;
                    *(PG8_GAS u32x4*)(O + off) = pack8(acc[ai][bj][m][0] * c0, acc[ai][bj][m][1] * c1);
                    if (m & 1) asm volatile("" ::: "memory"); }
        }
    }
};
struct EpiRetQK {
    static constexpr bool PERM = true, AFTER_DRAIN = false;
    bf16_t* Q; bf16_t* Kb; const float* cs; const float* sn; int seq; const float* rs; const float* step;
    __device__ __forceinline__ void operator()(const f32x4 (&acc)[2][2][4][2], const Unit& u, int wr, int wc, int fr, int fq) const {
        const int row0 = u.pm * BM + wr * 64 + fr;
        const float sc = (u.pn < 4) ? 1.0f : 0.0625f;
        bf16_t* op = ((u.pn < 4) ? Q : Kb) + (size_t)row0 * 1024 + (u.pn & 3) * 256 + wc * 32 + 8 * fq;
        const int fcol = wc * 32 + 8 * fq; const size_t toff = (size_t)(row0 & (seq - 1)) * 128 + fcol; const float* rp = rs + row0;
        float rv[2][4]; f32x4 c[2][2], sv[2][2], cst[2], sst[2];
#pragma unroll
        for (int ai = 0; ai < 2; ++ai) {
#pragma unroll
            for (int m = 0; m < 4; ++m) rv[ai][m] = ((const PG8_GAS float*)rp)[ai * HALF + m * 16] * sc;
#pragma unroll
            for (int n = 0; n < 2; ++n) { c[ai][n] = *(const PG8_GAS f32x4*)(cs + toff + (size_t)ai * HALF * 128 + 4 * n); sv[ai][n] = *(const PG8_GAS f32x4*)(sn + toff + (size_t)ai * HALF * 128 + 4 * n); } }
#pragma unroll
        for (int n = 0; n < 2; ++n) { cst[n] = *(const PG8_GAS f32x4*)(step + fcol + 4 * n); sst[n] = *(const PG8_GAS f32x4*)(step + 128 + fcol + 4 * n); }
#pragma unroll
        for (int ai = 0; ai < 2; ++ai)
#pragma unroll
            for (int m = 0; m < 4; ++m) { const int dr = ai * HALF + m * 16; f32x4 o1[2], o2[2]; const float r = rv[ai][m];
#pragma unroll
                for (int n = 0; n < 2; ++n) { const f32x4 cc = c[ai][n] * r, ss = sv[ai][n] * r;
                    const f32x4 x1 = acc[ai][0][m][n], x2 = acc[ai][1][m][n]; o1[n] = x1 * cc - x2 * ss; o2[n] = x2 * cc + x1 * ss;
                    const f32x4 cn = c[ai][n] * cst[n] - sv[ai][n] * sst[n], sn2 = sv[ai][n] * cst[n] + c[ai][n] * sst[n]; c[ai][n] = cn; sv[ai][n] = sn2; }
                *(PG8_GAS u32x4*)(op + dr * 1024) = pack8(o1[0], o1[1]); *(PG8_GAS u32x4*)(op + dr * 1024 + HALF) = pack8(o2[0], o2[1]); }
    }
};
struct EpiRetV {
    static constexpr bool PERM = true, AFTER_DRAIN = false;
    bf16_t* V; const float* rs;
    __device__ __forceinline__ void operator()(const f32x4 (&acc)[2][2][4][2], const Unit& u, int wr, int wc, int fr, int fq) const {
        const int row0 = u.pm * BM + wr * 64 + fr;
        const int head = u.pn >> 1; const float lg = __builtin_amdgcn_logf(1.0f - __builtin_amdgcn_exp2f(-5.0f - (float)head));
        bf16_t* op = V + (size_t)row0 * EPI_LDV + u.pn * 256 + wc * 32 + 8 * fq; const int j0 = 127 - (row0 & 127); const float* rp = rs + row0;
#pragma unroll
        for (int ai = 0; ai < 2; ++ai)
#pragma unroll
            for (int m = 0; m < 4; ++m) { const int dr = ai * HALF + m * 16; const float kd = __builtin_amdgcn_exp2f(lg * (float)(j0 - m * 16)) * ((const PG8_GAS float*)rp)[dr];
#pragma unroll
                for (int bj = 0; bj < 2; ++bj) *(PG8_GAS u32x4*)(op + dr * EPI_LDV + bj * HALF) = pack8(acc[ai][bj][m][0] * kd, acc[ai][bj][m][1] * kd); }
    }
};
struct EpiRetQKV {
    static constexpr bool PERM = true, AFTER_DRAIN = false;
    EpiRetQK qk; EpiRetV v;
    __device__ __forceinline__ void operator()(const f32x4 (&acc)[2][2][4][2], const Unit& u, int wr, int wc, int fr, int fq) const {
        if (u.pn < 8) qk(acc, u, wr, wc, fr, fq); else { Unit uv = u; uv.pn = u.pn - 8; v(acc, uv, wr, wc, fr, fq); }
    }
};
struct EpiRetGate {
    static constexpr bool PERM = true, AFTER_DRAIN = false;
    bf16_t* Y; const float* ssq; float eps; const float* rs;
    __device__ __forceinline__ void operator()(const f32x4 (&acc)[2][2][4][2], const Unit& u, int wr, int wc, int fr, int fq) const {
        const int row0 = u.pm * BM + wr * 64 + fr; const int head = u.pn >> 1, col0 = u.pn * BM + wc * 32 + 8 * fq;
        float rv[2][4], rn[2][4];
#pragma unroll
        for (int ai = 0; ai < 2; ++ai)
#pragma unroll
            for (int m = 0; m < 4; ++m) { const int row = row0 + ai * HALF + m * 16; rv[ai][m] = ((const PG8_GAS float*)rs)[row];
                const f32x4 s0 = *(const PG8_GAS f32x4*)(ssq + ((size_t)row * 4 + head) * 8), s1 = *(const PG8_GAS f32x4*)(ssq + ((size_t)row * 4 + head) * 8 + 4);
                const float tot = ((s0[0] + s0[1]) + (s0[2] + s0[3])) + ((s1[0] + s1[1]) + (s1[2] + s1[3])); rn[ai][m] = __builtin_amdgcn_rsqf(tot * (1.0f / 512.0f) + eps); }
#pragma unroll
        for (int ai = 0; ai < 2; ++ai)
#pragma unroll
            for (int m = 0; m < 4; ++m) { const int row = row0 + ai * HALF + m * 16; const float r = rv[ai][m], rnn = rn[ai][m];
                bf16_t* rowp = Y + (size_t)row * EPI_LDV + col0;
#pragma unroll
                for (int bj = 0; bj < 2; ++bj) { const u32x4 o = *(const PG8_GAS u32x4*)(rowp + bj * HALF); const f32x4 oa = bf4_lo(o), ob = bf4_hi(o); f32x4 va, vb;
#pragma unroll
                    for (int x = 0; x < 4; ++x) { const float a = acc[ai][bj][m][0][x] * r, b = acc[ai][bj][m][1][x] * r; va[x] = a * sigmoid_f(a) * oa[x] * rnn; vb[x] = b * sigmoid_f(b) * ob[x] * rnn; }
                    *(PG8_GAS u32x4*)(rowp + bj * HALF) = pack8(va, vb); }
                if (m & 1) asm volatile("" ::: "memory"); }
    }
};
struct EpiRetGateQ {
    static constexpr bool PERM = true, AFTER_DRAIN = false;
    bf16_t* Y; const float* ssq; float eps; const float* ra; const float* cw;
    __device__ __forceinline__ void operator()(const f32x4 (&acc)[2][2][4][2], const Unit& u, int wr, int wc, int fr, int fq) const {
        const int row0 = u.pm * BM + wr * 64 + fr; const int head = u.pn >> 1, col0 = u.pn * BM + wc * 32 + 8 * fq;
        f32x2 kl[2][4], kk[2][4];
#pragma unroll
        for (int bj = 0; bj < 2; ++bj)
#pragma unroll
            for (int n = 0; n < 2; ++n) { const f32x4 cv = *(const PG8_GAS f32x4*)(cw + col0 + bj * HALF + 4 * n);
#pragma unroll
                for (int h = 0; h < 2; ++h) { kk[bj][2 * n + h] = (f32x2){cv[2 * h], cv[2 * h + 1]}; kl[bj][2 * n + h] = (f32x2){cv[2 * h] * -1.4426950408889634f, cv[2 * h + 1] * -1.4426950408889634f}; } }
        float rv[2][4], rr[2][4];
#pragma unroll
        for (int ai = 0; ai < 2; ++ai)
#pragma unroll
            for (int m = 0; m < 4; ++m) { const int row = row0 + ai * HALF + m * 16; const float r = ((const PG8_GAS float*)ra)[row];
                const f32x4 s0 = *(const PG8_GAS f32x4*)(ssq + ((size_t)row * 4 + head) * 8), s1 = *(const PG8_GAS f32x4*)(ssq + ((size_t)row * 4 + head) * 8 + 4);
                const float tot = ((s0[0] + s0[1]) + (s0[2] + s0[3])) + ((s1[0] + s1[1]) + (s1[2] + s1[3])); rv[ai][m] = r; rr[ai][m] = r * __builtin_amdgcn_rsqf(tot * (1.0f / 512.0f) + eps); }
#pragma unroll
        for (int ai = 0; ai < 2; ++ai)
#pragma unroll
            for (int m = 0; m < 4; ++m) { const int row = row0 + ai * HALF + m * 16; const float r = rv[ai][m], rq = rr[ai][m];
                bf16_t* rowp = Y + (size_t)row * EPI_LDV + col0;
#pragma unroll
                for (int bj = 0; bj < 2; ++bj) { const u32x4 o = *(const PG8_GAS u32x4*)(rowp + bj * HALF); const f32x4 oa = bf4_lo(o), ob = bf4_hi(o);
                    const f32x2 op[4] = {(f32x2){oa[0], oa[1]}, (f32x2){oa[2], oa[3]}, (f32x2){ob[0], ob[1]}, (f32x2){ob[2], ob[3]}};
                    f32x2 fa[4], e[4], q[4];
#pragma unroll
                    for (int j = 0; j < 4; ++j) { const i32x4 ia = __builtin_bit_cast(i32x4, acc[ai][bj][m][j >> 1]); fa[j] = (f32x2){(float)ia[2 * (j & 1)], (float)ia[2 * (j & 1) + 1]}; }
#pragma unroll
                    for (int j = 0; j < 4; ++j) { const f32x2 t = fa[j] * (kl[bj][j] * r); e[j] = (f32x2){__builtin_amdgcn_exp2f(t.x), __builtin_amdgcn_exp2f(t.y)}; }
#pragma unroll
                    for (int j = 0; j < 4; ++j) { q[j] = (fa[j] * op[j]) * (kk[bj][j] * rq); e[j] = e[j] + 1.0f; }
#pragma unroll
                    for (int j = 0; j < 4; ++j) e[j] = (f32x2){__builtin_amdgcn_rcpf(e[j].x), __builtin_amdgcn_rcpf(e[j].y)};
#pragma unroll
                    for (int j = 0; j < 4; ++j) q[j] = q[j] * e[j];
                    u32x4 w; w.x = cvt_pk_bf16(q[0].x, q[0].y); w.y = cvt_pk_bf16(q[1].x, q[1].y); w.z = cvt_pk_bf16(q[2].x, q[2].y); w.w = cvt_pk_bf16(q[3].x, q[3].y);
                    *(PG8_GAS u32x4*)(rowp + bj * HALF) = w; }
                if (m & 1) asm volatile("" ::: "memory"); }
    }
};
template <class Inner> struct EpiDeq {
    static constexpr bool PERM = true, AFTER_DRAIN = false; static_assert(Inner::PERM, "EpiDeq: column map of PERM epilogues");
    Inner in; const float* cw;
    __device__ __forceinline__ void operator()(f32x4 (&acc)[2][2][4][2], const Unit& u, int wr, int wc, int fr, int fq) const {
        const int wcol0 = u.pn * BM + wc * 32 + 8 * fq;
#pragma unroll
        for (int bj = 0; bj < 2; ++bj)
#pragma unroll
            for (int n = 0; n < 2; ++n) { const f32x4 cv = *(const PG8_GAS f32x4*)(cw + wcol0 + bj * HALF + 4 * n);
#pragma unroll
                for (int ai = 0; ai < 2; ++ai)
#pragma unroll
                    for (int m = 0; m < 4; ++m) { const i32x4 iv = __builtin_bit_cast(i32x4, acc[ai][bj][m][n]); acc[ai][bj][m][n] = (f32x4){(float)iv[0], (float)iv[1], (float)iv[2], (float)iv[3]} * cv; } }
        in(acc, u, wr, wc, fr, fq);
    }
};
struct RowSsq {
    unsigned* xbuf;
    unsigned* cnt;
    unsigned* tmo;
    float eps; unsigned code;
    __device__ __forceinline__ bool run(const f32x4 (&v)[2][2][4][2], int panel, int pn, int wr, int wc, int fr, int fq, PG8_LAS unsigned char* lds, int wid, int lane) const {
        PG8_LAS float* P = (PG8_LAS float*)lds;
        PG8_LAS float* S = (PG8_LAS float*)(lds + 8192);
        PG8_LAS unsigned* flag = (PG8_LAS unsigned*)(lds + 8192 + 2048);
#pragma unroll
        for (int ai = 0; ai < 2; ++ai)
#pragma unroll
            for (int m = 0; m < 4; ++m) { float s = 0.f;
#pragma unroll
                for (int bj = 0; bj < 2; ++bj)
#pragma unroll
                    for (int n = 0; n < 2; ++n) { const f32x4 x = v[ai][bj][m][n]; s += (x[0] * x[0] + x[1] * x[1]) + (x[2] * x[2] + x[3] * x[3]); }
                s += __shfl_xor(s, 16); s += __shfl_xor(s, 32);
                if (fq == 0) P[(ai * HALF + wr * 64 + m * 16 + fr) * 4 + wc] = s; }
        asm volatile("s_waitcnt lgkmcnt(0)" ::: "memory"); __builtin_amdgcn_s_barrier(); asm volatile("" ::: "memory");
        const int row = wid * 32 + (lane & 31);
        if (lane < 32) { const float t = (P[row * 4 + 0] + P[row * 4 + 1]) + (P[row * 4 + 2] + P[row * 4 + 3]);
            unsigned long long* slot = (unsigned long long*)xbuf + ((size_t)(panel * BM + row) * 4 + pn);
            __hip_atomic_store(slot, (unsigned long long)__float_as_uint(t), __ATOMIC_RELAXED, __HIP_MEMORY_SCOPE_AGENT); }
        asm volatile("s_waitcnt vmcnt(0)" ::: "memory");
        if (lane == 0) __hip_atomic_fetch_add(cnt + 64 * panel, 1u, __ATOMIC_RELAXED, __HIP_MEMORY_SCOPE_AGENT);
        if (wid == 0) {
            bool dead = false; const unsigned long long t0 = __builtin_amdgcn_s_memrealtime(); const unsigned want = 32u;
            for (;;) {
                if ((unsigned)__builtin_amdgcn_readfirstlane(__hip_atomic_load(cnt + 64 * panel, __ATOMIC_RELAXED, __HIP_MEMORY_SCOPE_AGENT)) >= want) break;
                if (__builtin_amdgcn_s_memrealtime() - t0 > 2000000ull) {
                    if (lane == 0) { unsigned expect = 0u; __hip_atomic_compare_exchange_strong(tmo + 1, &expect, code | (unsigned)(panel & 0xff), __ATOMIC_RELAXED, __ATOMIC_RELAXED, __HIP_MEMORY_SCOPE_AGENT);
                                     __hip_atomic_store(tmo, 1u, __ATOMIC_RELAXED, __HIP_MEMORY_SCOPE_AGENT); }
                    dead = true; break; }
                __builtin_amdgcn_s_sleep(2);
            }
            __builtin_amdgcn_fence(__ATOMIC_ACQUIRE, "agent");
            if (lane == 0) flag[0] = dead ? 1u : 0u;
        }
        asm volatile("s_waitcnt vmcnt(0) lgkmcnt(0)" ::: "memory"); __builtin_amdgcn_s_barrier(); asm volatile("" ::: "memory");
        const bool bad = flag[0] != 0u;
        if (lane < 32) { const unsigned long long* slot = (const unsigned long long*)xbuf + (size_t)(panel * BM + row) * 4; float tot = 0.f;
#pragma unroll
            for (int t = 0; t < 4; ++t) { const unsigned long long w = __hip_atomic_load(slot + t, __ATOMIC_RELAXED, __HIP_MEMORY_SCOPE_AGENT); tot += __uint_as_float((unsigned)w); }
            S[row] = 1.0f / sqrtf(tot * (1.0f / 1024.0f) + eps); }
        asm volatile("s_waitcnt lgkmcnt(0)" ::: "memory"); __builtin_amdgcn_s_barrier(); asm volatile("" ::: "memory");
        return bad;
    }
};
template <bool GATED> struct EpiRmsRes {
    static constexpr bool PERM = true, AFTER_DRAIN = true;
    bf16_t* xb; float* out32; float* rs; const float* gate; const float* g_post; float scale; int row_off;
    RowSsq st1, st2; unsigned poison;
    __device__ __forceinline__ void fused(f32x4 (&acc)[2][2][4][2], const Unit& u, int wr, int wc, int fr, int fq, PG8_LAS unsigned char* lds, int wid, int lane) const {
        const PG8_LAS float* S = (const PG8_LAS float*)(lds + 8192);
        const int col0 = u.pn * BM + wc * 32 + 8 * fq, prow0 = row_off + u.pm * BM, panel = prow0 >> 8;
        if (GATED) {
#pragma unroll
            for (int ai = 0; ai < 2; ++ai)
#pragma unroll
                for (int m = 0; m < 4; ++m) { const size_t off = (size_t)(prow0 + ai * HALF + wr * 64 + m * 16 + fr) * 1024 + col0;
#pragma unroll
                    for (int bj = 0; bj < 2; ++bj)
#pragma unroll
                        for (int n = 0; n < 2; ++n) { const f32x4 gv = *(const PG8_GAS f32x4*)(gate + off + bj * HALF + n * 4);
#pragma unroll
                            for (int x = 0; x < 4; ++x) acc[ai][bj][m][n][x] *= sigmoid_f(gv[x]); }
                    asm volatile("" : "+v"(acc[ai][0][m][0]), "+v"(acc[ai][0][m][1]), "+v"(acc[ai][1][m][0]), "+v"(acc[ai][1][m][1]) :: "memory"); }
        }
        bool bad = st1.run(acc, panel, u.pn, wr, wc, fr, fq, lds, wid, lane) || poison != 0u;
        const float qnan = __builtin_nanf("");
        {
            f32x4 gp[2][2];
#pragma unroll
            for (int bj = 0; bj < 2; ++bj)
#pragma unroll
                for (int n = 0; n < 2; ++n) gp[bj][n] = *(const PG8_GAS f32x4*)(g_post + col0 + bj * HALF + n * 4);
#pragma unroll
            for (int ai = 0; ai < 2; ++ai)
#pragma unroll
                for (int m = 0; m < 4; ++m) { const int r = ai * HALF + wr * 64 + m * 16 + fr; const float sr = S[r] * scale; const size_t off = (size_t)(prow0 + r) * 1024 + col0;
#pragma unroll
                    for (int bj = 0; bj < 2; ++bj) { const u32x4 xw = *(const PG8_GAS u32x4*)(xb + off + bj * HALF);
                        const f32x4 x0 = bf4_lo(xw) + acc[ai][bj][m][0] * gp[bj][0] * sr, x1 = bf4_hi(xw) + acc[ai][bj][m][1] * gp[bj][1] * sr;
                        if (out32) { *(PG8_GAS f32x4*)(out32 + off + bj * HALF) = bad ? (f32x4){qnan, qnan, qnan, qnan} : x0; *(PG8_GAS f32x4*)(out32 + off + bj * HALF + 4) = bad ? (f32x4){qnan, qnan, qnan, qnan} : x1; }
                        const u32x4 w = pack8(x0, x1); *(PG8_GAS u32x4*)(xb + off + bj * HALF) = w;
                        acc[ai][bj][m][0] = bf4_lo(w); acc[ai][bj][m][1] = bf4_hi(w); }
                    asm volatile("" : "+v"(acc[ai][0][m][0]), "+v"(acc[ai][0][m][1]), "+v"(acc[ai][1][m][0]), "+v"(acc[ai][1][m][1]));
                    if (m & 1) asm volatile("" ::: "memory"); }
        }
        bad = st2.run(acc, panel, u.pn, wr, wc, fr, fq, lds, wid, lane) || bad;
        if (u.pn == 0 && wc == 0 && fq == 0) {
#pragma unroll
            for (int ai = 0; ai < 2; ++ai)
#pragma unroll
                for (int m = 0; m < 4; ++m) { const int r = ai * HALF + wr * 64 + m * 16 + fr; rs[prow0 + r] = bad ? qnan : S[r]; }
        }
    }
};

template <bool GATED> struct EpiRmsRes1 {
    static constexpr bool PERM = true, AFTER_DRAIN = true, XKEEP = false;
    unsigned char* wsb; float* out32; const float* g_post; float scale, eps; int cnt_word; PG8_LAS unsigned char* tab; unsigned poison; int row_off;
    static constexpr size_t O_XB = EPI_WS_XB, O_RS = EPI_WS_RS, O_GATE = EPI_WS_GATE, O_XBUF = EPI_WS_XBUF;
    __device__ __forceinline__ void fused(f32x4 (&acc)[2][2][4][2], const Unit& u, int wr, int wc, int fr, int fq, PG8_LAS unsigned char*, int wid, int lane) const {
        typedef float f32x2v __attribute__((ext_vector_type(2)));
        PG8_LAS f32x4* P = (PG8_LAS f32x4*)tab;
        PG8_LAS f32x2v* S = (PG8_LAS f32x2v*)(tab + 16384);
        PG8_LAS unsigned* flag = (PG8_LAS unsigned*)(tab + 16384 + 2048);
        bf16_t* const xb = (bf16_t*)(wsb + O_XB); float* const rs = (float*)(wsb + O_RS); const float* const gate = (const float*)(wsb + O_GATE);
        unsigned* const xbuf = (unsigned*)(wsb + O_XBUF); unsigned* const tmo = (unsigned*)wsb; unsigned* const cnt = (unsigned*)wsb + cnt_word;
        const int col0 = u.pn * BM + wc * 32 + 8 * fq, prow0 = row_off + u.pm * BM, panel = prow0 >> 8;
        u32x4 xk[4][2];
#pragma unroll
        for (int m = 0; m < 4; ++m)
#pragma unroll
            for (int bj = 0; bj < 2; ++bj) xk[m][bj] = XKEEP ? *(const PG8_GAS u32x4*)(xb + (size_t)(prow0 + wr * 64 + m * 16 + fr) * 1024 + col0 + bj * HALF) : (u32x4){0u, 0u, 0u, 0u};
        if (GATED) {
#pragma unroll
            for (int ai = 0; ai < 2; ++ai)
#pragma unroll
                for (int m = 0; m < 4; ++m) { const size_t off = (size_t)(prow0 + ai * HALF + wr * 64 + m * 16 + fr) * 1024 + col0;
#pragma unroll
                    for (int bj = 0; bj < 2; ++bj)
#pragma unroll
                        for (int n = 0; n < 2; ++n) { const f32x4 gv = *(const PG8_GAS f32x4*)(gate + off + bj * HALF + n * 4);
#pragma unroll
                            for (int x = 0; x < 4; ++x) acc[ai][bj][m][n][x] *= sigmoid_f(gv[x]); }
                    asm volatile("" : "+v"(acc[ai][0][m][0]), "+v"(acc[ai][0][m][1]), "+v"(acc[ai][1][m][0]), "+v"(acc[ai][1][m][1])); }
        }
        f32x4 gp[2][2];
#pragma unroll
        for (int bj = 0; bj < 2; ++bj)
#pragma unroll
            for (int n = 0; n < 2; ++n) gp[bj][n] = *(const PG8_GAS f32x4*)(g_post + col0 + bj * HALF + n * 4);
#pragma unroll
        for (int ai = 0; ai < 2; ++ai)
#pragma unroll
            for (int m = 0; m < 4; ++m) { float sa = 0.f, sb = 0.f, sc = 0.f, sd = 0.f;
#pragma unroll
                for (int bj = 0; bj < 2; ++bj) { u32x4 xv; if (ai == 0 && XKEEP) xv = xk[m][bj]; else xv = *(const PG8_GAS u32x4*)(xb + (size_t)(prow0 + ai * HALF + wr * 64 + m * 16 + fr) * 1024 + col0 + bj * HALF);
                    const f32x4 xl = bf4_lo(xv), xh = bf4_hi(xv);
#pragma unroll
                    for (int x = 0; x < 4; ++x) { const float h0 = acc[ai][bj][m][0][x], h1 = acc[ai][bj][m][1][x], g0 = gp[bj][0][x] * h0, g1 = gp[bj][1][x] * h1;
                        sa += h0 * h0 + h1 * h1; sc += g0 * g0 + g1 * g1; sb += xl[x] * g0 + xh[x] * g1; sd += xl[x] * xl[x] + xh[x] * xh[x]; } }
                sa += __shfl_xor(sa, 16); sb += __shfl_xor(sb, 16); sc += __shfl_xor(sc, 16); sd += __shfl_xor(sd, 16);
                sa += __shfl_xor(sa, 32); sb += __shfl_xor(sb, 32); sc += __shfl_xor(sc, 32); sd += __shfl_xor(sd, 32);
                if (fq == 0) P[(ai * HALF + wr * 64 + m * 16 + fr) * 4 + wc] = (f32x4){sa, sb, sc, sd};
                if (ai == 0 && XKEEP) asm volatile("" : "+v"(xk[m][0]), "+v"(xk[m][1]));
                asm volatile("" : "+v"(acc[ai][0][m][0]), "+v"(acc[ai][0][m][1]), "+v"(acc[ai][1][m][0]), "+v"(acc[ai][1][m][1]) :: "memory"); }
        asm volatile("s_waitcnt lgkmcnt(0)" ::: "memory"); __builtin_amdgcn_s_barrier(); asm volatile("" ::: "memory");
        const int row = wid * 32 + (lane & 31);
        if (lane < 32) { const f32x4 t = (P[row * 4 + 0] + P[row * 4 + 1]) + (P[row * 4 + 2] + P[row * 4 + 3]);
            unsigned long long* slot = (unsigned long long*)xbuf + ((size_t)(prow0 + row) * 4 + u.pn) * 2;
            __hip_atomic_store(slot, ((unsigned long long)__float_as_uint(t[1]) << 32) | __float_as_uint(t[0]), __ATOMIC_RELAXED, __HIP_MEMORY_SCOPE_AGENT);
            __hip_atomic_store(slot + 1, ((unsigned long long)__float_as_uint(t[3]) << 32) | __float_as_uint(t[2]), __ATOMIC_RELAXED, __HIP_MEMORY_SCOPE_AGENT); }
        asm volatile("s_waitcnt vmcnt(0)" ::: "memory");
        if (lane == 0) __hip_atomic_fetch_add(cnt + 64 * panel, 1u, __ATOMIC_RELAXED, __HIP_MEMORY_SCOPE_AGENT);
        if (wid == 0) {
            bool dead = false; const unsigned long long t0 = __builtin_amdgcn_s_memrealtime();
            for (;;) {
                if ((unsigned)__builtin_amdgcn_readfirstlane(__hip_atomic_load(cnt + 64 * panel, __ATOMIC_RELAXED, __HIP_MEMORY_SCOPE_AGENT)) >= 32u) break;
                if (__builtin_amdgcn_s_memrealtime() - t0 > 2000000ull) {
                    if (lane == 0) { unsigned expect = 0u; __hip_atomic_compare_exchange_strong(tmo + 1, &expect, 0x700u | (unsigned)(panel & 0xff), __ATOMIC_RELAXED, __ATOMIC_RELAXED, __HIP_MEMORY_SCOPE_AGENT);
                                     __hip_atomic_store(tmo, 1u, __ATOMIC_RELAXED, __HIP_MEMORY_SCOPE_AGENT); }
                    dead = true; break; }
                __builtin_amdgcn_s_sleep(1);
            }
            __builtin_amdgcn_fence(__ATOMIC_ACQUIRE, "agent");
            if (lane == 0) flag[0] = dead ? 1u : 0u;
        }
        asm volatile("s_waitcnt vmcnt(0) lgkmcnt(0)" ::: "memory"); __builtin_amdgcn_s_barrier(); asm volatile("" ::: "memory");
        const bool bad = flag[0] != 0u || poison != 0u;
        if (lane < 32) { const unsigned long long* slot = (const unsigned long long*)xbuf + (size_t)(prow0 + row) * 8; float ta = 0.f, tb = 0.f, tc = 0.f, td = 0.f;
#pragma unroll
            for (int t = 0; t < 4; ++t) { const unsigned long long w0 = __hip_atomic_load(slot + 2 * t, __ATOMIC_RELAXED, __HIP_MEMORY_SCOPE_AGENT), w1 = __hip_atomic_load(slot + 2 * t + 1, __ATOMIC_RELAXED, __HIP_MEMORY_SCOPE_AGENT);
                ta += __uint_as_float((unsigned)w0); tb += __uint_as_float((unsigned)(w0 >> 32)); tc += __uint_as_float((unsigned)w1); td += __uint_as_float((unsigned)(w1 >> 32)); }
            const float r1 = scale / sqrtf(ta * (1.0f / 1024.0f) + eps); const float s1 = td + r1 * ((tb + tb) + r1 * tc);
            S[row] = (f32x2v){r1, 1.0f / sqrtf(fmaxf(s1, 0.f) * (1.0f / 1024.0f) + eps)}; }
        asm volatile("s_waitcnt lgkmcnt(0)" ::: "memory"); __builtin_amdgcn_s_barrier(); asm volatile("" ::: "memory");
        const float qnan = __builtin_nanf("");
#pragma unroll
        for (int bj = 0; bj < 2; ++bj)
#pragma unroll
            for (int n = 0; n < 2; ++n) gp[bj][n] = *(const PG8_GAS f32x4*)(g_post + col0 + bj * HALF + n * 4);
#pragma unroll
        for (int ai = 0; ai < 2; ++ai)
#pragma unroll
            for (int m = 0; m < 4; ++m) { const int r = ai * HALF + wr * 64 + m * 16 + fr; const f32x2v sr = S[r]; const size_t off = (size_t)(prow0 + r) * 1024 + col0;
#pragma unroll
                for (int bj = 0; bj < 2; ++bj) { u32x4 xv; if (ai == 0 && XKEEP) xv = xk[m][bj]; else xv = *(const PG8_GAS u32x4*)(xb + off + bj * HALF);
                    f32x4 x0 = bf4_lo(xv) + acc[ai][bj][m][0] * gp[bj][0] * sr.x, x1 = bf4_hi(xv) + acc[ai][bj][m][1] * gp[bj][1] * sr.x;
                    if (bad) { x0 = (f32x4){qnan, qnan, qnan, qnan}; x1 = x0; }
                    if (out32) { *(PG8_GAS f32x4*)(out32 + off + bj * HALF) = x0; *(PG8_GAS f32x4*)(out32 + off + bj * HALF + 4) = x1; }
                    *(PG8_GAS u32x4*)(xb + off + bj * HALF) = pack8(x0, x1); }
                if (u.pn == 0 && wc == 0 && fq == 0) rs[prow0 + r] = bad ? qnan : sr.y; }
    }
};

template <bool I8> __device__ __forceinline__ f32x4 mma_frag(const bf16x8 b, const bf16x8 a, const f32x4 c) {
    if constexpr (I8) return __builtin_bit_cast(f32x4, __builtin_amdgcn_mfma_i32_16x16x64_i8(__builtin_bit_cast(i32x4, b), __builtin_bit_cast(i32x4, a), __builtin_bit_cast(i32x4, c), 0, 0, 0));
    else return __builtin_amdgcn_mfma_f32_16x16x32_bf16(b, a, c, 0, 0, 0);
}
struct NoPre {};
template <class E, class = void> struct epi_has_pre { static constexpr bool value = false; };
template <class E> struct epi_has_pre<E, decltype((void)E::HAS_PRE)> { static constexpr bool value = E::HAS_PRE; };
template <class E, bool H> struct epi_pre_t { typedef NoPre type; };
template <class E> struct epi_pre_t<E, true> { typedef typename E::Pre type; };
template <class Epi, class Sched, bool ALIGN_EPI = false, bool SP2 = false, bool I8 = false, bool BNT = false  >
__device__ __forceinline__ void gemm_phase(PG8_LAS unsigned char* lds, const Gemm g, const Sched& S, const Epi& E, int wave  ) {
    int tid_; asm volatile("v_mbcnt_lo_u32_b32 %0, -1, 0\n\tv_mbcnt_hi_u32_b32 %0, -1, %0" : "=v"(tid_)); tid_ += wave * 64;
    const int tid = tid_, wid = __builtin_amdgcn_readfirstlane(tid >> 6), lane = tid & 63, wr = wid >> 2, wc = wid & 3, fr = lane & 15, fq = lane >> 4;
    int K_ = g.K; asm volatile("" : "+s"(K_));
    const int K = K_, nt = K / BK;
    int lda_ = g.lda ? g.lda : g.K; asm volatile("" : "+s"(lda_)); const int lda = lda_;
    unsigned voffA[2], voffB[2];
#pragma unroll
    for (int i = 0; i < 2; ++i) { int R, C; stage_rc(tid * 16 + i * 8192, R, C); const int Rb = Epi::PERM ? ((R & ~31) + perm32(R & 31)) : R;
        voffA[i] = (unsigned)(R * lda + C) * 2u; voffB[i] = (unsigned)(Rb * K + C) * 2u; }
    const size_t kstep = (size_t)(BK * 2);
    const size_t hstep = (size_t)HALF * K * 2;
    const size_t hstepA = (size_t)HALF * lda * 2, tstepA = 2 * hstepA;
    const size_t tstep = 2 * hstep;
    const unsigned ldsw = (unsigned)wid * 1024u;
    const int aoff = lds_byte(wr * 64 + fr, fq * 8), boff = lds_byte(wc * 32 + fr, fq * 8);
#define PG8_SA(b, h) (((b) * 2 + (h)) * HTB)
#define PG8_SB(b, h) ((4 + (b) * 2 + (h)) * HTB)
#if PG8_ASM_STAGE
    const unsigned ldsb = (unsigned)__builtin_amdgcn_readfirstlane((int)(unsigned)(size_t)lds) + ldsw;
#define PG8_STAGE(bufoff, gbase, voff) do { _Pragma("unroll") for (int _i = 0; _i < 2; ++_i) { unsigned keep_; \
        asm volatile("s_mov_b32 %0, m0\n\ts_mov_b32 m0, %3\n\ts_nop 0\n\tglobal_load_lds_dwordx4 %1, %2\n\ts_mov_b32 m0, %0" : "=&s"(keep_) : "v"((voff)[_i]), "s"((const char*)(gbase)), "s"(ldsb + (unsigned)((bufoff) + _i * 8192)) : "memory"); } } while (0)
#define PG8_STAGE_B(bufoff, gbase, voff) do { if constexpr (BNT) { _Pragma("unroll") for (int _i = 0; _i < 2; ++_i) { unsigned keep_; \
        asm volatile("s_mov_b32 %0, m0\n\ts_mov_b32 m0, %3\n\ts_nop 0\n\tglobal_load_lds_dwordx4 %1, %2 nt\n\ts_mov_b32 m0, %0" : "=&s"(keep_) : "v"((voff)[_i]), "s"((const char*)(gbase)), "s"(ldsb + (unsigned)((bufoff) + _i * 8192)) : "memory"); } } else PG8_STAGE(bufoff, gbase, voff); } while (0)
#else
#define PG8_STAGE(bufoff, gbase, voff) do { _Pragma("unroll") for (int _i = 0; _i < 2; ++_i) \
        __builtin_amdgcn_global_load_lds((const unsigned*)((const char*)(gbase) + (voff)[_i]), (PG8_LAS unsigned*)(lds + (bufoff) + ldsw + _i * 8192), 16, 0, 0); } while (0)
#define PG8_STAGE_B(bufoff, gbase, voff) PG8_STAGE(bufoff, gbase, voff)
#endif
#define PG8_LDA(dst, b, h) do { _Pragma("unroll") for (int m = 0; m < 4; ++m) _Pragma("unroll") for (int k = 0; k < 2; ++k) dst[m][k] = *(const PG8_LAS bf16x8*)(lds + PG8_SA(b, h) + aoff + m * 2048 + k * 1024); } while (0)
#define PG8_LDB(dst, b, h) do { _Pragma("unroll") for (int n = 0; n < 2; ++n) _Pragma("unroll") for (int k = 0; k < 2; ++k) dst[n][k] = *(const PG8_LAS bf16x8*)(lds + PG8_SB(b, h) + boff + n * 2048 + k * 1024); } while (0)
#define PG8_MMA(ai, bj, At, Bt) do { __builtin_amdgcn_s_setprio(1); _Pragma("unroll") for (int m = 0; m < 4; ++m) _Pragma("unroll") for (int n = 0; n < 2; ++n) _Pragma("unroll") for (int k = 0; k < 2; ++k) \
        acc[ai][bj][m][n] = mma_frag<I8>(Bt[n][k], At[m][k], acc[ai][bj][m][n]); __builtin_amdgcn_s_setprio(0); } while (0)
#define PG8_WAIT_V(n) asm volatile("s_waitcnt vmcnt(" #n ")" ::: "memory")
#define PG8_WAIT_L(n) asm volatile("s_waitcnt lgkmcnt(" #n ")" ::: "memory")
#define PG8_BAR __builtin_amdgcn_s_barrier()
#define PG8_SCHED __builtin_amdgcn_sched_barrier(0)
    Unit cur, nxt; int ui = 0;
    typename epi_pre_t<Epi, epi_has_pre<Epi>::value>::type pre;
    if (!S.next(0, cur)) return;
    f32x4 acc[2][2][4][2];
#pragma unroll
    for (int a = 0; a < 2; ++a)
#pragma unroll
        for (int b = 0; b < 2; ++b)
#pragma unroll
            for (int m = 0; m < 4; ++m)
#pragma unroll
                for (int n = 0; n < 2; ++n) acc[a][b][m][n] = (f32x4){0.f, 0.f, 0.f, 0.f};
    bf16x8 At[4][2], B0[2][2], B1[2][2];
    const char* cA = (const char*)g.A + (size_t)cur.pm * tstepA; const char* cB = (const char*)g.Bt + (size_t)cur.pn * tstep;
    S.a_ready(cur);
    if constexpr (SP2) {
        PG8_STAGE_B(PG8_SB(0, 0), cB, voffB); PG8_STAGE_B(PG8_SB(0, 1), cB + hstep, voffB); PG8_STAGE(PG8_SA(0, 0), cA, voffA); PG8_STAGE(PG8_SA(0, 1), cA + hstepA, voffA);
        if (wr == 1) PG8_BAR;
        PG8_WAIT_V(2); PG8_BAR;
        PG8_STAGE_B(PG8_SB(1, 0), cB + kstep, voffB); PG8_STAGE(PG8_SA(1, 0), cA + kstep, voffA); PG8_STAGE_B(PG8_SB(1, 1), cB + hstep + kstep, voffB);
        PG8_WAIT_V(6); PG8_BAR;
    } else {
        PG8_STAGE_B(PG8_SB(0, 0), cB, voffB); PG8_STAGE(PG8_SA(0, 0), cA, voffA); PG8_STAGE_B(PG8_SB(0, 1), cB + hstep, voffB); PG8_STAGE(PG8_SA(0, 1), cA + hstepA, voffA);
        if (wr == 1) PG8_BAR;
        PG8_WAIT_V(4); PG8_BAR;
        PG8_STAGE_B(PG8_SB(1, 0), cB + kstep, voffB); PG8_STAGE(PG8_SA(1, 0), cA + kstep, voffA); PG8_STAGE_B(PG8_SB(1, 1), cB + hstep + kstep, voffB);
        PG8_WAIT_V(6); PG8_BAR;
    }
    for (;;) {
        const bool has_next = S.next(ui + 1, nxt);
        const char* nA = has_next ? (const char*)g.A + (size_t)nxt.pm * tstepA : cA; const char* nB = has_next ? (const char*)g.Bt + (size_t)nxt.pn * tstep : cB;
        for (int t = 0; t < nt; t += 2) {
            const bool last = (t == nt - 2);
            if constexpr (epi_has_pre<Epi>::value) { if (last) pre = E.preload(cur, wr, wc, fr, fq); }
            const char* a1 = cA + (size_t)(t + 1) * kstep;
            const char* a2 = last ? nA : cA + (size_t)(t + 2) * kstep; const char* b2 = last ? nB : cB + (size_t)(t + 2) * kstep;
            const char* a3 = a2 + kstep; const char* b3 = b2 + kstep;
            if (last && has_next) S.a_ready(nxt);
            if constexpr (SP2) {
#if PG8_LATE_STAGE
            PG8_LDB(B0, 0, 0); PG8_LDB(B1, 0, 1); PG8_SCHED; PG8_LDA(At, 0, 0);
            PG8_WAIT_V(6); PG8_WAIT_L(0); PG8_BAR; PG8_MMA(0, 0, At, B0); PG8_STAGE(PG8_SA(1, 1), a1 + hstepA, voffA); PG8_MMA(0, 1, At, B1); PG8_BAR; PG8_SCHED;
            PG8_LDA(At, 0, 1);
            PG8_WAIT_V(2); PG8_WAIT_L(0); PG8_BAR; PG8_MMA(1, 0, At, B0); PG8_STAGE_B(PG8_SB(0, 0), b2, voffB); PG8_STAGE_B(PG8_SB(0, 1), b2 + hstep, voffB); PG8_STAGE(PG8_SA(0, 0), a2, voffA); PG8_MMA(1, 1, At, B1); PG8_BAR; PG8_SCHED;
            PG8_LDB(B0, 1, 0); PG8_LDB(B1, 1, 1); PG8_SCHED; PG8_LDA(At, 1, 0);
            PG8_WAIT_V(6); PG8_WAIT_L(0); PG8_BAR; PG8_MMA(0, 0, At, B0); PG8_STAGE(PG8_SA(0, 1), a2 + hstepA, voffA); PG8_MMA(0, 1, At, B1); PG8_BAR; PG8_SCHED;
            PG8_LDA(At, 1, 1);
            PG8_WAIT_V(2); PG8_WAIT_L(0); PG8_BAR; PG8_MMA(1, 0, At, B0); PG8_STAGE_B(PG8_SB(1, 0), b3, voffB); PG8_STAGE_B(PG8_SB(1, 1), b3 + hstep, voffB); PG8_STAGE(PG8_SA(1, 0), a3, voffA); PG8_MMA(1, 1, At, B1); PG8_BAR; PG8_SCHED;
#else
            PG8_LDB(B0, 0, 0); PG8_LDB(B1, 0, 1); PG8_SCHED; PG8_LDA(At, 0, 0); PG8_STAGE(PG8_SA(1, 1), a1 + hstepA, voffA);
            PG8_WAIT_V(8); PG8_WAIT_L(0); PG8_BAR; PG8_MMA(0, 0, At, B0); PG8_MMA(0, 1, At, B1); PG8_BAR; PG8_SCHED;
            PG8_LDA(At, 0, 1); PG8_STAGE_B(PG8_SB(0, 0), b2, voffB); PG8_STAGE_B(PG8_SB(0, 1), b2 + hstep, voffB); PG8_STAGE(PG8_SA(0, 0), a2, voffA);
            PG8_WAIT_V(8); PG8_WAIT_L(0); PG8_BAR; PG8_MMA(1, 0, At, B0); PG8_MMA(1, 1, At, B1); PG8_BAR; PG8_SCHED;
            PG8_LDB(B0, 1, 0); PG8_LDB(B1, 1, 1); PG8_SCHED; PG8_LDA(At, 1, 0); PG8_STAGE(PG8_SA(0, 1), a2 + hstepA, voffA);
            PG8_WAIT_V(8); PG8_WAIT_L(0); PG8_BAR; PG8_MMA(0, 0, At, B0); PG8_MMA(0, 1, At, B1); PG8_BAR; PG8_SCHED;
            PG8_LDA(At, 1, 1); PG8_STAGE_B(PG8_SB(1, 0), b3, voffB); PG8_STAGE_B(PG8_SB(1, 1), b3 + hstep, voffB); PG8_STAGE(PG8_SA(1, 0), a3, voffA);
            PG8_WAIT_V(8); PG8_WAIT_L(0); PG8_BAR; PG8_MMA(1, 0, At, B0); PG8_MMA(1, 1, At, B1); PG8_BAR; PG8_SCHED;
#endif
            } else {
            PG8_LDB(B0, 0, 0); PG8_SCHED; PG8_LDA(At, 0, 0); PG8_STAGE(PG8_SA(1, 1), a1 + hstepA, voffA);
            PG8_WAIT_L(8); PG8_BAR; PG8_WAIT_L(0); PG8_MMA(0, 0, At, B0); PG8_BAR; PG8_SCHED;
            PG8_LDB(B1, 0, 1); PG8_STAGE_B(PG8_SB(0, 0), b2, voffB);
            PG8_BAR; PG8_WAIT_L(0); PG8_MMA(0, 1, At, B1); PG8_BAR;
            PG8_LDA(At, 0, 1); PG8_STAGE(PG8_SA(0, 0), a2, voffA);
            PG8_BAR; PG8_WAIT_L(0); PG8_MMA(1, 0, At, B0); PG8_BAR; PG8_SCHED;
            PG8_STAGE_B(PG8_SB(0, 1), b2 + hstep, voffB);
            PG8_WAIT_V(6); PG8_BAR; PG8_MMA(1, 1, At, B1); PG8_BAR;
            PG8_LDB(B0, 1, 0); PG8_SCHED; PG8_LDA(At, 1, 0); PG8_STAGE(PG8_SA(0, 1), a2 + hstepA, voffA);
            PG8_WAIT_L(8); PG8_BAR; PG8_WAIT_L(0); PG8_MMA(0, 0, At, B0); PG8_BAR; PG8_SCHED;
            PG8_LDB(B1, 1, 1); PG8_STAGE_B(PG8_SB(1, 0), b3, voffB);
            PG8_BAR; PG8_WAIT_L(0); PG8_MMA(0, 1, At, B1); PG8_BAR;
            PG8_LDA(At, 1, 1); PG8_STAGE(PG8_SA(1, 0), a3, voffA);
            PG8_BAR; PG8_WAIT_L(0); PG8_MMA(1, 0, At, B0); PG8_BAR; PG8_SCHED;
            PG8_STAGE_B(PG8_SB(1, 1), b3 + hstep, voffB);
            PG8_WAIT_V(6); PG8_BAR; PG8_MMA(1, 1, At, B1); PG8_BAR;
            }
        }
        if constexpr (ALIGN_EPI) { if (wr == 0) PG8_BAR; }
        if constexpr (!Epi::AFTER_DRAIN) { if constexpr (epi_has_pre<Epi>::value) E(acc, cur, wr, wc, fr, fq, pre); else E(acc, cur, wr, wc, fr, fq); S.done(cur); }
        if (!has_next) break;
#pragma unroll
        for (int a = 0; a < 2; ++a)
#pragma unroll
            for (int b = 0; b < 2; ++b)
#pragma unroll
                for (int m = 0; m < 4; ++m)
#pragma unroll
                    for (int n = 0; n < 2; ++n) acc[a][b][m][n] = (f32x4){0.f, 0.f, 0.f, 0.f};
        cur = nxt; cA = nA; cB = nB; ++ui;
        if constexpr (ALIGN_EPI) { if (wr == 1) PG8_BAR; }
    }
    PG8_WAIT_V(0);
    if constexpr (!ALIGN_EPI) { if (wr == 0) PG8_BAR; }
    PG8_BAR;
    if constexpr (Epi::AFTER_DRAIN) { E.fused(acc, cur, wr, wc, fr, fq, lds, wid, lane); S.done(cur); }
#undef PG8_SA
#undef PG8_SB
#undef PG8_STAGE
#undef PG8_STAGE_B
#undef PG8_LDA
#undef PG8_LDB
#undef PG8_MMA
#undef PG8_WAIT_V
#undef PG8_WAIT_L
#undef PG8_BAR
#undef PG8_SCHED
}
}
#define GAS __attribute__((address_space(1)))
#define LAS __attribute__((address_space(3)))
typedef unsigned short bf16;
typedef unsigned v4u __attribute__((ext_vector_type(4)));
typedef float f32x4 __attribute__((ext_vector_type(4)));
typedef short bf16x8 __attribute__((ext_vector_type(8)));
typedef GAS unsigned gu32;
typedef GAS unsigned long long gu64;
#define RLX_AGENT __ATOMIC_RELAXED, __HIP_MEMORY_SCOPE_AGENT
#define LDS_WAIT() asm volatile("s_waitcnt lgkmcnt(0)" ::: "memory")
#define VM_WAIT() asm volatile("s_waitcnt vmcnt(0)" ::: "memory")
__device__ __forceinline__ unsigned long long rt() { return __builtin_amdgcn_s_memrealtime(); }
__device__ __forceinline__ unsigned f2bf(float f) { unsigned u = __builtin_bit_cast(unsigned, f); return (u + 0x7fffu + ((u >> 16) & 1u)) >> 16; }
__device__ __forceinline__ unsigned pk2(float lo, float hi) { return f2bf(lo) | (f2bf(hi) << 16); }

#define XB_TMO      128
#define XB_XCNT(j)  (256  + 64 * (j))
#define XB_XSUB(j)  (1280 + 64 * (j))
#define XB_XGEN(j)  (2304 + 64 * (j))
#define XB_TOP      3328
#define XB_TOPGEN   3392
#define XCD_BAR_WORDS 3456
#define XB_SPIN_CAP (1u << 18)

__device__ __forceinline__ unsigned xb_ld(unsigned* p)              { return __hip_atomic_load(p, __ATOMIC_RELAXED, __HIP_MEMORY_SCOPE_AGENT); }
__device__ __forceinline__ unsigned xb_add(unsigned* p, unsigned v) { return __hip_atomic_fetch_add(p, v, __ATOMIC_RELAXED, __HIP_MEMORY_SCOPE_AGENT); }
__device__ __forceinline__ unsigned xb_xcc_id() { return (unsigned)__builtin_amdgcn_s_getreg((3 << 11) | 20) & 0xFu; }
#define XB_SPIN(cond, bar) do { unsigned _sp = 0; while (cond) { __builtin_amdgcn_s_sleep(1); \
    if ((++_sp & 255u) == 0u) { if (xb_ld(&(bar)[XB_TMO])) break; if (_sp > XB_SPIN_CAP) { atomicAdd(&(bar)[XB_TMO], 1u); break; } } } } while (0)

struct XcdBarrier {
    unsigned* bar; unsigned x; int wave;
    volatile LAS unsigned* st;
};

__device__ __forceinline__ int cur_lane() { int r; asm volatile("v_mbcnt_lo_u32_b32 %0, -1, 0\n\tv_mbcnt_hi_u32_b32 %0, -1, %0" : "=v"(r)); return r; }
__device__ __forceinline__ bool xb_thread0(int wave) { return wave == 0 && cur_lane() == 0; }
__device__ __forceinline__ XcdBarrier xcd_barrier_post(unsigned* bar, volatile LAS unsigned* st, int wave) {
    XcdBarrier b; b.bar = bar; b.x = xb_xcc_id(); b.st = st; b.wave = wave;
    if (xb_thread0(wave)) (void)xb_add(&bar[XB_XCNT(b.x)], 1u);
    return b;
}
__device__ __forceinline__ void xcd_barrier_complete(unsigned* bar, unsigned x, unsigned& nloc, unsigned& nx) {
    const unsigned G = gridDim.x * gridDim.y * gridDim.z;
    unsigned sum, cnt, mine, sp = 0u;
    for (;;) {
        sum = 0u; cnt = 0u; mine = 0u;
#pragma unroll
        for (unsigned j = 0; j < 16; ++j) { const unsigned c = xb_ld(&bar[XB_XCNT(j)]); sum += c; cnt += (c > 0u) ? 1u : 0u; mine = (j == x) ? c : mine; }
        if (sum == G) break;
        __builtin_amdgcn_s_sleep(1);
        if ((++sp & 255u) == 0u) { if (xb_ld(&bar[XB_TMO])) break; if (sp > XB_SPIN_CAP) { atomicAdd(&bar[XB_TMO], 1u); break; } }
    }
    nloc = mine > 0u ? mine : 1u; nx = cnt > 0u ? cnt : 1u;
}

__device__ __forceinline__ void xcd_barrier(const XcdBarrier& b) {
    asm volatile("s_waitcnt vmcnt(0)" ::: "memory");
    __syncthreads();
    if (xb_thread0(b.wave)) {
        unsigned* bar = b.bar;
        __builtin_amdgcn_s_waitcnt(0);
        unsigned nloc = b.st[0], nx = b.st[1];
        if (nloc == 0u) { xcd_barrier_complete(bar, b.x, nloc, nx); b.st[0] = nloc; b.st[1] = nx; }
        const unsigned old = xb_add(&bar[XB_XSUB(b.x)], 1u);
        const unsigned gen = old / nloc;
        if (old + 1u == (gen + 1u) * nloc) {
            __builtin_amdgcn_fence(__ATOMIC_RELEASE, "agent");
            asm volatile("s_waitcnt vmcnt(0)" ::: "memory");
            const unsigned og = xb_add(&bar[XB_TOP], 1u);
            const unsigned tg = og / nx;
            if (og + 1u == (tg + 1u) * nx) xb_add(&bar[XB_TOPGEN], 1u);
            else XB_SPIN(xb_ld(&bar[XB_TOPGEN]) == tg, bar);
            __builtin_amdgcn_fence(__ATOMIC_ACQUIRE, "agent");
            xb_add(&bar[XB_XGEN(b.x)], 1u);
            asm volatile("s_waitcnt vmcnt(0)" ::: "memory");
        } else {
            XB_SPIN(xb_ld(&bar[XB_XGEN(b.x)]) == gen, bar);
            __builtin_amdgcn_fence(__ATOMIC_ACQUIRE, "agent");
            asm volatile("s_waitcnt vmcnt(0)" ::: "memory");
        }
    }
    __syncthreads();
}

#define GRP_SPIN_CAP (1u << 22)
struct GroupBar { gu32* cnt; volatile LAS unsigned* st; int wave; unsigned n; };
__device__ __forceinline__ void group_barrier(const GroupBar& gb) {
    asm volatile("s_waitcnt vmcnt(0)" ::: "memory");
    __syncthreads();
    if (xb_thread0(gb.wave)) {
        const unsigned gen = gb.st[0] + 1u; gb.st[0] = gen;
        (void)__hip_atomic_fetch_add(gb.cnt, 1u, RLX_AGENT);
        unsigned sp = 0u;
        while (__hip_atomic_load(gb.cnt, RLX_AGENT) < gb.n * gen) { __builtin_amdgcn_s_sleep(1); if (++sp > GRP_SPIN_CAP) break; }
        __builtin_amdgcn_fence(__ATOMIC_ACQUIRE, "agent");
        asm volatile("s_waitcnt vmcnt(0)" ::: "memory");
    }
    __syncthreads();
}
__device__ __forceinline__ unsigned grp_mode_decide(gu32* masks, int G) {
    unsigned ok = (G == 256) ? 1u : 0u;
    for (int x = 0; x < 8; ++x) { const unsigned m0 = __hip_atomic_load(masks + 64 * (8 * x), RLX_AGENT); ok &= (m0 != 0u && (m0 & (m0 - 1u)) == 0u) ? 1u : 0u;
        for (int y = 1; y < 8; ++y) ok &= (__hip_atomic_load(masks + 64 * (8 * x + y), RLX_AGENT) == m0) ? 1u : 0u; }
    return ok ? 1u : 2u;
}
#define RET_HD __host__ __device__ __forceinline__
RET_HD unsigned off_b(unsigned row, unsigned ch) { return 256u * row + 16u * (ch ^ (((row & 3u) << 2) | ((row >> 2) & 3u))); }
RET_HD unsigned koff(unsigned j, unsigned d) { return (d >> 7) * 32768u + off_b(j, (d & 127u) >> 3) + (d & 7u) * 2u; }
RET_HD unsigned vswz(unsigned j) { return ((j >> 1) & 1u) | (((j >> 2) & 3u) << 1); }
RET_HD unsigned voff(unsigned j, unsigned e) { return 128u * j + 16u * ((e >> 3) ^ vswz(j)) + (e & 7u) * 2u; }
RET_HD unsigned soff(unsigned e, unsigned d) { return (d >> 7) * 16384u + off_b(e, (d & 127u) >> 3) + (d & 7u) * 2u; }
constexpr unsigned RET_LDS_K = 0u, RET_LDS_V = 65536u, RET_LDS_S = 81920u, RET_LDS_END = 114688u;
#ifndef PG8_SP2
#define PG8_SP2 true
#endif
#ifndef PG8_ALIGN
#define PG8_ALIGN true
#endif
#ifndef GROUP_MERGE
#define GROUP_MERGE 1
#endif
#ifndef NORM_NT
#define NORM_NT 1
#endif
#if NORM_NT
#define NORM_LD(p) __builtin_nontemporal_load(p)
#else
#define NORM_LD(p) (*(p))
#endif
#ifndef XQ_PITCH
#define XQ_PITCH (2 * D)
#endif
#ifndef MK_PER_PHASE
#define MK_PER_PHASE 0
#endif
constexpr int NWAVES = 8;

constexpr int BATCH = 8, SEQ = 4096, D = 1024, FF = 2816, DPLE = 256, NHEAD = 4, DK = 256, DV = 512, CHUNK = 128, NCHUNK = SEQ / CHUNK;
constexpr int M = BATCH * SEQ;
constexpr int NRQKV = 2 * NHEAD * DK + NHEAD * DV;
constexpr float NORM_EPS = 1e-6f;
enum { FFN1_PRE = 0, FFN1_POST, MIX_PRE, MIX_POST, FFN2_PRE, FFN2_POST, PLE_PRE, PLE_POST };

constexpr size_t MiB = 1u << 20;
constexpr size_t WS_CTL = 0, CTL_ZERO_BYTES = 1 * MiB;
constexpr size_t WS_RS = 1 * MiB;
constexpr size_t WS_RA = 1 * MiB + 256 * 1024;
constexpr size_t WS_CW = 1 * MiB + 512 * 1024;
constexpr size_t WS_CW2 = 1 * MiB + 512 * 1024 + 96 * 1024;
constexpr size_t WS_COS = 2 * MiB, WS_SIN = 4 * MiB;
constexpr size_t WS_SSQ = 6 * MiB;
constexpr size_t WS_W = 10 * MiB;
constexpr size_t W_GU = 0, W_DN = (size_t)2 * FF * D, W_FFN = W_DN + (size_t)D * FF;
constexpr size_t W_LAYER = 2 * W_FFN + (size_t)D * DPLE + (size_t)D * D;
constexpr size_t W_PP = 2 * W_FFN, W_PG = W_PP + (size_t)D * DPLE;
constexpr size_t W_CCH = 2 * W_LAYER, W_CB = W_CCH + (size_t)2 * D * D, W_CO = W_CB + (size_t)D * D;
constexpr size_t W_RIN = W_CO + (size_t)D * D, W_ROUT = W_RIN + (size_t)6144 * D, W_END = W_ROUT + (size_t)D * 2048;
static_assert(W_END * 2 <= 96 * MiB, "weights fit 96 MiB");
constexpr size_t WS_STEP = 105 * MiB;
constexpr size_t WS_PB = 106 * MiB;
constexpr size_t WS_XN = 138 * MiB;
constexpr size_t WS_HBUF = 202 * MiB;
constexpr size_t WS_Q = WS_HBUF, WS_K = WS_HBUF + 64 * MiB;
constexpr size_t WS_XQ = WS_HBUF + 64 * MiB;
constexpr size_t WS_BIG = 330 * MiB;
constexpr size_t WS_V = WS_BIG, WS_U = WS_BIG, WS_AB = WS_BIG + (size_t)D * 2;
constexpr int LDV = FF, XQ_LD = XQ_PITCH;
static_assert(LDV == EPI_LDV, "epilogue copy of the row stride");
constexpr size_t WS_XB = 506 * MiB;
constexpr size_t WS_END = 508 * MiB;
static_assert(WS_BIG + (size_t)M * FF * 2 <= WS_XB, "ws map");
static_assert(EPI_WS_XB == WS_XN && EPI_WS_RS == WS_RS && EPI_WS_GATE == WS_HBUF && EPI_WS_XBUF == WS_XB && WS_CTL == 0, "the fused epilogue's copies of the workspace offsets");
constexpr int CW_TMO = 0, CW_CODE = 1, CW_BAR = 4096;

constexpr int RING_OFF = 0, RING_BYTES = 131072;
constexpr int LDSCTL_OFF = RING_BYTES, MISC_OFF = LDSCTL_OFF + 320;
constexpr int TAB_OFF = RING_BYTES + 1024, TAB_BYTES = 16384 + 2048 + 64;
constexpr int LDS_BYTES = 151552;
static_assert(TAB_OFF + TAB_BYTES <= LDS_BYTES && MISC_OFF + 128 <= TAB_OFF, "LDS map");

struct Frame {
    LAS unsigned char* lds;
    volatile LAS unsigned* MISC;
    gu32* ctl;
    int wave;
    int vcu, G;
};


__device__ __forceinline__ float wave_max(float v) {
#pragma unroll
    for (int o = 1; o < 64; o <<= 1) v = fmaxf(v, __shfl_xor(v, o));
    return v;
}
__device__ __forceinline__ unsigned q4(float a, float b, float c, float d) {
    return ((unsigned)(int)__builtin_rintf(a) & 0xffu) | (((unsigned)(int)__builtin_rintf(b) & 0xffu) << 8) | (((unsigned)(int)__builtin_rintf(c) & 0xffu) << 16) | ((unsigned)(int)__builtin_rintf(d) << 24);
}
__device__ __forceinline__ float wave_sum(float v) {
#pragma unroll
    for (int o = 1; o < 64; o <<= 1) v += __shfl_xor(v, o);
    return v;
}
__device__ __forceinline__ void p0_transpose_item(const float* W, int ldw, int K, bf16* WT, int k0, int ncol0, int drow0, LAS float* scr, int lane, const float* gk) {
    const int c = lane & 7;
    f32x4 ga = (f32x4){1.f, 1.f, 1.f, 1.f}, gb = ga;
    if (gk) { ga = *(const GAS f32x4*)(gk + k0 + 8 * c); gb = *(const GAS f32x4*)(gk + k0 + 8 * c + 4); }
#pragma unroll 8
    for (int i = 0; i < 32; ++i) { const int kk = 2 * i + (lane >> 5); scr[kk * 33 + (lane & 31)] = NORM_LD((const GAS float*)W + (size_t)(k0 + kk) * ldw + ncol0 + (lane & 31)); }
    LDS_WAIT(); asm volatile("" ::: "memory");
#pragma unroll
    for (int j = 0; j < 4; ++j) { const int n = (lane >> 3) + 8 * j; const LAS float* s = scr + (8 * c) * 33 + n;
        v4u o; o.x = pk2(s[0 * 33] * ga.x, s[1 * 33] * ga.y); o.y = pk2(s[2 * 33] * ga.z, s[3 * 33] * ga.w); o.z = pk2(s[4 * 33] * gb.x, s[5 * 33] * gb.y); o.w = pk2(s[6 * 33] * gb.z, s[7 * 33] * gb.w);
        *(GAS v4u*)(WT + (size_t)(drow0 + n) * K + k0 + 8 * c) = o; }
    LDS_WAIT(); asm volatile("" ::: "memory");
}
struct WJob { const float* W; int ldw, col0, K, N; bf16* WT; int glu_off; const float* gk; };
struct KArgs { const float* in[16]; float* out; unsigned char* ws; int ph_lo, ph_hi; };
__device__ __forceinline__ WJob wjob(const KArgs& a, bf16* wb, int j) {
    WJob r; const float* gains = a.in[2];
    if (j < 16) { const int l = j >> 3, k = j & 7; bf16* lw = wb + (size_t)l * W_LAYER; const float* g = gains + (size_t)l * 8 * D;
        switch (k) {
        case 0: r = WJob{a.in[3] + (size_t)l * D * FF, FF, 0, D, FF, lw + W_GU, 0, g + FFN1_PRE * D}; break;
        case 1: r = WJob{a.in[4] + (size_t)l * D * FF, FF, 0, D, FF, lw + W_GU, 128, g + FFN1_PRE * D}; break;
        case 2: r = WJob{a.in[5] + (size_t)l * D * FF, D, 0, FF, D, lw + W_DN, -1, nullptr}; break;
        case 3: r = WJob{a.in[6] + (size_t)l * D * FF, FF, 0, D, FF, lw + W_FFN + W_GU, 0, g + FFN2_PRE * D}; break;
        case 4: r = WJob{a.in[7] + (size_t)l * D * FF, FF, 0, D, FF, lw + W_FFN + W_GU, 128, g + FFN2_PRE * D}; break;
        case 5: r = WJob{a.in[8] + (size_t)l * D * FF, D, 0, FF, D, lw + W_FFN + W_DN, -1, nullptr}; break;
        case 6: r = WJob{a.in[14] + (size_t)l * DPLE * D, D, 0, DPLE, D, lw + W_PP, -1, nullptr}; break;
        default: r = WJob{a.in[15] + (size_t)l * D * D, D, 0, D, D, lw + W_PG, -1, g + PLE_PRE * D}; break;
        }
        return r; }
    switch (j) {
    case 16: r = WJob{a.in[9], 3 * D, 0, D, D, wb + W_CB, -1, gains + MIX_PRE * D}; break;
    case 17: r = WJob{a.in[9], 3 * D, D, D, D, wb + W_CCH, 0, gains + MIX_PRE * D}; break;
    case 18: r = WJob{a.in[9], 3 * D, 2 * D, D, D, wb + W_CCH, 128, gains + MIX_PRE * D}; break;
    case 19: r = WJob{a.in[11], D, 0, D, D, wb + W_CO, -1, nullptr}; break;
    case 20: r = WJob{a.in[12], 6144, 0, D, NRQKV, wb + W_RIN, -1, gains + (size_t)8 * D + MIX_PRE * D}; break;
    default: r = WJob{a.in[13], D, 0, 2048, D, wb + W_ROUT, -1, nullptr}; break;
    }
    return r;
}
constexpr int N_WJOBS = 22;

__device__ __forceinline__ void xb_rows(Frame& F, const float* xsrc, bf16* xb, float* rs, signed char* xq, float* ra) {
    const int gw = F.vcu * NWAVES + F.wave, NGW = F.G * NWAVES;
    int lane = cur_lane(); asm volatile("" : "+v"(lane));
    for (int m = gw; m < M; m += NGW) {
        const GAS f32x4* xr = (const GAS f32x4*)(xsrc + (size_t)m * D) + lane;
        float s2 = 0.f, am = 0.f; f32x4 z[4];
#pragma unroll
        for (int j = 0; j < 4; ++j) { const f32x4 v = NORM_LD(xr + 64 * j); const unsigned w0 = pk2(v.x, v.y), w1 = pk2(v.z, v.w);
            z[j] = (f32x4){__uint_as_float(w0 << 16), __uint_as_float(w0 & 0xffff0000u), __uint_as_float(w1 << 16), __uint_as_float(w1 & 0xffff0000u)};
            s2 += (z[j].x * z[j].x + z[j].y * z[j].y) + (z[j].z * z[j].z + z[j].w * z[j].w); am = fmaxf(fmaxf(am, fmaxf(fabsf(z[j].x), fabsf(z[j].y))), fmaxf(fabsf(z[j].z), fabsf(z[j].w)));
            }
        const float r2 = 1.f / sqrtf(wave_sum(s2) * (1.f / D) + NORM_EPS); am = wave_max(am); const float qs = am > 0.f ? 127.f / am : 0.f;
        GAS unsigned* oq = (GAS unsigned*)(xq + (size_t)m * XQ_LD) + lane;
#pragma unroll
        for (int j = 0; j < 4; ++j) oq[64 * j] = q4(z[j].x * qs, z[j].y * qs, z[j].z * qs, z[j].w * qs);
        if (lane == 0) { ((GAS float*)rs)[m] = r2; ((GAS float*)ra)[m] = r2 * am * (1.f / 127.f); }
    }
}

template <bool XF32  >
__device__ __forceinline__ void norm_pair(const bf16* hsrc, bf16* xb, float* rs, float scale, float* out32, signed char* xq, float* ra, const int m0, const int lane, const f32x4 (&gp)[2][2], const float omul, const int xq_ld, const float* x32) {
    v4u hw[2][2], xw[2][2]; f32x4 xf[2][2][2];
#pragma unroll
    for (int q = 0; q < 2; ++q)
#pragma unroll
        for (int j = 0; j < 2; ++j) { hw[q][j] = NORM_LD((const GAS v4u*)(hsrc + (size_t)(m0 + q) * D + 512 * j + 8 * lane));
            if constexpr (XF32) { xf[q][j][0] = NORM_LD((const GAS f32x4*)(x32 + (size_t)(m0 + q) * D + 512 * j + 8 * lane)); xf[q][j][1] = NORM_LD((const GAS f32x4*)(x32 + (size_t)(m0 + q) * D + 512 * j + 8 * lane + 4)); }
            else xw[q][j] = NORM_LD((const GAS v4u*)(xb + (size_t)(m0 + q) * D + 512 * j + 8 * lane)); }
#pragma unroll
    for (int q = 0; q < 2; ++q) {
        f32x4 h[2][2], x[2][2]; float s = 0.f;
#pragma unroll
        for (int j = 0; j < 2; ++j) { h[j][0] = pg8::bf4_lo(hw[q][j]); h[j][1] = pg8::bf4_hi(hw[q][j]); if constexpr (XF32) { const v4u t = pg8::pack8(xf[q][j][0], xf[q][j][1]); x[j][0] = pg8::bf4_lo(t); x[j][1] = pg8::bf4_hi(t); }     else { x[j][0] = pg8::bf4_lo(xw[q][j]); x[j][1] = pg8::bf4_hi(xw[q][j]); }
#pragma unroll
            for (int n = 0; n < 2; ++n) s += (h[j][n].x * h[j][n].x + h[j][n].y * h[j][n].y) + (h[j][n].z * h[j][n].z + h[j][n].w * h[j][n].w); }
        const float r1 = scale / sqrtf(wave_sum(s) * (1.f / D) + NORM_EPS); float s2 = 0.f;
#pragma unroll
        for (int j = 0; j < 2; ++j) { const f32x4 y0 = x[j][0] + h[j][0] * gp[j][0] * r1, y1 = x[j][1] + h[j][1] * gp[j][1] * r1;
            if (out32) { __builtin_nontemporal_store(y0 * omul, (GAS f32x4*)(out32 + (size_t)(m0 + q) * D + 512 * j + 8 * lane)); __builtin_nontemporal_store(y1 * omul, (GAS f32x4*)(out32 + (size_t)(m0 + q) * D + 512 * j + 8 * lane + 4)); }
            const v4u w = pg8::pack8(y0, y1); if (!out32) *(GAS v4u*)(xb + (size_t)(m0 + q) * D + 512 * j + 8 * lane) = w;
            const f32x4 z0 = pg8::bf4_lo(w), z1 = pg8::bf4_hi(w); s2 += ((z0.x * z0.x + z0.y * z0.y) + (z0.z * z0.z + z0.w * z0.w)) + ((z1.x * z1.x + z1.y * z1.y) + (z1.z * z1.z + z1.w * z1.w));
            x[j][0] = z0; x[j][1] = z1; }
        const float r2 = 1.f / sqrtf(wave_sum(s2) * (1.f / D) + NORM_EPS);
        if (lane == 0) ((GAS float*)rs)[m0 + q] = r2;
        if (xq) { float am = 0.f;
#pragma unroll
            for (int j = 0; j < 2; ++j)
#pragma unroll
                for (int n = 0; n < 2; ++n) am = fmaxf(fmaxf(am, fmaxf(fabsf(x[j][n].x), fabsf(x[j][n].y))), fmaxf(fabsf(x[j][n].z), fabsf(x[j][n].w)));
            am = wave_max(am); const float qs = am > 0.f ? 127.f / am : 0.f;
#pragma unroll
            for (int j = 0; j < 2; ++j) { const unsigned long long pk = (unsigned long long)q4(x[j][0].x * qs, x[j][0].y * qs, x[j][0].z * qs, x[j][0].w * qs) | ((unsigned long long)q4(x[j][1].x * qs, x[j][1].y * qs, x[j][1].z * qs, x[j][1].w * qs) << 32);
                *(GAS unsigned long long*)(xq + (size_t)(m0 + q) * xq_ld + 512 * j + 8 * lane) = pk; }
            if (lane == 0) ((GAS float*)ra)[m0 + q] = r2 * am * (1.f / 127.f); }
    }
}
__device__ __forceinline__ void norm_gains(const float* g_post, int lane, f32x4 (&gp)[2][2]) {
#pragma unroll
    for (int j = 0; j < 2; ++j) { gp[j][0] = *(const GAS f32x4*)(g_post + 512 * j + 8 * lane); gp[j][1] = *(const GAS f32x4*)(g_post + 512 * j + 8 * lane + 4); }
}
template <bool XF32 = false, class Sched>
__device__ __forceinline__ void norm_rows_g(Frame& F, const Sched& S, const bf16* hsrc, bf16* xb, float* rs, const float* g_post, float scale, float* out32, signed char* xq, float* ra, const float omul = 1.0f, const int xq_ld = XQ_LD, const float* x32 = nullptr) {
    int lane = cur_lane();
    f32x4 gp[2][2]; norm_gains(g_post, lane, gp);
    pg8::Unit u;
    for (int i = 0; S.next(i, u); ++i) { const int base = u.pm * pg8::BM + u.pn * (pg8::BM / 4) + 2 * F.wave;
        for (int k = 0; k < 4; ++k) norm_pair<XF32>(hsrc, xb, rs, scale, out32, xq, ra, base + 16 * k, lane, gp, omul, xq_ld, x32); }
}

struct QJob { const float* W; const float* gk; signed char* WQ; float* cwf; int glu_off; int ldw; };
struct QSrc { const float* g1; const float* u1; const float* g2; const float* u2; const float* gains; const float* pg; const float* rin; };
constexpr int Q_STRIPS_GU = 8 * (FF / 32), Q_STRIPS_PG = 2 * (D / 32), Q_STRIPS_RG = 6144 / 32, Q_STRIPS = Q_STRIPS_GU + Q_STRIPS_PG + Q_STRIPS_RG;
__device__ __forceinline__ QJob qjob(const QSrc a, unsigned char* ws, int st, int& n0) {
    const float* gains = a.gains; QJob r; bf16* wb = (bf16*)(ws + WS_W);
    if (st >= Q_STRIPS_GU + Q_STRIPS_PG) {
        n0 = 32 * (st - Q_STRIPS_GU - Q_STRIPS_PG); r.W = a.rin; r.ldw = 6144; r.gk = gains + (size_t)8 * D + MIX_PRE * D; r.WQ = (signed char*)(wb + W_RIN); r.cwf = (float*)(ws + WS_CW2) + 2 * D; r.glu_off = -1; return r; }
    if (st >= Q_STRIPS_GU) { const int q = st - Q_STRIPS_GU, l = q / (D / 32);
        n0 = 32 * (q % (D / 32)); r.W = a.pg + (size_t)l * D * D; r.ldw = D; r.gk = gains + (size_t)l * 8 * D + PLE_PRE * D; r.WQ = (signed char*)(wb + (size_t)l * W_LAYER + W_PG); r.cwf = (float*)(ws + WS_CW2) + l * D; r.glu_off = -1; return r; }
    const int j = st / (FF / 32), l = j >> 2, f = (j >> 1) & 1, which = j & 1; n0 = 32 * (st % (FF / 32));
    { const float* w0 = f ? (which ? a.u2 : a.g2) : (which ? a.u1 : a.g1); r.W = w0 + (size_t)l * D * FF; } r.gk = gains + (size_t)l * 8 * D + (f ? FFN2_PRE : FFN1_PRE) * D; r.ldw = FF;
    r.WQ = (signed char*)(wb + (size_t)l * W_LAYER + (size_t)f * W_FFN + W_GU); r.cwf = (float*)(ws + WS_CW) + (l * 2 + f) * 2 * FF; r.glu_off = which * 128;
    return r;
}
__device__ __forceinline__ void q_strip(const QJob& jb, int n0, LAS float* scr  , LAS float* red  , int wave, int lane) {
    { const int n = lane & 31, hf = lane >> 5; float mx = 0.f;
#pragma unroll
      for (int t = 0; t < 2; ++t) { const int k0 = 128 * wave + 64 * t;
#pragma unroll
          for (int i4 = 0; i4 < 8; ++i4) { const f32x4 gv = *(const GAS f32x4*)(jb.gk + k0 + 32 * hf + 4 * i4);
#pragma unroll
              for (int x = 0; x < 4; ++x) { const float v = NORM_LD((const GAS float*)jb.W + (size_t)(k0 + 32 * hf + 4 * i4 + x) * jb.ldw + n0 + n) * gv[x]; scr[t * 2048 + (32 * hf + 4 * i4 + x) * 32 + n] = v; mx = fmaxf(mx, fabsf(v)); } } }
      mx = fmaxf(mx, __shfl_xor(mx, 32));
      if (hf == 0) red[wave * 32 + n] = mx; }
    __syncthreads();
    const int n = lane >> 1, hf = lane & 1;
    float cm = 0.f;
#pragma unroll
    for (int w8 = 0; w8 < 8; ++w8) cm = fmaxf(cm, red[w8 * 32 + n]);
    const float qs = cm > 0.f ? 127.f / cm : 0.f;
    const int drow = jb.glu_off < 0 ? (n0 + n) : (((n0 + n) >> 7) * 256 + jb.glu_off + ((n0 + n) & 127));
#pragma unroll
    for (int t = 0; t < 2; ++t) { const LAS float* s = scr + t * 2048 + (32 * hf) * 32 + n; unsigned w[8];
#pragma unroll
        for (int i4 = 0; i4 < 8; ++i4) w[i4] = q4(s[(4 * i4 + 0) * 32] * qs, s[(4 * i4 + 1) * 32] * qs, s[(4 * i4 + 2) * 32] * qs, s[(4 * i4 + 3) * 32] * qs);
        GAS v4u* dst = (GAS v4u*)(jb.WQ + (size_t)drow * D + 128 * wave + 64 * t + 32 * hf);
        dst[0] = (v4u){w[0], w[1], w[2], w[3]}; dst[1] = (v4u){w[4], w[5], w[6], w[7]}; }
    if (wave == 0 && hf == 0) ((GAS float*)jb.cwf)[drow] = cm * (1.f / 127.f);
    __syncthreads();
}

#ifndef PRO_REP
#define PRO_REP 0
#endif
__device__ __forceinline__ void p0_prologue(Frame& F, const KArgs& a) {
    unsigned char* ws = a.ws;
    LAS float* scr = (LAS float*)(F.lds + RING_OFF + F.wave * 16384);
    const int gw = F.vcu * NWAVES + F.wave, NGW = F.G * NWAVES; const int lane0 = cur_lane();
    bf16* wb = (bf16*)(ws + WS_W);
    for (int rp_ = 0; rp_ <= ((PRO_REP >> 0) & 1); ++rp_)
    { const QSrc qs{a.in[3], a.in[4], a.in[6], a.in[7], a.in[2], a.in[15], a.in[12]};
      for (int st = F.vcu; st < Q_STRIPS; st += F.G) { int n0; const QJob jb = qjob(qs, ws, st, n0);
          q_strip(jb, n0, scr, (LAS float*)(F.lds + TAB_OFF), F.wave, lane0); } }
    for (int rp_ = 0; rp_ <= ((PRO_REP >> 1) & 1); ++rp_)
    for (int j = 0; j < N_WJOBS; ++j) {
        if ((j < 16 && ((j & 7) == 0 || (j & 7) == 1 || (j & 7) == 3 || (j & 7) == 4 || (j & 7) == 7)) || j == 20) continue;
        const WJob jb = wjob(a, wb, j); const int nblk = jb.N / 32, nitems = (jb.K / 64) * nblk;
        for (int it = gw; it < nitems; it += NGW) { const int kb = it / nblk, nb = it % nblk, n0 = 32 * nb;
            const int drow0 = jb.glu_off < 0 ? n0 : ((n0 >> 7) * 256 + jb.glu_off + (n0 & 127));
            p0_transpose_item(jb.W, jb.ldw, jb.K, jb.WT, 64 * kb, jb.col0 + n0, drow0, scr, lane0, jb.gk); }
    }
    { const int gt = (F.vcu * NWAVES + F.wave) * 64 + lane0, NGT = NGW * 64; const f32x4* src = (const f32x4*)a.in[1]; v4u* dst = (v4u*)(ws + WS_PB);
      for (int rp_ = 0; rp_ <= ((PRO_REP >> 2) & 1); ++rp_)
      for (int i = gt; i < 2 * M * DPLE / 8; i += NGT) { const f32x4 v0 = NORM_LD((const GAS f32x4*)src + 2 * i), v1 = NORM_LD((const GAS f32x4*)src + 2 * i + 1); v4u o; o.x = pk2(v0.x, v0.y); o.y = pk2(v0.z, v0.w); o.z = pk2(v1.x, v1.y); o.w = pk2(v1.z, v1.w); ((GAS v4u*)dst)[i] = o; }
      float* cs = (float*)(ws + WS_COS); float* sn = (float*)(ws + WS_SIN);
      float* stp = (float*)(ws + WS_STEP);
      for (int i = gt; i < (SEQ + 1) * 128; i += NGT) { const bool is_step = (i >> 7) == SEQ; const int pos = is_step ? 16 : (i >> 7), fi = i & 127;
          const float inv = 1.0f / exp2f((float)fi * (13.287712379549449f / 127.0f)); const float ang = (float)pos * inv;
          double tr = (double)ang * 0.15915494309189535; tr -= __builtin_rint(tr); const float tf = (float)tr;
          const float cv = __builtin_amdgcn_cosf(tf), sv = __builtin_amdgcn_sinf(tf);
          if (is_step) { ((GAS float*)stp)[fi] = cv; ((GAS float*)stp)[128 + fi] = sv; } else { ((GAS float*)cs)[i] = cv; ((GAS float*)sn)[i] = sv; } }
    }
    for (int rp_ = 0; rp_ <= ((PRO_REP >> 3) & 1); ++rp_)
    xb_rows(F, a.in[0], (bf16*)(ws + WS_XN), (float*)(ws + WS_RS), (signed char*)(ws + WS_XQ), (float*)(ws + WS_RA));
}
typedef short s16x4 __attribute__((ext_vector_type(4)));
typedef short v4i16_t __attribute__((ext_vector_type(4)));
typedef float f32x16 __attribute__((ext_vector_type(16)));
__device__ __forceinline__ s16x4 tr_rd(LAS unsigned char* p) { return __builtin_bit_cast(s16x4, __builtin_amdgcn_ds_read_tr16_b64_v4i16((LAS v4i16_t*)p)); }
__device__ __forceinline__ bf16x8 cat8(const s16x4 a, const s16x4 b) { return (bf16x8){a[0], a[1], a[2], a[3], b[0], b[1], b[2], b[3]}; }
__device__ __forceinline__ unsigned cvtpk(float lo, float hi) { unsigned r; asm volatile("v_cvt_pk_bf16_f32 %0, %1, %2" : "=v"(r) : "v"(lo), "v"(hi)); return r; }

__device__ __forceinline__ void ret_core_unit(LAS unsigned char* lds, const bf16* Qg, const bf16* Kg, bf16* Vg, float* ssq, int b, int h, int es, int tid_in, int lane_in, int w, bool do_store, int pmask = 31) {
    int tid = tid_in, lane = lane_in; asm volatile("" : "+v"(tid), "+v"(lane));
    const int c16 = lane & 15, q = lane >> 4, r32 = lane & 31, hh = lane >> 5, blk = (lane >> 4) & 1, qq = c16 >> 2, pp = c16 & 3;
    const int ib = (w < 4) ? w : 11 - w;
    const float lg = __builtin_amdgcn_logf(1.0f - __builtin_amdgcn_exp2f(-5.0f - (float)h));
    const float cd = __builtin_amdgcn_exp2f(lg * 128.0f);
    const float fi = __builtin_amdgcn_exp2f(lg * (float)(16 * ib + c16 - 127));
    float qd[4];
#pragma unroll
    for (int r = 0; r < 4; ++r) qd[r] = __builtin_amdgcn_exp2f(lg * (float)(16 * ib + 4 * q + r + 1));
    const size_t rowbase = (size_t)b * SEQ;
    const bf16* Qh = Qg + rowbase * 1024 + h * 256;
    const bf16* Kh = Kg + rowbase * 1024 + h * 256;
    bf16* Vh = Vg + rowbase * LDV + h * 512 + es * 64;
    LAS unsigned char* ldK = lds + RET_LDS_K; LAS unsigned char* ldV = lds + RET_LDS_V; LAS unsigned char* ldS = lds + RET_LDS_S;
    unsigned rx[4], kt[2], vt[2][2], vdx[4], st[4], kst_a, vst_a;
    { const unsigned rbase = 256u * c16 + 16u * (q ^ ((c16 >> 2) & 3)), sig64 = 64u * (c16 & 3);
#pragma unroll
      for (int k = 0; k < 4; ++k) { rx[k] = rbase + ((64u * k) ^ sig64); asm volatile("" : "+v"(rx[k])); }
      const unsigned L = (2 * blk + (pp >> 1)) ^ (2 * hh);
#pragma unroll
      for (int t = 0; t < 2; ++t) { kt[t] = 256u * (8 * hh + qq) + 8u * (pp & 1) + 32768u * (w >> 2) + 64u * ((w & 3) ^ qq) + 1024u * t + 16u * (L ^ t); asm volatile("" : "+v"(kt[t])); }
      const unsigned vb = 128u * (8 * hh + qq) + 16u * ((pp >> 1) ^ (qq >> 1)) + 8u * (pp & 1);
#pragma unroll
      for (int eb = 0; eb < 2; ++eb)
#pragma unroll
          for (int t = 0; t < 2; ++t) { vt[eb][t] = vb + 512u * t + 64u * (eb ^ hh) + 32u * (blk ^ t); asm volatile("" : "+v"(vt[eb][t])); }
      const unsigned vd = 128u * (4 * q + qq) + 16u * ((pp >> 1) ^ (qq >> 1)) + 8u * (pp & 1);
#pragma unroll
      for (int cc = 0; cc < 4; ++cc) { vdx[cc] = vd + 32u * (cc ^ q); asm volatile("" : "+v"(vdx[cc])); }
      const unsigned ssb = 256u * r32 + 8u * hh + 64u * ((w & 3) ^ (r32 & 3)) + 16384u * (w >> 2);
#pragma unroll
      for (int g = 0; g < 4; ++g) { st[g] = ssb + 16u * (g ^ ((r32 >> 2) & 3)); asm volatile("" : "+v"(st[g])); }
      kst_a = koff(tid >> 5, (tid & 31) * 8); vst_a = voff(tid >> 3, (tid & 7) * 8); asm volatile("" : "+v"(kst_a), "+v"(vst_a));
    }
    f32x16 S0, S1;
#pragma unroll
    for (int r = 0; r < 16; ++r) { S0[r] = 0.f; S1[r] = 0.f; }
    v4u kst[8], vst[2]; bf16x8 qf[8];
    const bf16* kgp = Kh + (size_t)(tid >> 5) * 1024 + (tid & 31) * 8;
    const bf16* vgp = Vh + (size_t)(tid >> 3) * LDV + (tid & 7) * 8;
    const bf16* qgp = Qh + (size_t)(16 * ib + c16) * 1024 + 8 * q;
#define RET_LOAD_KV(c) do { const size_t t0_ = (size_t)(c) * CHUNK; \
        _Pragma("unroll") for (int n = 0; n < 8; ++n) kst[n] = *(const GAS v4u*)(kgp + (t0_ + 16 * n) * 1024); \
        _Pragma("unroll") for (int n = 0; n < 2; ++n) vst[n] = *(const GAS v4u*)(vgp + (t0_ + 64 * n) * LDV); } while (0)
#define RET_STORE_KV() do { \
        _Pragma("unroll") for (int n = 0; n < 8; ++n) *(LAS v4u*)(ldK + kst_a + 4096 * n) = kst[n]; \
        _Pragma("unroll") for (int n = 0; n < 2; ++n) *(LAS v4u*)(ldV + vst_a + 8192 * n) = vst[n]; } while (0)
#define RET_LOAD_Q(c) do { const size_t t0_ = (size_t)(c) * CHUNK; \
        _Pragma("unroll") for (int ks = 0; ks < 8; ++ks) qf[ks] = *(const GAS bf16x8*)(qgp + t0_ * 1024 + 32 * ks); } while (0)
#define RET_STORE_S() do { \
        _Pragma("unroll") for (int g = 0; g < 4; ++g) { \
            unsigned long long v0 = (unsigned long long)cvtpk(S0[4 * g], S0[4 * g + 1]) | ((unsigned long long)cvtpk(S0[4 * g + 2], S0[4 * g + 3]) << 32); \
            unsigned long long v1 = (unsigned long long)cvtpk(S1[4 * g], S1[4 * g + 1]) | ((unsigned long long)cvtpk(S1[4 * g + 2], S1[4 * g + 3]) << 32); \
            *(LAS unsigned long long*)(ldS + st[g]) = v0; *(LAS unsigned long long*)(ldS + st[g] + 8192) = v1; } } while (0)
    RET_LOAD_KV(0); RET_LOAD_Q(0);
    RET_STORE_S();
    RET_STORE_KV();
    RET_LOAD_KV(1);
    __syncthreads();
    for (int c = 0; c < NCHUNK; ++c) {
        const int t0 = c * CHUNK;
        f32x4 O[4];
#pragma unroll
        for (int cc = 0; cc < 4; ++cc) O[cc] = (f32x4){0.f, 0.f, 0.f, 0.f};
        if (pmask & 1)
#pragma unroll
        for (int ks = 0; ks < 8; ++ks)
#pragma unroll
            for (int cc = 0; cc < 4; ++cc) { const bf16x8 sb = *(const LAS bf16x8*)(ldS + rx[ks & 3] + (4096 * cc + 16384 * (ks >> 2))); O[cc] = __builtin_amdgcn_mfma_f32_16x16x32_bf16(qf[ks], sb, O[cc], 0, 0, 0); }
#pragma unroll
        for (int cc = 0; cc < 4; ++cc)
#pragma unroll
            for (int r = 0; r < 4; ++r) O[cc][r] *= qd[r];
        f32x4 X[8];
        {
            bf16x8 kf[8];
            if (pmask & 2) {
#pragma unroll
                for (int ks = 0; ks < 8; ++ks) kf[ks] = *(const LAS bf16x8*)(ldK + rx[ks & 3] + (32768 * (ks >> 2)));
            }
#pragma unroll
            for (int jb = 0; jb < 8; ++jb) { X[jb] = (f32x4){0.f, 0.f, 0.f, 0.f};
                if (jb <= ib && (pmask & 2)) {
#pragma unroll
                    for (int ks = 0; ks < 8; ++ks) { X[jb] = __builtin_amdgcn_mfma_f32_16x16x32_bf16(kf[ks], qf[ks], X[jb], 0, 0, 0);
                        if (jb < 7) kf[ks] = *(const LAS bf16x8*)(ldK + rx[ks & 3] + (4096 * (jb + 1) + 32768 * (ks >> 2))); }
#pragma unroll
                    for (int r = 0; r < 4; ++r) { float v = X[jb][r] * fi; if (jb == ib && 4 * q + r > c16) v = 0.f; X[jb][r] = v; }
                } }
        }
        if (c + 1 < NCHUNK) RET_LOAD_Q(c + 1);
#pragma unroll
        for (int s = 0; s < 4; ++s) {
            if (2 * s <= ib && (pmask & 16)) {
                v4u aw; aw.x = cvtpk(X[2 * s][0], X[2 * s][1]); aw.y = cvtpk(X[2 * s][2], X[2 * s][3]); aw.z = cvtpk(X[2 * s + 1][0], X[2 * s + 1][1]); aw.w = cvtpk(X[2 * s + 1][2], X[2 * s + 1][3]);
                const bf16x8 af = __builtin_bit_cast(bf16x8, aw);
#pragma unroll
                for (int cc = 0; cc < 4; ++cc) { const s16x4 b0 = tr_rd(ldV + vdx[cc] + 4096 * s), b1 = tr_rd(ldV + vdx[cc] + (4096 * s + 2048));
                    O[cc] = __builtin_amdgcn_mfma_f32_16x16x32_bf16(af, cat8(b0, b1), O[cc], 0, 0, 0); }
            } }
        if (do_store) {
            bf16* orow = Vh + (size_t)(t0 + 16 * ib + 4 * q) * LDV + c16; float* srow = ssq + ((rowbase + t0 + 16 * ib + 4 * q) * 4 + h) * 8 + es;
#pragma unroll
            for (int r = 0; r < 4; ++r) { float sq = 0.f;
#pragma unroll
                for (int cc = 0; cc < 4; ++cc) { sq += O[cc][r] * O[cc][r]; ((GAS bf16*)orow)[(size_t)r * LDV + 16 * cc] = (bf16)f2bf(O[cc][r]); }
                sq += __shfl_xor(sq, 1); sq += __shfl_xor(sq, 2); sq += __shfl_xor(sq, 4); sq += __shfl_xor(sq, 8);
                if (c16 == 0) ((GAS float*)srow)[r * 32] = sq; }
        }
        if (c + 1 < NCHUNK && (pmask & 4)) {
#pragma unroll
            for (int r = 0; r < 16; ++r) { S0[r] *= cd; S1[r] *= cd; }
#pragma unroll
            for (int ks = 0; ks < 8; ++ks) {
                const s16x4 a0 = tr_rd(ldK + kt[0] + 4096 * ks), a1 = tr_rd(ldK + kt[1] + 4096 * ks);
                const s16x4 b00 = tr_rd(ldV + vt[0][0] + 2048 * ks), b01 = tr_rd(ldV + vt[0][1] + 2048 * ks);
                const s16x4 b10 = tr_rd(ldV + vt[1][0] + 2048 * ks), b11 = tr_rd(ldV + vt[1][1] + 2048 * ks);
                const bf16x8 af = cat8(a0, a1);
                S0 = __builtin_amdgcn_mfma_f32_32x32x16_bf16(af, cat8(b00, b01), S0, 0, 0, 0);
                S1 = __builtin_amdgcn_mfma_f32_32x32x16_bf16(af, cat8(b10, b11), S1, 0, 0, 0);
            }
        }
        __syncthreads();
        if (c + 1 < NCHUNK) {
            RET_STORE_S();
            RET_STORE_KV();
            if (c + 2 < NCHUNK) RET_LOAD_KV(c + 2);
        }
        __syncthreads();
    }
#undef RET_LOAD_KV
#undef RET_STORE_KV
#undef RET_LOAD_Q
#undef RET_STORE_S
}
__device__ __forceinline__ void ret_core_phase(Frame& F, unsigned char* ws, bool do_store = true, int pmask = 31) {
    for (int unit = F.vcu; unit < BATCH * NHEAD * 8; unit += F.G)
        ret_core_unit(F.lds + RING_OFF, (const bf16*)(ws + WS_Q), (const bf16*)(ws + WS_K), (bf16*)(ws + WS_V), (float*)(ws + WS_SSQ), unit >> 5, (unit >> 3) & 3, unit & 7, F.wave * 64 + cur_lane(), cur_lane(), F.wave, do_store, pmask);
}

constexpr int CW_SEAM = 16384, SEAM_BANK = 128 * 64;
static_assert((CW_SEAM + 16 * SEAM_BANK) * 4 <= (int)CTL_ZERO_BYTES, "counter banks inside the memset region");
__global__ void __launch_bounds__(NWAVES * 64, 2) hybrid_fwd(KArgs args) {
    extern __shared__ __attribute__((aligned(16))) unsigned char lds[];
    Frame F;
    F.lds = (LAS unsigned char*)lds;
    F.MISC = (volatile LAS unsigned*)(F.lds + MISC_OFF);
    F.wave = __builtin_amdgcn_readfirstlane((int)threadIdx.x >> 6);
    F.G = gridDim.x; { const int bx = blockIdx.x; F.vcu = (F.G % 8 == 0) ? (bx % 8) * (F.G / 8) + bx / 8 : bx; }
    unsigned char* const ws_k = args.ws; const float* const gains_k = args.in[2];
    F.ctl = (gu32*)(ws_k + WS_CTL);
    for (int u = F.wave * 64 + cur_lane(); u < (LDS_BYTES - LDSCTL_OFF) / 4; u += NWAVES * 64) ((LAS unsigned*)(F.lds + LDSCTL_OFF))[u] = 0u;
    __syncthreads();
#if MK_PER_PHASE
#define GRID_BAR() do { } while (0)
#else
    XcdBarrier bar = xcd_barrier_post((unsigned*)(F.ctl + CW_BAR), F.MISC + 8, F.wave);
#define GRID_BAR() xcd_barrier(bar)
#endif
    const int lo = args.ph_lo, hi = args.ph_hi; int ph = 0;
    constexpr int CW_GRP = 8192;
    GroupBar gb, xb; { const int c = (int)blockIdx.x, gi = (c & 7) * 8 + ((c >> 3) & 7); gb.cnt = F.ctl + CW_GRP + 64 * (gi & ~(GROUP_MERGE - 1)); gb.st = F.MISC + 10; gb.wave = F.wave; gb.n = 4u * GROUP_MERGE;
        xb.cnt = F.ctl + CW_GRP + 64 * (64 + (c & 7)); xb.st = F.MISC + 12; xb.wave = F.wave; xb.n = 32u;
        if (xb_thread0(F.wave)) (void)__hip_atomic_fetch_or(F.ctl + CW_GRP + 64 * gi + 32, 1u << (bar.x & 31u), RLX_AGENT); }
#ifndef B_NT_MASK
#define B_NT_MASK 0
#endif
#ifndef GROUP_SEAMS
#define GROUP_SEAMS 1
#endif
#if GROUP_SEAMS
#define GROUP_BAR() do { if (F.MISC[11] == 1u) group_barrier(gb); else GRID_BAR(); } while (0)
#define XCD_BAR() do { if (F.MISC[11] == 1u) group_barrier(xb); else GRID_BAR(); } while (0)
#else
#define GROUP_BAR() GRID_BAR()
#define XCD_BAR() GRID_BAR()
#endif
#ifndef PROBE_CLK
#define PROBE_CLK 0
#endif
#if PROBE_CLK
#ifndef PROBE_BASE
#define PROBE_BASE 0.f
#endif
#define STAMP(k) if (F.wave == 0 && cur_lane() == 0) { const unsigned t_ = (unsigned)__builtin_amdgcn_s_memrealtime(); (void)__hip_atomic_fetch_max(F.ctl + 128 + 2 * (k), t_, RLX_AGENT); (void)__hip_atomic_fetch_max(F.ctl + 129 + 2 * (k), 0xffffffffu - t_, RLX_AGENT); }
#define TMAX(k) __hip_atomic_load(F.ctl + 128 + 2 * (k), RLX_AGENT)
#define TMIN(k) (0xffffffffu - __hip_atomic_load(F.ctl + 129 + 2 * (k), RLX_AGENT))
#define PROBE_OMUL , 1.0f + PROBE_BASE + floorf((float)(int)(PROBE_EXPR) / (float)(PROBE_Q)) * 0.01f
#else
#define STAMP(k)
#define PROBE_OMUL
#endif
#define PH_BEGIN if (lo <= ph && ph < hi) { unsigned char* ws = ws_k; const float* gains = gains_k; asm volatile("" : "+s"(ws), "+s"(gains));
#define PH_END_XCD if (ph + 1 < hi) XCD_BAR(); STAMP(ph) } ++ph;
#define PH_END_GRID if (ph + 1 < hi) GRID_BAR(); STAMP(ph) } ++ph;
#define PH_END_SEL(grid_) if (ph + 1 < hi) { if (grid_) GRID_BAR(); else GROUP_BAR(); } STAMP(ph) } ++ph;
#ifndef ALIGN_FFN
#define ALIGN_FFN 0
#endif
#if ALIGN_FFN
#define PH_END_ALIGN if (ph + 1 < hi) XCD_BAR(); STAMP(ph) } ++ph;
#else
#define PH_END_ALIGN if (ph + 1 < hi) GROUP_BAR(); STAMP(ph) } ++ph;
#endif
#define PH_END_GROUP if (ph + 1 < hi) GROUP_BAR(); STAMP(ph) } ++ph;
#define GEMM(EPI, I8_, SITE_) pg8::gemm_phase<EPI, pg8::StaticOrder, PG8_ALIGN, PG8_SP2, I8_, ((B_NT_MASK >> (SITE_)) & 1) != 0>(F.lds + RING_OFF, gm, S, E, F.wave)
#define SORDER(N_) pg8::StaticOrder S; S.init(M, (N_), F.G, (int)blockIdx.x)
#define wb ((bf16*)(ws + WS_W))
#define XN ((bf16*)(ws + WS_XN))
#define RS ((float*)(ws + WS_RS))
#define HB ((bf16*)(ws + WS_HBUF))
#define HID ((bf16*)(ws + WS_BIG))
#define XQp ((signed char*)(ws + WS_XQ))
#define RAp ((float*)(ws + WS_RA))
#define XQB ((signed char*)(ws + WS_BIG) + 2 * NHEAD * DV)
#define lw (wb + (size_t)l * W_LAYER)
#define fw (lw + (size_t)f * W_FFN)
#define g (gains + (size_t)l * 8 * D)

    PH_BEGIN
        p0_prologue(F, args);
        if (ph + 1 < hi) GRID_BAR();
        if (xb_thread0(F.wave)) F.MISC[11] = grp_mode_decide(F.ctl + CW_GRP + 32, F.G);
        __syncthreads();
        STAMP(ph) } ++ph;

    _Pragma("nounroll") for (int l = 0; l < 2; ++l) {
        _Pragma("nounroll") for (int f = 0; f < 2; ++f) {
            PH_BEGIN
                { pg8::Gemm gm{(const bf16*)XQp, fw + W_GU, M, 2 * FF, D / 2, XQ_LD / 2}; SORDER(2 * FF); pg8::EpiGLUq E{HID, FF, RAp, (const float*)(ws + WS_CW) + (l * 2 + f) * 2 * FF}; GEMM(pg8::EpiGLUq, true, 0); }
            PH_END_GROUP
            PH_BEGIN
                { pg8::Gemm gm{HID, fw + W_DN, M, D, FF}; SORDER(D); pg8::EpiH<0> E{HB, D, RS}; GEMM(pg8::EpiH<0>, false, 1);
                  GROUP_BAR();
                  if (l == 0 && f == 0) norm_rows_g<true>(F, S, HB, XN, RS, g + (f ? FFN2_POST : FFN1_POST) * D, 0.5f, (float*)nullptr, f ? XQp : (l == 1 ? XQB : (signed char*)nullptr), RAp, 1.0f, f ? XQ_LD : 2 * LDV, args.in[0]);
                  else norm_rows_g<false>(F, S, HB, XN, RS, g + (f ? FFN2_POST : FFN1_POST) * D, 0.5f, (float*)nullptr, f ? XQp : (l == 1 ? XQB : (signed char*)nullptr), RAp, 1.0f, f ? XQ_LD : 2 * LDV); }
            PH_END_GROUP
            if (f == 0) {
                if (l == 0) {
                    PH_BEGIN
                        { pg8::Gemm gm{XN, wb + W_CCH, M, 2 * D, D}; SORDER(2 * D); pg8::EpiGLU<0> E{(bf16*)(ws + WS_U), LDV, RS}; GEMM(pg8::EpiGLU<0>, false, 2); }
                    PH_END_XCD
                    PH_BEGIN
                        { pg8::Gemm gm{XN, wb + W_CB, M, D, D}; SORDER(D); pg8::EpiConv E{(bf16*)(ws + WS_AB), (const bf16*)(ws + WS_U), args.in[10], D, SEQ, RS, LDV}; GEMM(pg8::EpiConv, false, 3); }
                    PH_END_GROUP
                    PH_BEGIN
                        { pg8::Gemm gm{(const bf16*)(ws + WS_AB), wb + W_CO, M, D, D, LDV}; SORDER(D); pg8::EpiH<0> E{HB, D, RS}; GEMM(pg8::EpiH<0>, false, 4);
                          GROUP_BAR();
                          norm_rows_g(F, S, HB, XN, RS, g + MIX_POST * D, 1.0f, (float*)nullptr, XQp, RAp); }
                    PH_END_XCD
                } else {
                    PH_BEGIN
                        { pg8::Gemm gm{(const bf16*)XQB, wb + W_RIN, M, NRQKV, D / 2, LDV}; SORDER(NRQKV);
                          pg8::EpiDeq<pg8::EpiRetQKV> E{pg8::EpiRetQKV{pg8::EpiRetQK{(bf16*)(ws + WS_Q), (bf16*)(ws + WS_K), (const float*)(ws + WS_COS), (const float*)(ws + WS_SIN), SEQ, RAp, (const float*)(ws + WS_STEP)}, pg8::EpiRetV{(bf16*)(ws + WS_V), RAp}}, (const float*)(ws + WS_CW2) + 2 * D};
                          GEMM(pg8::EpiDeq<pg8::EpiRetQKV>, true, 5); }
                    PH_END_XCD
                    PH_BEGIN
                        ret_core_phase(F, ws);
                    PH_END_XCD
                    PH_BEGIN
                        { pg8::Gemm gm{(const bf16*)XQB, wb + W_RIN + (size_t)NRQKV * D / 2, M, 2048, D / 2, LDV}; SORDER(2048);
                          pg8::EpiRetGateQ E{(bf16*)(ws + WS_V), (const float*)(ws + WS_SSQ), NORM_EPS, RAp, (const float*)(ws + WS_CW2) + 2 * D + NRQKV}; GEMM(pg8::EpiRetGateQ, true, 6); }
                    PH_END_GROUP
                    PH_BEGIN
                        { pg8::Gemm gm{(const bf16*)(ws + WS_V), wb + W_ROUT, M, D, 2048, LDV}; SORDER(D); pg8::EpiH<0> E{HB, D, RS}; GEMM(pg8::EpiH<0>, false, 7);
                          GROUP_BAR();
                          norm_rows_g(F, S, HB, XN, RS, g + MIX_POST * D, 1.0f, (float*)nullptr, XQp, RAp); }
                    PH_END_ALIGN
                }
            } else {
                PH_BEGIN
                    { pg8::Gemm gm{(const bf16*)XQp, lw + W_PG, M, D, D / 2, XQ_LD / 2}; SORDER(D); pg8::EpiDeq<pg8::EpiH<1>> E{pg8::EpiH<1>{HB, D, RAp}, (const float*)(ws + WS_CW2) + l * D}; GEMM(pg8::EpiDeq<pg8::EpiH<1>>, true, 8); }
                    __syncthreads();
                    { pg8::Gemm gm{(const bf16*)(ws + WS_PB) + (size_t)l * M * DPLE, lw + W_PP, M, D, DPLE}; SORDER(D); pg8::EpiH<2> E{HB, D, RS}; GEMM(pg8::EpiH<2>, false, 9);
                      GROUP_BAR();
                      norm_rows_g(F, S, HB, XN, RS, g + PLE_POST * D, 1.0f, (l == 1 ? args.out : (float*)nullptr), (l == 1 ? (signed char*)nullptr : XQp), RAp PROBE_OMUL); }
                PH_END_ALIGN
            }
        }
    }
#undef PH_BEGIN
#undef PH_END_GRID
#undef PH_END_XCD
#undef PH_END_GROUP
#undef PH_END_ALIGN
#undef PH_END_SEL
#undef GEMM
#undef SORDER
#undef wb
#undef XN
#undef RS
#undef HB
#undef HID
#undef XQp
#undef RAp
#undef XQB
#undef lw
#undef fw
#undef g
}
constexpr int N_PHASES = 18;

extern "C" void kernel_launch(void* const* d_in, const int* in_sizes, int n_in, void* d_out, int out_size, void* d_ws, size_t ws_size, hipStream_t stream) {
    static int grid = 0;
    if (grid == 0) {
        if (n_in != 16 || in_sizes[0] != M * D || out_size != M * D || ws_size < WS_END) { fprintf(stderr, "kernel_launch: unexpected shapes / workspace (n_in %d, in0 %d, out %d, ws %zu, need %zu)\n", n_in, n_in > 0 ? in_sizes[0] : -1, out_size, ws_size, (size_t)WS_END); grid = -1; return; }
        int dev = 0, cus = 0;
        if (hipGetDevice(&dev) != hipSuccess || hipDeviceGetAttribute(&cus, hipDeviceAttributeMultiprocessorCount, dev) != hipSuccess) { grid = -1; return; }
        if (hipFuncSetAttribute((const void*)hybrid_fwd, hipFuncAttributeMaxDynamicSharedMemorySize, LDS_BYTES) != hipSuccess) { fprintf(stderr, "kernel_launch: hipFuncSetAttribute failed\n"); grid = -1; return; }
        int per_cu = 0;
        if (hipOccupancyMaxActiveBlocksPerMultiprocessor(&per_cu, (const void*)hybrid_fwd, NWAVES * 64, LDS_BYTES) != hipSuccess || per_cu < 1) fprintf(stderr, "kernel_launch: occupancy query reports %d\n", per_cu);
        (void)hipGetLastError();
        grid = cus;
    }
    if (grid < 0) return;
    if (hipMemsetAsync((char*)d_ws + WS_CTL, 0, CTL_ZERO_BYTES, stream) != hipSuccess) return;
    KArgs a{};
    for (int i = 0; i < 16; ++i) a.in[i] = (const float*)d_in[i];
    a.out = (float*)d_out; a.ws = (unsigned char*)d_ws;
#if MK_PER_PHASE
    for (int ph = 0; ph < N_PHASES; ++ph) { a.ph_lo = ph; a.ph_hi = ph + 1; hipLaunchKernelGGL(hybrid_fwd, dim3(grid), dim3(NWAVES * 64), LDS_BYTES, stream, a); }
#else
    a.ph_lo = 0; a.ph_hi = N_PHASES; hipLaunchKernelGGL(hybrid_fwd, dim3(grid), dim3(NWAVES * 64), LDS_BYTES, stream, a);
#endif
}
```
